# Optimizing an MI355X kernel written in HIP

```python
import jax, jax.numpy as jnp
from jax import lax
import numpy as np

D_MODEL = 1024
BATCH = 8
SEQ = 4096
DEPTH = 1
DEC_BATCH = 32
DEC_SEQ = 4
PAST_LEN = 16384
PAGE_SIZE = 128

HEAD_DIM = 64
N_GROUPS = 3
HEADS_PER_GROUP = 4
N_HEADS = N_GROUPS * HEADS_PER_GROUP
D_ATT = N_HEADS * HEAD_DIM
D_ATT_OUT = HEADS_PER_GROUP * HEAD_DIM
WINDOWS = (128, 512, 2048)
DILATIONS = (1, 4, 16)
C_CONV = D_MODEL
CONV_WIDTH = 31
D_FF = -(-8 * D_MODEL // (3 * 256)) * 256
N_IN = 3 * D_ATT + 2 * C_CONV + 2 * D_MODEL
RMS_EPS = 1e-6
LN_EPS = 1e-5
NEG_INF = -1e30
ATT_SCALE = HEAD_DIM ** -0.5

kernel_name = "dilated_window_conformer_conv_gated_hybrid_step"


def rms_norm(x, w):
    xf = x.astype(jnp.float32)
    y = xf * lax.rsqrt(jnp.mean(xf * xf, axis=-1, keepdims=True) + RMS_EPS)
    return (y * w.astype(jnp.float32)).astype(x.dtype)


def layer_norm(x, w, b):
    xf = x.astype(jnp.float32)
    mu = jnp.mean(xf, axis=-1, keepdims=True)
    xc = xf - mu
    y = xc * lax.rsqrt(jnp.mean(xc * xc, axis=-1, keepdims=True) + LN_EPS)
    return (y * w.astype(jnp.float32) + b.astype(jnp.float32)).astype(x.dtype)


def branch_inputs(x, norm_w, w_in, q_norm_w, k_norm_w):
    xn = rms_norm(x, norm_w)
    z = xn @ w_in
    lead = z.shape[:-1]
    o = 0
    q = z[..., o:o + D_ATT].reshape(*lead, N_GROUPS, HEADS_PER_GROUP, HEAD_DIM); o += D_ATT
    k = z[..., o:o + D_ATT].reshape(*lead, N_GROUPS, HEADS_PER_GROUP, HEAD_DIM); o += D_ATT
    v = z[..., o:o + D_ATT].reshape(*lead, N_GROUPS, HEADS_PER_GROUP, HEAD_DIM); o += D_ATT
    ua = z[..., o:o + C_CONV]; o += C_CONV
    ub = z[..., o:o + C_CONV]; o += C_CONV
    ga = z[..., o:o + D_MODEL]; o += D_MODEL
    gb = z[..., o:o + D_MODEL]
    q = rms_norm(q, q_norm_w)
    k = rms_norm(k, k_norm_w)
    u = ua * jax.nn.sigmoid(ub)
    return q, k, v, u, ga, gb


def window_attn_prompt(q, k, v, window, dil):
    B, T, H, dh = q.shape
    blk = window // dil
    seg = blk * dil
    Tp = -(-T // seg) * seg
    pad = Tp - T
    n = Tp // dil
    nb = n // blk

    def to_blocks(a):
        a = jnp.pad(a, ((0, 0), (0, pad), (0, 0), (0, 0)))
        a = a.reshape(B, n, dil, H, dh).transpose(0, 2, 1, 3, 4)
        return a.reshape(B, dil, nb, blk, H, dh)

    def with_prev(a):
        prev = jnp.pad(a[:, :, :-1], ((0, 0), (0, 0), (1, 0), (0, 0), (0, 0), (0, 0)))
        return jnp.concatenate([prev, a], axis=3)

    qb = to_blocks(q).astype(jnp.float32)
    kk = with_prev(to_blocks(k)).astype(jnp.float32)
    vv = with_prev(to_blocks(v)).astype(jnp.float32)
    s = jnp.einsum('brnqhd,brnkhd->brnhqk', qb, kk) * ATT_SCALE
    qi = jnp.arange(blk)[:, None]
    ki = jnp.arange(2 * blk)[None, :]
    dist = qi + blk - ki
    band = (dist >= 0) & (dist <= blk)
    has_prev = jnp.arange(nb)[:, None, None] > 0
    valid = band[None] & (has_prev | (ki >= blk)[None])
    s = jnp.where(valid[None, None, :, None], s, NEG_INF)
    lse = jax.nn.logsumexp(s, axis=-1)
    p = jnp.exp(s - lse[..., None])
    o = jnp.einsum('brnhqk,brnkhd->brnqhd', p, vv)
    o = o.reshape(B, dil, n, H, dh).transpose(0, 2, 1, 3, 4).reshape(B, Tp, H, dh)[:, :T]
    lse = lse.transpose(0, 1, 2, 4, 3).reshape(B, dil, n, H).transpose(0, 2, 1, 3).reshape(B, Tp, H)[:, :T]
    return o, lse


def window_attn_sample(q, ext_k, ext_v, window, dil):
    S = q.shape[1]
    L = ext_k.shape[1] - S
    J = window // dil
    idx = L + jnp.arange(S)[:, None] - dil * jnp.arange(J + 1)[None, :]
    valid = idx >= 0
    idx = jnp.maximum(idx, 0)
    kg = ext_k[:, idx].astype(jnp.float32)
    vg = ext_v[:, idx].astype(jnp.float32)
    s = jnp.einsum('bshd,bsjhd->bshj', q.astype(jnp.float32), kg) * ATT_SCALE
    s = jnp.where(valid[None, :, None, :], s, NEG_INF)
    lse = jax.nn.logsumexp(s, axis=-1)
    p = jnp.exp(s - lse[..., None])
    o = jnp.einsum('bshj,bsjhd->bshd', p, vg)
    return o, lse


def combine_groups(outs, lses):
    o = jnp.stack(outs, axis=0)
    alpha = jax.nn.softmax(jnp.stack(lses, axis=0), axis=0)
    return jnp.sum(alpha[..., None] * o, axis=0)


def causal_dwconv(u_ext, w, b):
    y = lax.conv_general_dilated(u_ext, w[:, None, :], window_strides=(1,), padding='VALID',
                                 dimension_numbers=('NWC', 'WIO', 'NWC'), feature_group_count=C_CONV)
    return y + b


def merge_and_ffn(x, o_att, c, ga, gb, w_att, conv_ln_w, conv_ln_b, w_conv_out, w_out,
                  norm_ffn_w, w_gate_up, w_down):
    a = o_att.reshape(*o_att.shape[:-2], D_ATT_OUT) @ w_att
    cb = jax.nn.silu(layer_norm(c, conv_ln_w, conv_ln_b)) @ w_conv_out
    h = jax.nn.sigmoid(ga) * a + jax.nn.sigmoid(gb) * cb
    x = x + h @ w_out
    gu = rms_norm(x, norm_ffn_w) @ w_gate_up
    g, up = gu[..., :D_FF], gu[..., D_FF:]
    return x + (jax.nn.silu(g) * up) @ w_down


def setup_inputs(seed: int = 0) -> dict:
    key = jax.random.key(seed)
    ks = jax.random.split(key, 24)
    f32 = jnp.float32
    nrm = lambda k, shape, scale: jax.random.normal(k, shape, f32) * scale
    lens = [min(w, PAST_LEN) for w in WINDOWS]
    return {
        "x_prompt": nrm(ks[0], (BATCH, SEQ, D_MODEL), 1.0),
        "x_sample": nrm(ks[1], (DEC_BATCH, DEC_SEQ, D_MODEL), 1.0),
        "cache_kv_w128": nrm(ks[2], (DEPTH, DEC_BATCH, lens[0], 2, HEADS_PER_GROUP, HEAD_DIM), 1.0),
        "cache_kv_w512": nrm(ks[3], (DEPTH, DEC_BATCH, lens[1], 2, HEADS_PER_GROUP, HEAD_DIM), 1.0),
        "cache_kv_w2048": nrm(ks[4], (DEPTH, DEC_BATCH, lens[2], 2, HEADS_PER_GROUP, HEAD_DIM), 1.0),
        "state_conv": nrm(ks[5], (DEPTH, DEC_BATCH, CONV_WIDTH - 1, C_CONV), 0.5),
        "norm_mix_w": 1.0 + nrm(ks[6], (DEPTH, D_MODEL), 0.02),
        "w_in": nrm(ks[7], (DEPTH, D_MODEL, N_IN), D_MODEL ** -0.5),
        "q_norm_w": 1.0 + nrm(ks[8], (DEPTH, HEAD_DIM), 0.02),
        "k_norm_w": 1.0 + nrm(ks[9], (DEPTH, HEAD_DIM), 0.02),
        "w_att": nrm(ks[10], (DEPTH, D_ATT_OUT, D_MODEL), D_ATT_OUT ** -0.5),
        "conv_w": nrm(ks[11], (DEPTH, CONV_WIDTH, C_CONV), CONV_WIDTH ** -0.5),
        "conv_b": nrm(ks[12], (DEPTH, C_CONV), 0.02),
        "conv_ln_w": 1.0 + nrm(ks[13], (DEPTH, C_CONV), 0.02),
        "conv_ln_b": nrm(ks[14], (DEPTH, C_CONV), 0.02),
        "w_conv_out": nrm(ks[15], (DEPTH, C_CONV, D_MODEL), C_CONV ** -0.5),
        "w_out": nrm(ks[16], (DEPTH, D_MODEL, D_MODEL), D_MODEL ** -0.5),
        "norm_ffn_w": 1.0 + nrm(ks[17], (DEPTH, D_MODEL), 0.02),
        "w_gate_up": nrm(ks[18], (DEPTH, D_MODEL, 2 * D_FF), D_MODEL ** -0.5),
        "w_down": nrm(ks[19], (DEPTH, D_FF, D_MODEL), D_FF ** -0.5),
    }


def reference(x_prompt, x_sample, cache_kv_w128, cache_kv_w512, cache_kv_w2048, state_conv,
              norm_mix_w, w_in, q_norm_w, k_norm_w, w_att, conv_w, conv_b, conv_ln_w, conv_ln_b,
              w_conv_out, w_out, norm_ffn_w, w_gate_up, w_down):
    caches = (cache_kv_w128, cache_kv_w512, cache_kv_w2048)
    xp, xs = x_prompt, x_sample
    p_kv = [[] for _ in WINDOWS]
    s_kv = [[] for _ in WINDOWS]
    p_conv, s_conv = [], []
    for l in range(DEPTH):
        q, k, v, u, ga, gb = branch_inputs(xp, norm_mix_w[l], w_in[l], q_norm_w[l], k_norm_w[l])
        T = xp.shape[1]
        outs, lses = [], []
        for g, (win, dil) in enumerate(zip(WINDOWS, DILATIONS)):
            o, lse = window_attn_prompt(q[:, :, g], k[:, :, g], v[:, :, g], win, dil)
            outs.append(o)
            lses.append(lse)
            lp = min(win, T)
            p_kv[g].append(jnp.stack([k[:, T - lp:, g], v[:, T - lp:, g]], axis=2))
        o_att = combine_groups(outs, lses).astype(xp.dtype)
        u_ext = jnp.pad(u, ((0, 0), (CONV_WIDTH - 1, 0), (0, 0)))
        c = causal_dwconv(u_ext, conv_w[l], conv_b[l])
        p_conv.append(u_ext[:, -(CONV_WIDTH - 1):])
        xp = merge_and_ffn(xp, o_att, c, ga, gb, w_att[l], conv_ln_w[l], conv_ln_b[l], w_conv_out[l],
                           w_out[l], norm_ffn_w[l], w_gate_up[l], w_down[l])

        q, k, v, u, ga, gb = branch_inputs(xs, norm_mix_w[l], w_in[l], q_norm_w[l], k_norm_w[l])
        outs, lses = [], []
        for g, (win, dil) in enumerate(zip(WINDOWS, DILATIONS)):
            new_kv = jnp.stack([k[:, :, g], v[:, :, g]], axis=2)
            ext = jnp.concatenate([caches[g][l].astype(new_kv.dtype), new_kv], axis=1)
            o, lse = window_attn_sample(q[:, :, g], ext[:, :, 0], ext[:, :, 1], win, dil)
            outs.append(o)
            lses.append(lse)
            ln = min(win, ext.shape[1])
            s_kv[g].append(ext[:, ext.shape[1] - ln:])
        o_att = combine_groups(outs, lses).astype(xs.dtype)
        u_ext = jnp.concatenate([state_conv[l].astype(u.dtype), u], axis=1)
        c = causal_dwconv(u_ext, conv_w[l], conv_b[l])
        s_conv.append(u_ext[:, -(CONV_WIDTH - 1):])
        xs = merge_and_ffn(xs, o_att, c, ga, gb, w_att[l], conv_ln_w[l], conv_ln_b[l], w_conv_out[l],
                           w_out[l], norm_ffn_w[l], w_gate_up[l], w_down[l])
    return (xp, xs,
            jnp.stack(p_kv[0]), jnp.stack(s_kv[0]),
            jnp.stack(p_kv[1]), jnp.stack(s_kv[1]),
            jnp.stack(p_kv[2]), jnp.stack(s_kv[2]),
            jnp.stack(p_conv), jnp.stack(s_conv))
```

```cpp
#include <hip/hip_runtime.h>
#include <cstdio>
#include <cstdint>
namespace pg8 {
#define PG8_LAS __attribute__((address_space(3)))
typedef unsigned short bf16_t;
typedef short bf16x8 __attribute__((ext_vector_type(8)));
typedef float f32x4 __attribute__((ext_vector_type(4)));
typedef unsigned u32x4 __attribute__((ext_vector_type(4)));
constexpr int BM = 256, BK = 64, HALF = 128, HTB = HALF * BK * 2  , STAGE_BYTES = 8 * HTB, NXCD = 8, WGM = 8;

__host__ __device__ __forceinline__ int lds_byte(int r, int c) { const int st = (r >> 4) * 2 + (c >> 5), rr = r & 15, cc = c & 31, ob = rr * 64 + cc * 2; return st * 1024 + (ob ^ (((ob >> 9) & 1) << 5)); }
__host__ __device__ __forceinline__ void stage_rc(int b, int& R, int& C) { const int st = b / 1024, sb = b % 1024, swz = sb ^ (((sb >> 9) & 1) << 5); R = (st >> 1) * 16 + swz / 64; C = (st & 1) * 32 + (swz % 64) / 2; }
__host__ __device__ __forceinline__ int perm32(int rho) { const int n = rho >> 4, i = rho & 15; return 8 * (i >> 2) + 4 * n + (i & 3); }

struct Unit { int pm, pn; };
struct Gemm { const bf16_t* A; const bf16_t* Bt; int M, N, K; };

struct StaticOrder {
    int nM, nN, nwg, G, c;
    __host__ __device__ void init(int M, int N, int G_, int c_) { nM = M / BM; nN = N / BM; nwg = nM * nN; G = G_; c = c_; }
    __host__ __device__ bool next(int i, Unit& u) const {
        const long L = (long)i * G + c; if (L >= nwg) return false;
        int wgid = (int)L; { const int q = nwg / NXCD, r = nwg % NXCD, xcd = wgid % NXCD, off = wgid / NXCD; wgid = (xcd < r ? xcd * (q + 1) : r * (q + 1) + (xcd - r) * q) + off; }
        const int nig = WGM * nN, gid = wgid / nig, fm = gid * WGM, gsz = (nM - fm) < WGM ? (nM - fm) : WGM;
        u.pm = fm + ((wgid % nig) % gsz); u.pn = (wgid % nig) / gsz; return true;
    }
    __device__ __forceinline__ void a_ready(const Unit&) const {}
    __device__ __forceinline__ void done(const Unit&) const {}
};
typedef float f32x2_cv __attribute__((ext_vector_type(2))); typedef __bf16 bf16x2_cv __attribute__((ext_vector_type(2)));
__device__ __forceinline__ unsigned cvt_pk_bf16(float lo, float hi) { f32x2_cv v = {lo, hi}; bf16x2_cv b = __builtin_convertvector(v, bf16x2_cv); return __builtin_bit_cast(unsigned, b); }
typedef float f32x2 __attribute__((ext_vector_type(2)));
template <class Epi, class Sched, bool ALIGN_EPI = false, bool SP2 = false>
__device__ __forceinline__ void gemm_phase(PG8_LAS unsigned char* lds, const Gemm g, const Sched& S, const Epi& E) {
    const int tid = threadIdx.x, wid = __builtin_amdgcn_readfirstlane(tid >> 6), lane = tid & 63, wr = wid >> 2, wc = wid & 3, fr = lane & 15, fq = lane >> 4;
    const int K = g.K, nt = K / BK;
    unsigned voffA[2], voffB[2];
#pragma unroll
    for (int i = 0; i < 2; ++i) { int R, C; stage_rc(tid * 16 + i * 8192, R, C); const int Rb = Epi::PERM ? ((R & ~31) + perm32(R & 31)) : R;
        voffA[i] = (unsigned)(R * K + C) * 2u; voffB[i] = (unsigned)(Rb * K + C) * 2u; }
    const size_t kstep = (size_t)(BK * 2);
    const size_t hstep = (size_t)HALF * K * 2;
    const size_t tstep = 2 * hstep;
    const unsigned ldsw = (unsigned)wid * 1024u;
    const int aoff = lds_byte(wr * 64 + fr, fq * 8), boff = lds_byte(wc * 32 + fr, fq * 8);
#define PG8_SA(b, h) (((b) * 2 + (h)) * HTB)
#define PG8_SB(b, h) ((4 + (b) * 2 + (h)) * HTB)
#define PG8_STAGE(bufoff, gbase, voff) do { _Pragma("unroll") for (int _i = 0; _i < 2; ++_i) \
        __builtin_amdgcn_global_load_lds((const unsigned*)((const char*)(gbase) + (voff)[_i]), (PG8_LAS unsigned*)(lds + (bufoff) + ldsw + _i * 8192), 16, 0, 0); } while (0)
#define PG8_LDA(dst, b, h) do { _Pragma("unroll") for (int m = 0; m < 4; ++m) _Pragma("unroll") for (int k = 0; k < 2; ++k) dst[m][k] = *(const PG8_LAS bf16x8*)(lds + PG8_SA(b, h) + aoff + m * 2048 + k * 1024); } while (0)
#define PG8_LDB(dst, b, h) do { _Pragma("unroll") for (int n = 0; n < 2; ++n) _Pragma("unroll") for (int k = 0; k < 2; ++k) dst[n][k] = *(const PG8_LAS bf16x8*)(lds + PG8_SB(b, h) + boff + n * 2048 + k * 1024); } while (0)
#define PG8_MMA(ai, bj, At, Bt) do { __builtin_amdgcn_s_setprio(1); _Pragma("unroll") for (int m = 0; m < 4; ++m) _Pragma("unroll") for (int n = 0; n < 2; ++n) _Pragma("unroll") for (int k = 0; k < 2; ++k) \
        acc[ai][bj][m][n] = __builtin_amdgcn_mfma_f32_16x16x32_bf16(Bt[n][k], At[m][k], acc[ai][bj][m][n], 0, 0, 0); __builtin_amdgcn_s_setprio(0); } while (0)
#define PG8_WAIT_V(n) asm volatile("s_waitcnt vmcnt(" #n ")" ::: "memory")
#define PG8_WAIT_L(n) asm volatile("s_waitcnt lgkmcnt(" #n ")" ::: "memory")
#define PG8_BAR __builtin_amdgcn_s_barrier()
#define PG8_SCHED __builtin_amdgcn_sched_barrier(0)
    Unit cur, nxt; int ui = 0;
    if (!S.next(0, cur)) return;
    f32x4 acc[2][2][4][2];
#pragma unroll
    for (int a = 0; a < 2; ++a)
#pragma unroll
        for (int b = 0; b < 2; ++b)
#pragma unroll
            for (int m = 0; m < 4; ++m)
#pragma unroll
                for (int n = 0; n < 2; ++n) acc[a][b][m][n] = (f32x4){0.f, 0.f, 0.f, 0.f};
    bf16x8 At[4][2], B0[2][2], B1[2][2];
    const char* cA = (const char*)g.A + (size_t)cur.pm * tstep; const char* cB = (const char*)g.Bt + (size_t)cur.pn * tstep;
    S.a_ready(cur);
    if constexpr (SP2) {
        PG8_STAGE(PG8_SB(0, 0), cB, voffB); PG8_STAGE(PG8_SB(0, 1), cB + hstep, voffB); PG8_STAGE(PG8_SA(0, 0), cA, voffA); PG8_STAGE(PG8_SA(0, 1), cA + hstep, voffA);
        if (wr == 1) PG8_BAR;
        PG8_WAIT_V(2); PG8_BAR;
        PG8_STAGE(PG8_SB(1, 0), cB + kstep, voffB); PG8_STAGE(PG8_SA(1, 0), cA + kstep, voffA); PG8_STAGE(PG8_SB(1, 1), cB + hstep + kstep, voffB);
        PG8_WAIT_V(6); PG8_BAR;
    } else {
        PG8_STAGE(PG8_SB(0, 0), cB, voffB); PG8_STAGE(PG8_SA(0, 0), cA, voffA); PG8_STAGE(PG8_SB(0, 1), cB + hstep, voffB); PG8_STAGE(PG8_SA(0, 1), cA + hstep, voffA);
        if (wr == 1) PG8_BAR;
        PG8_WAIT_V(4); PG8_BAR;
        PG8_STAGE(PG8_SB(1, 0), cB + kstep, voffB); PG8_STAGE(PG8_SA(1, 0), cA + kstep, voffA); PG8_STAGE(PG8_SB(1, 1), cB + hstep + kstep, voffB);
        PG8_WAIT_V(6); PG8_BAR;
    }
    for (;;) {
        const bool has_next = S.next(ui + 1, nxt);
        const char* nA = has_next ? (const char*)g.A + (size_t)nxt.pm * tstep : cA; const char* nB = has_next ? (const char*)g.Bt + (size_t)nxt.pn * tstep : cB;
        for (int t = 0; t < nt; t += 2) {
            const bool last = (t == nt - 2);
            const char* a1 = cA + (size_t)(t + 1) * kstep;
            const char* a2 = last ? nA : cA + (size_t)(t + 2) * kstep; const char* b2 = last ? nB : cB + (size_t)(t + 2) * kstep;
            const char* a3 = a2 + kstep; const char* b3 = b2 + kstep;
            if (last && has_next) S.a_ready(nxt);
            if constexpr (SP2) {
            PG8_LDB(B0, 0, 0); PG8_LDB(B1, 0, 1); PG8_SCHED; PG8_LDA(At, 0, 0); PG8_STAGE(PG8_SA(1, 1), a1 + hstep, voffA);
            PG8_WAIT_V(8); PG8_WAIT_L(0); PG8_BAR; PG8_MMA(0, 0, At, B0); PG8_MMA(0, 1, At, B1); PG8_BAR; PG8_SCHED;
            PG8_LDA(At, 0, 1); PG8_STAGE(PG8_SB(0, 0), b2, voffB); PG8_STAGE(PG8_SB(0, 1), b2 + hstep, voffB); PG8_STAGE(PG8_SA(0, 0), a2, voffA);
            PG8_WAIT_V(8); PG8_WAIT_L(0); PG8_BAR; PG8_MMA(1, 0, At, B0); PG8_MMA(1, 1, At, B1); PG8_BAR; PG8_SCHED;
            PG8_LDB(B0, 1, 0); PG8_LDB(B1, 1, 1); PG8_SCHED; PG8_LDA(At, 1, 0); PG8_STAGE(PG8_SA(0, 1), a2 + hstep, voffA);
            PG8_WAIT_V(8); PG8_WAIT_L(0); PG8_BAR; PG8_MMA(0, 0, At, B0); PG8_MMA(0, 1, At, B1); PG8_BAR; PG8_SCHED;
            PG8_LDA(At, 1, 1); PG8_STAGE(PG8_SB(1, 0), b3, voffB); PG8_STAGE(PG8_SB(1, 1), b3 + hstep, voffB); PG8_STAGE(PG8_SA(1, 0), a3, voffA);
            PG8_WAIT_V(8); PG8_WAIT_L(0); PG8_BAR; PG8_MMA(1, 0, At, B0); PG8_MMA(1, 1, At, B1); PG8_BAR; PG8_SCHED;
            } else {
            PG8_LDB(B0, 0, 0); PG8_SCHED; PG8_LDA(At, 0, 0); PG8_STAGE(PG8_SA(1, 1), a1 + hstep, voffA);
            PG8_WAIT_L(8); PG8_BAR; PG8_WAIT_L(0); PG8_MMA(0, 0, At, B0); PG8_BAR; PG8_SCHED;
            PG8_LDB(B1, 0, 1); PG8_STAGE(PG8_SB(0, 0), b2, voffB);
            PG8_BAR; PG8_WAIT_L(0); PG8_MMA(0, 1, At, B1); PG8_BAR;
            PG8_LDA(At, 0, 1); PG8_STAGE(PG8_SA(0, 0), a2, voffA);
            PG8_BAR; PG8_WAIT_L(0); PG8_MMA(1, 0, At, B0); PG8_BAR; PG8_SCHED;
            PG8_STAGE(PG8_SB(0, 1), b2 + hstep, voffB);
            PG8_WAIT_V(6); PG8_BAR; PG8_MMA(1, 1, At, B1); PG8_BAR;
            PG8_LDB(B0, 1, 0); PG8_SCHED; PG8_LDA(At, 1, 0); PG8_STAGE(PG8_SA(0, 1), a2 + hstep, voffA);
            PG8_WAIT_L(8); PG8_BAR; PG8_WAIT_L(0); PG8_MMA(0, 0, At, B0); PG8_BAR; PG8_SCHED;
            PG8_LDB(B1, 1, 1); PG8_STAGE(PG8_SB(1, 0), b3, voffB);
            PG8_BAR; PG8_WAIT_L(0); PG8_MMA(0, 1, At, B1); PG8_BAR;
            PG8_LDA(At, 1, 1); PG8_STAGE(PG8_SA(1, 0), a3, voffA);
            PG8_BAR; PG8_WAIT_L(0); PG8_MMA(1, 0, At, B0); PG8_BAR; PG8_SCHED;
            PG8_STAGE(PG8_SB(1, 1), b3 + hstep, voffB);
            PG8_WAIT_V(6); PG8_BAR; PG8_MMA(1, 1, At, B1); PG8_BAR;
            }
        }
        if constexpr (ALIGN_EPI) { if (wr == 0) PG8_BAR; }
        if constexpr (!Epi::AFTER_DRAIN) { E(acc, cur, wr, wc, fr, fq); S.done(cur); }
        if (!has_next) break;
#pragma unroll
        for (int a = 0; a < 2; ++a)
#pragma unroll
            for (int b = 0; b < 2; ++b)
#pragma unroll
                for (int m = 0; m < 4; ++m)
#pragma unroll
                    for (int n = 0; n < 2; ++n) acc[a][b][m][n] = (f32x4){0.f, 0.f, 0.f, 0.f};
        cur = nxt; cA = nA; cB = nB; ++ui;
        if constexpr (ALIGN_EPI) { if (wr == 1) PG8_BAR; }
    }
    PG8_WAIT_V(0);
    if constexpr (!ALIGN_EPI) { if (wr == 0) PG8_BAR; }
    PG8_BAR;
    if constexpr (Epi::AFTER_DRAIN) { E.fused(acc, cur, wr, wc, fr, fq, lds, wid, lane); S.done(cur); }
#undef PG8_SA
#undef PG8_SB
#undef PG8_STAGE
#undef PG8_LDA
#undef PG8_LDB
#undef PG8_MMA
#undef PG8_WAIT_V
#undef PG8_WAIT_L
#undef PG8_BAR
#undef PG8_SCHED
}
}
#define GAS __attribute__((address_space(1)))
#define LAS __attribute__((address_space(3)))
typedef unsigned short bf16;
typedef unsigned v4u __attribute__((ext_vector_type(4)));
typedef float f32x4 __attribute__((ext_vector_type(4)));
typedef short bf16x8 __attribute__((ext_vector_type(8)));
typedef GAS unsigned gu32;
typedef GAS unsigned long long gu64;
#define RLX_AGENT __ATOMIC_RELAXED, __HIP_MEMORY_SCOPE_AGENT
#define LDS_WAIT() asm volatile("s_waitcnt lgkmcnt(0)" ::: "memory")
#define VM_WAIT() asm volatile("s_waitcnt vmcnt(0)" ::: "memory")
__device__ __forceinline__ unsigned long long rt() { return __builtin_amdgcn_s_memrealtime(); }
__device__ __forceinline__ unsigned f2bf(float f) { unsigned u = __builtin_bit_cast(unsigned, f); return (u + 0x7fffu + ((u >> 16) & 1u)) >> 16; }
__device__ __forceinline__ unsigned pk2(float lo, float hi) { return f2bf(lo) | (f2bf(hi) << 16); }

#define XB_TMO      128
#define XB_XCNT(j)  (256  + 64 * (j))
#define XB_XSUB(j)  (1280 + 64 * (j))
#define XB_XGEN(j)  (2304 + 64 * (j))
#define XB_TOP      3328
#define XB_TOPGEN   3392
#define XCD_BAR_WORDS 3456
#define XB_SPIN_CAP (1u << 18)

__device__ __forceinline__ unsigned xb_ld(unsigned* p)              { return __hip_atomic_load(p, __ATOMIC_RELAXED, __HIP_MEMORY_SCOPE_AGENT); }
__device__ __forceinline__ unsigned xb_add(unsigned* p, unsigned v) { return __hip_atomic_fetch_add(p, v, __ATOMIC_RELAXED, __HIP_MEMORY_SCOPE_AGENT); }
__device__ __forceinline__ unsigned xb_xcc_id() { return (unsigned)__builtin_amdgcn_s_getreg((3 << 11) | 20) & 0xFu; }
#define XB_SPIN(cond, bar) do { unsigned _sp = 0; while (cond) { __builtin_amdgcn_s_sleep(1); \
    if ((++_sp & 255u) == 0u) { if (xb_ld(&(bar)[XB_TMO])) break; if (_sp > XB_SPIN_CAP) { atomicAdd(&(bar)[XB_TMO], 1u); break; } } } } while (0)

struct XcdBarrier {
    unsigned* bar; unsigned x;
    volatile LAS unsigned* st;
};

__device__ __forceinline__ XcdBarrier xcd_barrier_post(unsigned* bar, volatile LAS unsigned* st) {
    XcdBarrier b; b.bar = bar; b.x = xb_xcc_id(); b.st = st;
    if (threadIdx.x == 0) (void)xb_add(&bar[XB_XCNT(b.x)], 1u);
    return b;
}
__device__ __forceinline__ void xcd_barrier_complete(unsigned* bar, unsigned x, unsigned& nloc, unsigned& nx) {
    const unsigned G = gridDim.x * gridDim.y * gridDim.z;
    unsigned sum, cnt, mine, sp = 0u;
    for (;;) {
        sum = 0u; cnt = 0u; mine = 0u;
#pragma unroll
        for (unsigned j = 0; j < 16; ++j) { const unsigned c = xb_ld(&bar[XB_XCNT(j)]); sum += c; cnt += (c > 0u) ? 1u : 0u; mine = (j == x) ? c : mine; }
        if (sum == G) break;
        __builtin_amdgcn_s_sleep(1);
        if ((++sp & 255u) == 0u) { if (xb_ld(&bar[XB_TMO])) break; if (sp > XB_SPIN_CAP) { atomicAdd(&bar[XB_TMO], 1u); break; } }
    }
    nloc = mine > 0u ? mine : 1u; nx = cnt > 0u ? cnt : 1u;
}

__device__ __forceinline__ void xcd_barrier(const XcdBarrier& b) {
    asm volatile("s_waitcnt vmcnt(0)" ::: "memory");
    __syncthreads();
    if (threadIdx.x == 0) {
        unsigned* bar = b.bar;
        __builtin_amdgcn_s_waitcnt(0);
        unsigned nloc = b.st[0], nx = b.st[1];
        if (nloc == 0u) { xcd_barrier_complete(bar, b.x, nloc, nx); b.st[0] = nloc; b.st[1] = nx; }
        const unsigned old = xb_add(&bar[XB_XSUB(b.x)], 1u);
        const unsigned gen = old / nloc;
        if (old + 1u == (gen + 1u) * nloc) {
            __builtin_amdgcn_fence(__ATOMIC_RELEASE, "agent");
            asm volatile("s_waitcnt vmcnt(0)" ::: "memory");
            const unsigned og = xb_add(&bar[XB_TOP], 1u);
            const unsigned tg = og / nx;
            if (og + 1u == (tg + 1u) * nx) xb_add(&bar[XB_TOPGEN], 1u);
            else XB_SPIN(xb_ld(&bar[XB_TOPGEN]) == tg, bar);
            __builtin_amdgcn_fence(__ATOMIC_ACQUIRE, "agent");
            xb_add(&bar[XB_XGEN(b.x)], 1u);
            asm volatile("s_waitcnt vmcnt(0)" ::: "memory");
        } else {
            XB_SPIN(xb_ld(&bar[XB_XGEN(b.x)]) == gen, bar);
            __builtin_amdgcn_fence(__ATOMIC_ACQUIRE, "agent");
            asm volatile("s_waitcnt vmcnt(0)" ::: "memory");
        }
    }
    __syncthreads();
}

#ifndef PH_MASK
#define PH_MASK 0x1ff
#endif
constexpr int DM = 1024, NB = 8, SEQ = 4096, MP = NB * SEQ;
constexpr int SB = 32, SS_ = 4, MS = SB * SS_, MV = MP + MS;
constexpr int MR = 129 * 256;
constexpr int NIN = 6400, DFF = 2816, NGU = 2 * DFF, DAO = 256;
constexpr float RMS_EPS = 1e-6f, LN_EPS = 1e-5f;
constexpr int NWAVES = 8;

constexpr size_t O_Y = 0;
constexpr size_t O_KVP0 = 33685504, O_KVS0 = 34209792, O_KVP1 = 36306944, O_KVS1 = 38404096, O_KVP2 = 46792704, O_KVS2 = 55181312;
constexpr size_t O_CONVP = 88735744, O_CONVS = 88981504, O_TOTAL = 89964544;

constexpr size_t MiB = 1u << 20;
constexpr size_t WS_CTL = 0, CTL_ZERO_BYTES = 1 * MiB;
constexpr size_t WS_W1 = 1 * MiB;
constexpr size_t WS_WATT = 14 * MiB;
constexpr size_t WS_WCO = 15 * MiB;
constexpr size_t WS_WOUT = 17 * MiB;
constexpr size_t WS_WGU = 19 * MiB;
constexpr size_t WS_WD = 30 * MiB;
constexpr size_t WS_A = 36 * MiB;
constexpr size_t WS_B = 101 * MiB;
constexpr size_t WS_GA = 166 * MiB, WS_GB = 231 * MiB;
constexpr size_t WS_Q = 296 * MiB, WS_K = 344 * MiB, WS_V = 392 * MiB;
constexpr size_t WS_OATT = 440 * MiB;
constexpr size_t WS_OG = 440 * MiB;
constexpr size_t WS_LSE = 489 * MiB;
constexpr size_t WS_SS = 491 * MiB;
constexpr size_t WS_SQ = 494 * MiB;
constexpr size_t WS_ACT = 296 * MiB;
constexpr size_t WS_END = 496 * MiB;
constexpr int CW_BAR = 4096;

constexpr int RING_BYTES = 131072, LDSCTL_OFF = RING_BYTES, MISC_OFF = LDSCTL_OFF + 320, LDS_BYTES = 147456;

typedef unsigned u32x4 __attribute__((ext_vector_type(4)));
typedef unsigned u32x2 __attribute__((ext_vector_type(2)));

struct Params {
    const float* in[20];
    float* out;
    unsigned char* ws;
    int ph_lo, ph_hi;
};

__device__ __forceinline__ float sigmoidf_(float x) { return __builtin_amdgcn_rcpf(1.0f + __expf(-x)); }
__device__ __forceinline__ float wave_sum(float v) {
#pragma unroll
    for (int o = 1; o < 64; o <<= 1) v += __shfl_xor(v, o);
    return v;
}

struct EpiP1 {
    static constexpr bool PERM = true, AFTER_DRAIN = false;
    bf16 *Q, *K, *V, *U, *GA, *GB; float* SQ; float* out; const float *qw, *kw;
    __device__ __forceinline__ void operator()(const pg8::f32x4 (&acc)[2][2][4][2], const pg8::Unit& u, int wr, int wc, int fr, int fq) const {
        const int pn = u.pn, row0 = u.pm * 256 + wr * 64 + fr;
        if (pn < 9) {
            const int seg = pn / 3, g = pn - 3 * seg, sh = 2 * g, win = 128 << sh, head = wc;
            f32x4 w[2][2];
            const float* nw = (seg == 0) ? qw : kw;
#pragma unroll
            for (int bj = 0; bj < 2; ++bj)
#pragma unroll
                for (int n = 0; n < 2; ++n) w[bj][n] = (seg < 2) ? *(const f32x4*)(nw + 32 * bj + 8 * fq + 4 * n) : (f32x4){1.f, 1.f, 1.f, 1.f};
            const float post = (seg == 0) ? 0.125f : 1.0f;
            bf16* dstb = Q + (size_t)seg * ((WS_K - WS_Q) / 2);
            const size_t okp = (g == 0) ? O_KVP0 : (g == 1) ? O_KVP1 : O_KVP2;
            const size_t oks = (g == 0) ? O_KVS0 : (g == 1) ? O_KVS1 : O_KVS2;
#pragma unroll
            for (int ai = 0; ai < 2; ++ai)
#pragma unroll
                for (int m = 0; m < 4; ++m) {
                    const int row = row0 + ai * 128 + m * 16;
                    f32x4 v[2][2];
#pragma unroll
                    for (int bj = 0; bj < 2; ++bj)
#pragma unroll
                        for (int n = 0; n < 2; ++n) v[bj][n] = acc[ai][bj][m][n];
                    if (seg < 2) {
                        float ss = 0.f;
#pragma unroll
                        for (int bj = 0; bj < 2; ++bj)
#pragma unroll
                            for (int n = 0; n < 2; ++n) { const f32x4 x = v[bj][n]; ss += (x[0] * x[0] + x[1] * x[1]) + (x[2] * x[2] + x[3] * x[3]); }
                        ss += __shfl_xor(ss, 16); ss += __shfl_xor(ss, 32);
                        const float rs = __builtin_amdgcn_rsqf(ss * (1.0f / 64.0f) + RMS_EPS) * post;
#pragma unroll
                        for (int bj = 0; bj < 2; ++bj)
#pragma unroll
                            for (int n = 0; n < 2; ++n) v[bj][n] = v[bj][n] * rs * w[bj][n];
                    }
                    if (row < MP) {
                        const int b = row >> 12, t = row & 4095;
                        const int pos = ((t & ((1 << sh) - 1)) << (12 - sh)) + (t >> sh);
                        bf16* d = dstb + ((size_t)((b * 3 + g) * 4 + head) * 4096 + pos) * 64 + 8 * fq;
#pragma unroll
                        for (int bj = 0; bj < 2; ++bj) {
                            u32x4 pk; pk.x = pg8::cvt_pk_bf16(v[bj][0][0], v[bj][0][1]); pk.y = pg8::cvt_pk_bf16(v[bj][0][2], v[bj][0][3]);
                            pk.z = pg8::cvt_pk_bf16(v[bj][1][0], v[bj][1][1]); pk.w = pg8::cvt_pk_bf16(v[bj][1][2], v[bj][1][3]);
                            *(u32x4*)(d + 32 * bj) = pk;
                        }
                        if (seg >= 1 && t >= 4096 - win) {
                            float* o = out + okp + ((size_t)(b * win + (t - (4096 - win))) * 2 + (seg - 1)) * 256 + head * 64 + 8 * fq;
#pragma unroll
                            for (int bj = 0; bj < 2; ++bj)
#pragma unroll
                                for (int n = 0; n < 2; ++n) *(f32x4*)(o + 32 * bj + 4 * n) = v[bj][n];
                        }
                    } else if (row < MV) {
                        const int si = row - MP, sb = si >> 2, s = si & 3;
                        float* o = (seg == 0) ? SQ + ((size_t)si * 12 + g * 4 + head) * 64 + 8 * fq
                                              : out + oks + ((size_t)(sb * win + win - 4 + s) * 2 + (seg - 1)) * 256 + head * 64 + 8 * fq;
#pragma unroll
                        for (int bj = 0; bj < 2; ++bj)
#pragma unroll
                            for (int n = 0; n < 2; ++n) *(f32x4*)(o + 32 * bj + 4 * n) = v[bj][n];
                    }
                }
        } else if (pn < 17) {
            const int ch0 = 128 * (pn - 9) + 32 * wc + 8 * fq;
#pragma unroll
            for (int ai = 0; ai < 2; ++ai)
#pragma unroll
                for (int m = 0; m < 4; ++m) {
                    const int row = row0 + ai * 128 + m * 16;
                    f32x4 uu[2];
#pragma unroll
                    for (int n = 0; n < 2; ++n) {
                        const f32x4 a = acc[ai][0][m][n], b = acc[ai][1][m][n];
#pragma unroll
                        for (int i = 0; i < 4; ++i) uu[n][i] = a[i] * sigmoidf_(b[i]);
                    }
                    u32x4 pk; pk.x = pg8::cvt_pk_bf16(uu[0][0], uu[0][1]); pk.y = pg8::cvt_pk_bf16(uu[0][2], uu[0][3]);
                    pk.z = pg8::cvt_pk_bf16(uu[1][0], uu[1][1]); pk.w = pg8::cvt_pk_bf16(uu[1][2], uu[1][3]);
                    *(u32x4*)(U + (size_t)row * DM + ch0) = pk;
                    float* o = nullptr;
                    if (row < MP) { const int b = row >> 12, t = row & 4095; if (t >= 4066) o = out + O_CONVP + ((size_t)(b * 30 + t - 4066)) * DM + ch0; }
                    else if (row < MV) { const int si = row - MP; o = out + O_CONVS + ((size_t)((si >> 2) * 30 + 26 + (si & 3))) * DM + ch0; }
                    if (o) { *(f32x4*)o = uu[0]; *(f32x4*)(o + 4) = uu[1]; }
                }
        } else {
            const int q = pn - 17; bf16* G = (q >> 2) ? GB : GA;
            const int col0 = 256 * (q & 3) + 32 * wc + 8 * fq;
#pragma unroll
            for (int ai = 0; ai < 2; ++ai)
#pragma unroll
                for (int m = 0; m < 4; ++m) {
                    const int row = row0 + ai * 128 + m * 16;
#pragma unroll
                    for (int bj = 0; bj < 2; ++bj) {
                        f32x4 a = acc[ai][bj][m][0], b = acc[ai][bj][m][1];
#pragma unroll
                        for (int i = 0; i < 4; ++i) { a[i] = sigmoidf_(a[i]); b[i] = sigmoidf_(b[i]); }
                        u32x4 pk; pk.x = pg8::cvt_pk_bf16(a[0], a[1]); pk.y = pg8::cvt_pk_bf16(a[2], a[3]); pk.z = pg8::cvt_pk_bf16(b[0], b[1]); pk.w = pg8::cvt_pk_bf16(b[2], b[3]);
                        *(u32x4*)(G + (size_t)row * DM + col0 + 128 * bj) = pk;
                    }
                }
        }
    }
};


__device__ __forceinline__ float bf_lo(unsigned w) { return __builtin_bit_cast(float, w << 16); }
__device__ __forceinline__ float bf_hi(unsigned w) { return __builtin_bit_cast(float, w & 0xffff0000u); }
__device__ __forceinline__ void unpack8(const u32x4 w, f32x4& a, f32x4& b) {
    a = (f32x4){bf_lo(w.x), bf_hi(w.x), bf_lo(w.y), bf_hi(w.y)}; b = (f32x4){bf_lo(w.z), bf_hi(w.z), bf_lo(w.w), bf_hi(w.w)};
}
__device__ __forceinline__ u32x4 pack8(const f32x4 a, const f32x4 b) {
    u32x4 pk; pk.x = pg8::cvt_pk_bf16(a[0], a[1]); pk.y = pg8::cvt_pk_bf16(a[2], a[3]); pk.z = pg8::cvt_pk_bf16(b[0], b[1]); pk.w = pg8::cvt_pk_bf16(b[2], b[3]); return pk;
}

struct EpiGateA {
    static constexpr bool PERM = true, AFTER_DRAIN = false;
    const bf16* GA; bf16* HA;
    __device__ __forceinline__ void operator()(const pg8::f32x4 (&acc)[2][2][4][2], const pg8::Unit& u, int wr, int wc, int fr, int fq) const {
        const int row0 = u.pm * 256 + wr * 64 + fr, col0 = u.pn * 256 + 32 * wc + 8 * fq;
#pragma unroll
        for (int ai = 0; ai < 2; ++ai)
#pragma unroll
            for (int m = 0; m < 4; ++m) {
                const size_t off = (size_t)(row0 + ai * 128 + m * 16) * DM + col0;
#pragma unroll
                for (int bj = 0; bj < 2; ++bj) {
                    f32x4 ga, gb; unpack8(*(const u32x4*)(GA + off + 128 * bj), ga, gb);
                    *(u32x4*)(HA + off + 128 * bj) = pack8(acc[ai][bj][m][0] * ga, acc[ai][bj][m][1] * gb);
                }
            }
    }
};
struct EpiGateB {
    static constexpr bool PERM = true, AFTER_DRAIN = false;
    const bf16* GB; bf16* H;
    __device__ __forceinline__ void operator()(const pg8::f32x4 (&acc)[2][2][4][2], const pg8::Unit& u, int wr, int wc, int fr, int fq) const {
        const int row0 = u.pm * 256 + wr * 64 + fr, col0 = u.pn * 256 + 32 * wc + 8 * fq;
#pragma unroll
        for (int ai = 0; ai < 2; ++ai)
#pragma unroll
            for (int m = 0; m < 4; ++m) {
                const size_t off = (size_t)(row0 + ai * 128 + m * 16) * DM + col0;
#pragma unroll
                for (int bj = 0; bj < 2; ++bj) {
                    f32x4 ga, gb, ha, hb; unpack8(*(const u32x4*)(GB + off + 128 * bj), ga, gb); unpack8(*(const u32x4*)(H + off + 128 * bj), ha, hb);
                    *(u32x4*)(H + off + 128 * bj) = pack8(acc[ai][bj][m][0] * ga + ha, acc[ai][bj][m][1] * gb + hb);
                }
            }
    }
};
struct EpiX1 {
    static constexpr bool PERM = true, AFTER_DRAIN = false;
    const float *xp, *xs; float* out; bf16* X1B; float* SS;
    __device__ __forceinline__ void operator()(const pg8::f32x4 (&acc)[2][2][4][2], const pg8::Unit& u, int wr, int wc, int fr, int fq) const {
        const int row0 = u.pm * 256 + wr * 64 + fr, col0 = u.pn * 256 + 32 * wc + 8 * fq;
#pragma unroll
        for (int ai = 0; ai < 2; ++ai)
#pragma unroll
            for (int m = 0; m < 4; ++m) {
                const int row = row0 + ai * 128 + m * 16;
                const bool valid = row < MV;
                const float* xr = (row < MP) ? xp + (size_t)row * DM + col0 : xs + (size_t)(row - MP) * DM + col0;
                float ss = 0.f;
#pragma unroll
                for (int bj = 0; bj < 2; ++bj) {
                    f32x4 v[2];
#pragma unroll
                    for (int n = 0; n < 2; ++n) {
                        f32x4 xv = (f32x4){0.f, 0.f, 0.f, 0.f};
                        if (valid) xv = *(const f32x4*)(xr + 128 * bj + 4 * n);
                        v[n] = xv + acc[ai][bj][m][n];
                        ss += (v[n][0] * v[n][0] + v[n][1] * v[n][1]) + (v[n][2] * v[n][2] + v[n][3] * v[n][3]);
                        if (valid) *(f32x4*)(out + (size_t)row * DM + col0 + 128 * bj + 4 * n) = v[n];
                    }
                    *(u32x4*)(X1B + (size_t)row * DM + col0 + 128 * bj) = pack8(v[0], v[1]);
                }
                ss += __shfl_xor(ss, 16); ss += __shfl_xor(ss, 32);
                if (fq == 0) SS[(size_t)row * 16 + u.pn * 4 + wc] = ss;
            }
    }
};
struct EpiAct {
    static constexpr bool PERM = true, AFTER_DRAIN = false;
    const float* SS; bf16* ACT;
    __device__ __forceinline__ void operator()(const pg8::f32x4 (&acc)[2][2][4][2], const pg8::Unit& u, int wr, int wc, int fr, int fq) const {
        const int row0 = u.pm * 256 + wr * 64 + fr, ch0 = u.pn * 128 + 32 * wc + 8 * fq;
#pragma unroll
        for (int ai = 0; ai < 2; ++ai)
#pragma unroll
            for (int m = 0; m < 4; ++m) {
                const int row = row0 + ai * 128 + m * 16;
                const f32x4* sp = (const f32x4*)(SS + (size_t)row * 16);
                const f32x4 s0 = sp[0], s1 = sp[1], s2 = sp[2], s3 = sp[3];
                const float tot = ((s0[0] + s0[1]) + (s0[2] + s0[3])) + ((s1[0] + s1[1]) + (s1[2] + s1[3])) + ((s2[0] + s2[1]) + (s2[2] + s2[3])) + ((s3[0] + s3[1]) + (s3[2] + s3[3]));
                const float rstd = __builtin_amdgcn_rsqf(tot * (1.0f / DM) + RMS_EPS);
                f32x4 a[2];
#pragma unroll
                for (int n = 0; n < 2; ++n)
#pragma unroll
                    for (int i = 0; i < 4; ++i) { const float g = acc[ai][0][m][n][i] * rstd, up = acc[ai][1][m][n][i] * rstd; a[n][i] = g * sigmoidf_(g) * up; }
                *(u32x4*)(ACT + (size_t)row * DFF + ch0) = pack8(a[0], a[1]);
            }
    }
};
struct EpiOut {
    static constexpr bool PERM = true, AFTER_DRAIN = false;
    float* out;
    __device__ __forceinline__ void operator()(const pg8::f32x4 (&acc)[2][2][4][2], const pg8::Unit& u, int wr, int wc, int fr, int fq) const {
        const int row0 = u.pm * 256 + wr * 64 + fr, col0 = u.pn * 256 + 32 * wc + 8 * fq;
#pragma unroll
        for (int ai = 0; ai < 2; ++ai)
#pragma unroll
            for (int m = 0; m < 4; ++m) {
                const int row = row0 + ai * 128 + m * 16;
                if (row < MV) {
                    float* o = out + (size_t)row * DM + col0;
#pragma unroll
                    for (int bj = 0; bj < 2; ++bj)
#pragma unroll
                        for (int n = 0; n < 2; ++n) { const f32x4 x1 = *(const f32x4*)(o + 128 * bj + 4 * n); *(f32x4*)(o + 128 * bj + 4 * n) = x1 + acc[ai][bj][m][n]; }
                }
            }
    }
};

__device__ __forceinline__ void attn_simple_prompt(const Params& p, LAS float* sS, int gw, int NGW, int lane) {
    unsigned char* ws = p.ws;
    const bf16* Q = (const bf16*)(ws + WS_Q); const bf16* K = (const bf16*)(ws + WS_K); const bf16* V = (const bf16*)(ws + WS_V);
    bf16* OATT = (bf16*)(ws + WS_OATT);
    for (int it = gw; it < MP * 4; it += NGW) {
        const int row = it >> 2, j = it & 3, b = row >> 12, t = row & 4095;
        float mx = -1e30f;
#pragma unroll 1
        for (int g = 0; g < 3; ++g) {
            const int sh = 2 * g, nidx = t >> sh, pos = ((t & ((1 << sh) - 1)) << (12 - sh)) + nidx;
            const size_t hb = ((size_t)((b * 3 + g) * 4 + j) * 4096) * 64;
            const u32x4* qp = (const u32x4*)(Q + hb + (size_t)pos * 64);
            f32x4 q[16];
#pragma unroll
            for (int c = 0; c < 8; ++c) unpack8(qp[c], q[2 * c], q[2 * c + 1]);
#pragma unroll 1
            for (int c = 0; c < 3; ++c) {
                const int jj = lane + 64 * c;
                const bool valid = (jj <= 128) && (jj <= nidx);
                float d = 0.f;
                if (valid) {
                    const u32x4* kp = (const u32x4*)(K + hb + (size_t)(pos - jj) * 64);
#pragma unroll
                    for (int c8 = 0; c8 < 8; ++c8) { f32x4 ka, kb; unpack8(kp[c8], ka, kb); const f32x4 pa = ka * q[2 * c8], pb = kb * q[2 * c8 + 1]; d += ((pa[0] + pa[1]) + (pa[2] + pa[3])) + ((pb[0] + pb[1]) + (pb[2] + pb[3])); }
                }
                d = valid ? d : -1e30f;
                sS[g * 192 + jj] = d;
                mx = fmaxf(mx, d);
            }
        }
#pragma unroll
        for (int o = 1; o < 64; o <<= 1) mx = fmaxf(mx, __shfl_xor(mx, o));
        LDS_WAIT();
        float l = 0.f;
#pragma unroll 1
        for (int e = lane; e < 576; e += 64) { const float v = sS[e]; const float pe = (v > -1e29f) ? __expf(v - mx) : 0.f; sS[e] = pe; l += pe; }
        l = wave_sum(l);
        LDS_WAIT();
        float o = 0.f;
#pragma unroll 1
        for (int g = 0; g < 3; ++g) {
            const int sh = 2 * g, nidx = t >> sh, pos = ((t & ((1 << sh) - 1)) << (12 - sh)) + nidx;
            const bf16* vp = V + ((size_t)((b * 3 + g) * 4 + j) * 4096) * 64 + lane;
            const int nk = (nidx < 128) ? nidx + 1 : 129;
#pragma unroll 4
            for (int jj = 0; jj < nk; ++jj) o += sS[g * 192 + jj] * bf_lo((unsigned)vp[(size_t)(pos - jj) * 64]);
        }
        OATT[(size_t)row * DAO + j * 64 + lane] = (bf16)f2bf(o / l);
        LDS_WAIT();
    }
}
__device__ __forceinline__ void attn_simple_sample(const Params& p, LAS float* sS, int gw, int NGW, int lane) {
    unsigned char* ws = p.ws;
    const float* SQ = (const float*)(ws + WS_SQ);
    bf16* OATT = (bf16*)(ws + WS_OATT);
    for (int it = gw; it < MS * 4; it += NGW) {
        const int si = it >> 2, j = it & 3, b = si >> 2, s = si & 3;
        float mx = -1e30f;
#pragma unroll 1
        for (int g = 0; g < 3; ++g) {
            const int sh = 2 * g, win = 128 << sh;
            const float* cache = p.in[2 + g];
            const float* newr = p.out + ((g == 0) ? O_KVS0 : (g == 1) ? O_KVS1 : O_KVS2);
            const f32x4* qp = (const f32x4*)(SQ + ((size_t)si * 12 + g * 4 + j) * 64);
            f32x4 q[16];
#pragma unroll
            for (int c = 0; c < 16; ++c) q[c] = qp[c];
#pragma unroll 1
            for (int c = 0; c < 3; ++c) {
                const int jj = lane + 64 * c;
                const bool valid = (jj <= 128);
                float d = 0.f;
                if (valid) {
                    const int idx = win + s - (jj << sh);
                    const float* kr = (idx < win) ? cache + ((size_t)(b * win + idx) * 2 + 0) * 256 + j * 64 : newr + ((size_t)(b * win + idx - 4) * 2 + 0) * 256 + j * 64;
#pragma unroll
                    for (int c16 = 0; c16 < 16; ++c16) { const f32x4 pa = *((const f32x4*)kr + c16) * q[c16]; d += (pa[0] + pa[1]) + (pa[2] + pa[3]); }
                }
                d = valid ? d : -1e30f;
                sS[g * 192 + jj] = d;
                mx = fmaxf(mx, d);
            }
        }
#pragma unroll
        for (int o = 1; o < 64; o <<= 1) mx = fmaxf(mx, __shfl_xor(mx, o));
        LDS_WAIT();
        float l = 0.f;
#pragma unroll 1
        for (int e = lane; e < 576; e += 64) { const float v = sS[e]; const float pe = (v > -1e29f) ? __expf(v - mx) : 0.f; sS[e] = pe; l += pe; }
        l = wave_sum(l);
        LDS_WAIT();
        float o = 0.f;
#pragma unroll 1
        for (int g = 0; g < 3; ++g) {
            const int sh = 2 * g, win = 128 << sh;
            const float* cache = p.in[2 + g];
            const float* newr = p.out + ((g == 0) ? O_KVS0 : (g == 1) ? O_KVS1 : O_KVS2);
#pragma unroll 4
            for (int jj = 0; jj < 129; ++jj) {
                const int idx = win + s - (jj << sh);
                const float* vr = (idx < win) ? cache + ((size_t)(b * win + idx) * 2 + 1) * 256 + j * 64 : newr + ((size_t)(b * win + idx - 4) * 2 + 1) * 256 + j * 64;
                o += sS[g * 192 + jj] * vr[lane];
            }
        }
        OATT[(size_t)(MP + si) * DAO + j * 64 + lane] = (bf16)f2bf(o / l);
        LDS_WAIT();
    }
}
__device__ __forceinline__ void conv_simple(const Params& p, LAS unsigned char* lds, int vcu, int G, int tid, int wave, int lane) {
    unsigned char* ws = p.ws;
    const bf16* U = (const bf16*)(ws + WS_B); bf16* CACT = (bf16*)(ws + WS_A);
    LAS float* red = (LAS float*)lds;
    const int ch = 2 * tid;
    float w0[31], w1[31];
#pragma unroll
    for (int i = 0; i < 31; ++i) { const float* wp = p.in[11] + (size_t)i * DM + ch; w0[i] = wp[0]; w1[i] = wp[1]; }
    const float b0 = p.in[12][ch], b1 = p.in[12][ch + 1], lw0 = p.in[13][ch], lw1 = p.in[13][ch + 1], lb0 = p.in[14][ch], lb1 = p.in[14][ch + 1];
    for (int row = vcu; row < MV; row += G) {
        float c0 = b0, c1 = b1;
        if (row < MP) {
            const int t = row & 4095;
#pragma unroll
            for (int i = 0; i < 31; ++i) {
                const int tt = t - 30 + i;
                if (tt >= 0) { const unsigned w = *(const unsigned*)(U + (size_t)(row - 30 + i) * DM + ch); c0 += w0[i] * bf_lo(w); c1 += w1[i] * bf_hi(w); }
            }
        } else {
            const int si = row - MP, b = si >> 2, s = si & 3;
#pragma unroll
            for (int i = 0; i < 31; ++i) {
                const int e = s + i;
                float u0, u1;
                if (e < 30) { const float* sp = p.in[5] + ((size_t)b * 30 + e) * DM + ch; u0 = sp[0]; u1 = sp[1]; }
                else { const unsigned w = *(const unsigned*)(U + (size_t)(MP + b * 4 + (e - 30)) * DM + ch); u0 = bf_lo(w); u1 = bf_hi(w); }
                c0 += w0[i] * u0; c1 += w1[i] * u1;
            }
        }
        float s1 = wave_sum(c0 + c1);
        __syncthreads();
        if (lane == 0) red[wave] = s1;
        __syncthreads();
        float tot = 0.f;
#pragma unroll
        for (int w = 0; w < 8; ++w) tot += red[w];
        const float mean = tot * (1.0f / DM);
        const float d0 = c0 - mean, d1 = c1 - mean;
        float s2 = wave_sum(d0 * d0 + d1 * d1);
        if (lane == 0) red[16 + wave] = s2;
        __syncthreads();
        float tq = 0.f;
#pragma unroll
        for (int w = 0; w < 8; ++w) tq += red[16 + w];
        const float rstd = __builtin_amdgcn_rsqf(tq * (1.0f / DM) + LN_EPS);
        float y0 = d0 * rstd * lw0 + lb0, y1 = d1 * rstd * lw1 + lb1;
        y0 = y0 * sigmoidf_(y0); y1 = y1 * sigmoidf_(y1);
        *(unsigned*)(CACT + (size_t)row * DM + ch) = pg8::cvt_pk_bf16(y0, y1);
    }
    __syncthreads();
}

__device__ __forceinline__ void tr_item(const float* W, int ldw, int K, bf16* WT, int k0, int pos0, int src0, const float* ksc, LAS float* scr, int lane) {
#pragma unroll 8
    for (int i = 0; i < 32; ++i) { const int kk = 2 * i + (lane >> 5); float v = W[(size_t)(k0 + kk) * ldw + src0 + (lane & 31)]; if (ksc) v *= ksc[k0 + kk]; scr[kk * 33 + (lane & 31)] = v; }
    LDS_WAIT(); asm volatile("" ::: "memory");
    const int c = lane & 7;
#pragma unroll
    for (int j = 0; j < 4; ++j) { const int n = (lane >> 3) + 8 * j; const LAS float* s = scr + (8 * c) * 33 + n;
        v4u o; o.x = pk2(s[0 * 33], s[1 * 33]); o.y = pk2(s[2 * 33], s[3 * 33]); o.z = pk2(s[4 * 33], s[5 * 33]); o.w = pk2(s[6 * 33], s[7 * 33]);
        *(GAS v4u*)(WT + (size_t)(pos0 + n) * K + k0 + 8 * c) = o; }
    LDS_WAIT(); asm volatile("" ::: "memory");
}
__device__ __forceinline__ int w1_src(int pos0) {
    const int pn = pos0 >> 8, p = pos0 & 255;
    if (pn < 9) { const int seg = pn / 3, g = pn - 3 * seg; return seg * 768 + g * 256 + 64 * ((p >> 5) & 3) + 32 * (p >> 7); }
    if (pn < 17) { return ((p < 128) ? 2304 : 3328) + 128 * (pn - 9) + (p & 127); }
    return pos0;
}
__device__ __forceinline__ int wgu_src(int pos0) { const int pn = pos0 >> 8, p = pos0 & 255; return ((p < 128) ? 0 : DFF) + 128 * pn + (p & 127); }

__device__ __forceinline__ void copy_rows(const float* src, float* dst, int rows, int per, int rw, int gt, int NGT) {
    const int n4b = rows * rw, tot = SB * n4b;
    for (int i = gt; i < tot; i += NGT) {
        const int b = i / n4b, r = i - b * n4b;
        const f32x4 v = *((const GAS f32x4*)src + (size_t)b * per * rw + 4 * rw + r);
        *((GAS f32x4*)dst + (size_t)b * per * rw + r) = v;
    }
}
__device__ __forceinline__ void p0_prologue(const Params& p, LAS unsigned char* lds, int vcu, int G, int wave, int lane) {
    unsigned char* ws = p.ws;
    LAS float* scr = (LAS float*)(lds + wave * 16384);
    const int gw = vcu * NWAVES + wave, NGW = G * NWAVES;
    constexpr int I_W1 = 16 * (NIN / 32), I_ATT = 4 * 32, I_CO = 16 * 32, I_OUT = 16 * 32, I_GU = 16 * (NGU / 32), I_D = (DFF / 64) * 32;
    constexpr int NITEMS = I_W1 + I_ATT + I_CO + I_OUT + I_GU + I_D;
    for (int it = gw; it < NITEMS; it += NGW) {
        int r = it;
        if (r < I_W1) { const int nb = r % (NIN / 32), kb = r / (NIN / 32); tr_item(p.in[7], NIN, DM, (bf16*)(ws + WS_W1), 64 * kb, 32 * nb, w1_src(32 * nb), nullptr, scr, lane); continue; } r -= I_W1;
        if (r < I_ATT) { const int nb = r % 32, kb = r / 32; tr_item(p.in[10], DM, DAO, (bf16*)(ws + WS_WATT), 64 * kb, 32 * nb, 32 * nb, nullptr, scr, lane); continue; } r -= I_ATT;
        if (r < I_CO) { const int nb = r % 32, kb = r / 32; tr_item(p.in[15], DM, DM, (bf16*)(ws + WS_WCO), 64 * kb, 32 * nb, 32 * nb, nullptr, scr, lane); continue; } r -= I_CO;
        if (r < I_OUT) { const int nb = r % 32, kb = r / 32; tr_item(p.in[16], DM, DM, (bf16*)(ws + WS_WOUT), 64 * kb, 32 * nb, 32 * nb, nullptr, scr, lane); continue; } r -= I_OUT;
        if (r < I_GU) { const int nb = r % (NGU / 32), kb = r / (NGU / 32); tr_item(p.in[18], NGU, DM, (bf16*)(ws + WS_WGU), 64 * kb, 32 * nb, wgu_src(32 * nb), p.in[17], scr, lane); continue; } r -= I_GU;
        { const int nb = r % 32, kb = r / 32; tr_item(p.in[19], DM, DFF, (bf16*)(ws + WS_WD), 64 * kb, 32 * nb, 32 * nb, nullptr, scr, lane); }
    }
    bf16* XN = (bf16*)(ws + WS_A);
    const float* nw = p.in[6];
    f32x4 wv[4];
#pragma unroll
    for (int j = 0; j < 4; ++j) wv[j] = *((const f32x4*)nw + lane + 64 * j);
    for (int m = gw; m < MR; m += NGW) {
        GAS unsigned long long* o8 = (GAS unsigned long long*)(XN + (size_t)m * DM) + lane;
        if (m >= MV) {
#pragma unroll
            for (int j = 0; j < 4; ++j) o8[64 * j] = 0ull;
            continue;
        }
        const float* xrow = (m < MP) ? p.in[0] + (size_t)m * DM : p.in[1] + (size_t)(m - MP) * DM;
        const GAS f32x4* xr = (const GAS f32x4*)xrow + lane;
        f32x4 v[4]; float s = 0.f;
#pragma unroll
        for (int j = 0; j < 4; ++j) { v[j] = xr[64 * j]; s += (v[j].x * v[j].x + v[j].y * v[j].y) + (v[j].z * v[j].z + v[j].w * v[j].w); }
        const float rstd = __builtin_amdgcn_rsqf(wave_sum(s) * (1.f / DM) + RMS_EPS);
#pragma unroll
        for (int j = 0; j < 4; ++j) { const f32x4 y = v[j] * rstd * wv[j]; o8[64 * j] = (unsigned long long)pk2(y.x, y.y) | ((unsigned long long)pk2(y.z, y.w) << 32); }
    }
    {
        const int gt = vcu * (NWAVES * 64) + wave * 64 + lane, NGT = G * NWAVES * 64;
        copy_rows(p.in[2], p.out + O_KVS0, 124, 128, 128, gt, NGT);
        copy_rows(p.in[3], p.out + O_KVS1, 508, 512, 128, gt, NGT);
        copy_rows(p.in[4], p.out + O_KVS2, 2044, 2048, 128, gt, NGT);
        copy_rows(p.in[5], p.out + O_CONVS, 26, 30, 256, gt, NGT);
    }
}

__global__ void __launch_bounds__(NWAVES * 64, 2) fwd_kernel(Params p) {
    extern __shared__ __attribute__((aligned(16))) unsigned char lds_raw[];
    LAS unsigned char* lds = (LAS unsigned char*)lds_raw;
    volatile LAS unsigned* MISC = (volatile LAS unsigned*)(lds + MISC_OFF);
    const int tid = threadIdx.x, lane = tid & 63, wave = __builtin_amdgcn_readfirstlane(tid >> 6);
    const int G = gridDim.x; const int bx = blockIdx.x; const int vcu = (G % 8 == 0) ? (bx % 8) * (G / 8) + bx / 8 : bx;
    unsigned char* ws = p.ws;
    gu32* ctl = (gu32*)(ws + WS_CTL);
    for (int u = tid; u < (LDS_BYTES - LDSCTL_OFF) / 4; u += NWAVES * 64) ((LAS unsigned*)(lds + LDSCTL_OFF))[u] = 0u;
    __syncthreads();
    XcdBarrier bar = xcd_barrier_post((unsigned*)(ctl + CW_BAR), MISC + 8);
    const int lo = p.ph_lo, hi = p.ph_hi;
#define IN(k) (lo <= (k) && (k) < hi)
#define BOTH(k) (IN(k) && IN((k) + 1))

#if PH_MASK & 1
    if (IN(0)) { p0_prologue(p, lds, vcu, G, wave, lane); if (BOTH(0)) xcd_barrier(bar); }
#endif

#if PH_MASK & (1 << 1)
    if (IN(1)) {
        pg8::Gemm g{(const bf16*)(ws + WS_A), (const bf16*)(ws + WS_W1), MR, NIN, DM}; pg8::StaticOrder S; S.init(MR, NIN, G, bx);
        EpiP1 E{(bf16*)(ws + WS_Q), (bf16*)(ws + WS_K), (bf16*)(ws + WS_V), (bf16*)(ws + WS_B), (bf16*)(ws + WS_GA), (bf16*)(ws + WS_GB), (float*)(ws + WS_SQ), p.out, p.in[8], p.in[9]};
        pg8::gemm_phase<EpiP1, pg8::StaticOrder, true, true>(lds, g, S, E);
        if (BOTH(1)) xcd_barrier(bar);
    }
#endif

#if PH_MASK & (1 << 2)
    if (IN(2)) {
        conv_simple(p, lds, vcu, G, tid, wave, lane);
        if (BOTH(2)) xcd_barrier(bar);
    }
#endif
#if PH_MASK & (1 << 3)
    if (IN(3)) {
        const int gw = vcu * NWAVES + wave, NGW = G * NWAVES;
        LAS float* sS = (LAS float*)(lds + wave * 4096);
        attn_simple_prompt(p, sS, gw, NGW, lane);
        attn_simple_sample(p, sS, gw, NGW, lane);
        __syncthreads();
        if (BOTH(3)) xcd_barrier(bar);
    }
#endif
#if PH_MASK & (1 << 4)
    if (IN(4)) {
        pg8::Gemm g{(const bf16*)(ws + WS_OATT), (const bf16*)(ws + WS_WATT), MR, DM, DAO}; pg8::StaticOrder S; S.init(MR, DM, G, bx);
        EpiGateA E{(const bf16*)(ws + WS_GA), (bf16*)(ws + WS_B)};
        pg8::gemm_phase<EpiGateA, pg8::StaticOrder, true, true>(lds, g, S, E);
        if (BOTH(4)) xcd_barrier(bar);
    }
#endif
#if PH_MASK & (1 << 5)
    if (IN(5)) {
        pg8::Gemm g{(const bf16*)(ws + WS_A), (const bf16*)(ws + WS_WCO), MR, DM, DM}; pg8::StaticOrder S; S.init(MR, DM, G, bx);
        EpiGateB E{(const bf16*)(ws + WS_GB), (bf16*)(ws + WS_B)};
        pg8::gemm_phase<EpiGateB, pg8::StaticOrder, true, true>(lds, g, S, E);
        if (BOTH(5)) xcd_barrier(bar);
    }
#endif
#if PH_MASK & (1 << 6)
    if (IN(6)) {
        pg8::Gemm g{(const bf16*)(ws + WS_B), (const bf16*)(ws + WS_WOUT), MR, DM, DM}; pg8::StaticOrder S; S.init(MR, DM, G, bx);
        EpiX1 E{p.in[0], p.in[1], p.out, (bf16*)(ws + WS_A), (float*)(ws + WS_SS)};
        pg8::gemm_phase<EpiX1, pg8::StaticOrder, true, true>(lds, g, S, E);
        if (BOTH(6)) xcd_barrier(bar);
    }
#endif
#if PH_MASK & (1 << 7)
    if (IN(7)) {
        pg8::Gemm g{(const bf16*)(ws + WS_A), (const bf16*)(ws + WS_WGU), MR, NGU, DM}; pg8::StaticOrder S; S.init(MR, NGU, G, bx);
        EpiAct E{(const float*)(ws + WS_SS), (bf16*)(ws + WS_ACT)};
        pg8::gemm_phase<EpiAct, pg8::StaticOrder, true, true>(lds, g, S, E);
        if (BOTH(7)) xcd_barrier(bar);
    }
#endif
#if PH_MASK & (1 << 8)
    if (IN(8)) {
        pg8::Gemm g{(const bf16*)(ws + WS_ACT), (const bf16*)(ws + WS_WD), MR, DM, DFF}; pg8::StaticOrder S; S.init(MR, DM, G, bx);
        EpiOut E{p.out};
        pg8::gemm_phase<EpiOut, pg8::StaticOrder, true, true>(lds, g, S, E);
    }
#endif
#undef IN
#undef BOTH
}

extern "C" void kernel_launch(void* const* d_in, const int* in_sizes, int n_in, void* d_out, int out_size, void* d_ws, size_t ws_size, hipStream_t stream) {
    static int grid = 0;
    if (grid == 0) {
        if (n_in != 20 || (size_t)out_size != O_TOTAL || ws_size < WS_END) { fprintf(stderr, "kernel_launch: unexpected sizes n_in %d out %d ws %zu\n", n_in, out_size, ws_size); grid = -1; return; }
        int dev = 0, cus = 0, per_cu = 0;
        if (hipGetDevice(&dev) != hipSuccess || hipDeviceGetAttribute(&cus, hipDeviceAttributeMultiprocessorCount, dev) != hipSuccess) { grid = -1; return; }
        if (hipFuncSetAttribute((const void*)fwd_kernel, hipFuncAttributeMaxDynamicSharedMemorySize, LDS_BYTES) != hipSuccess) { fprintf(stderr, "kernel_launch: hipFuncSetAttribute failed\n"); grid = -1; return; }
        if (hipOccupancyMaxActiveBlocksPerMultiprocessor(&per_cu, (const void*)fwd_kernel, NWAVES * 64, LDS_BYTES) != hipSuccess || per_cu < 1)
            fprintf(stderr, "kernel_launch: occupancy query reports %d\n", per_cu);
        (void)hipGetLastError();
        grid = cus;
    }
    if (grid < 0) return;
    if (hipMemsetAsync((char*)d_ws + WS_CTL, 0, CTL_ZERO_BYTES, stream) != hipSuccess) return;
    Params a{};
    for (int i = 0; i < 20; ++i) a.in[i] = (const float*)d_in[i];
    a.out = (float*)d_out; a.ws = (unsigned char*)d_ws; a.ph_lo = 0; a.ph_hi = 16;
    hipLaunchKernelGGL(fwd_kernel, dim3(grid), dim3(NWAVES * 64), LDS_BYTES, stream, a);
}
```

```cpp
#include <hip/hip_runtime.h>
#include <cstdio>
#include <cstdint>
namespace pg8 {
#define PG8_LAS __attribute__((address_space(3)))
typedef unsigned short bf16_t;
typedef short bf16x8 __attribute__((ext_vector_type(8)));
typedef float f32x4 __attribute__((ext_vector_type(4)));
typedef unsigned u32x4 __attribute__((ext_vector_type(4)));
constexpr int BM = 256, BK = 64, HALF = 128, HTB = HALF * BK * 2  , STAGE_BYTES = 8 * HTB, NXCD = 8, WGM = 8;

__host__ __device__ __forceinline__ int lds_byte(int r, int c) { const int st = (r >> 4) * 2 + (c >> 5), rr = r & 15, cc = c & 31, ob = rr * 64 + cc * 2; return st * 1024 + (ob ^ (((ob >> 9) & 1) << 5)); }
__host__ __device__ __forceinline__ void stage_rc(int b, int& R, int& C) { const int st = b / 1024, sb = b % 1024, swz = sb ^ (((sb >> 9) & 1) << 5); R = (st >> 1) * 16 + swz / 64; C = (st & 1) * 32 + (swz % 64) / 2; }
__host__ __device__ __forceinline__ int perm32(int rho) { const int n = rho >> 4, i = rho & 15; return 8 * (i >> 2) + 4 * n + (i & 3); }

struct Unit { int pm, pn; };
struct Gemm { const bf16_t* A; const bf16_t* Bt; int M, N, K; };

struct StaticOrder {
    int nM, nN, nwg, G, c;
    __host__ __device__ void init(int M, int N, int G_, int c_) { nM = M / BM; nN = N / BM; nwg = nM * nN; G = G_; c = c_; }
    __host__ __device__ bool next(int i, Unit& u) const {
        const long L = (long)i * G + c; if (L >= nwg) return false;
        int wgid = (int)L; { const int q = nwg / NXCD, r = nwg % NXCD, xcd = wgid % NXCD, off = wgid / NXCD; wgid = (xcd < r ? xcd * (q + 1) : r * (q + 1) + (xcd - r) * q) + off; }
        const int nig = WGM * nN, gid = wgid / nig, fm = gid * WGM, gsz = (nM - fm) < WGM ? (nM - fm) : WGM;
        u.pm = fm + ((wgid % nig) % gsz); u.pn = (wgid % nig) / gsz; return true;
    }
    __device__ __forceinline__ void a_ready(const Unit&) const {}
    __device__ __forceinline__ void done(const Unit&) const {}
};
typedef float f32x2_cv __attribute__((ext_vector_type(2))); typedef __bf16 bf16x2_cv __attribute__((ext_vector_type(2)));
__device__ __forceinline__ unsigned cvt_pk_bf16(float lo, float hi) { f32x2_cv v = {lo, hi}; bf16x2_cv b = __builtin_convertvector(v, bf16x2_cv); return __builtin_bit_cast(unsigned, b); }
typedef float f32x2 __attribute__((ext_vector_type(2)));
template <class Epi, class Sched, bool ALIGN_EPI = false, bool SP2 = false>
__device__ __forceinline__ void gemm_phase(PG8_LAS unsigned char* lds, const Gemm g, const Sched& S, const Epi& E) {
    const int tid = threadIdx.x, wid = __builtin_amdgcn_readfirstlane(tid >> 6), lane = tid & 63, wr = wid >> 2, wc = wid & 3, fr = lane & 15, fq = lane >> 4;
    const int K = g.K, nt = K / BK;
    unsigned voffA[2], voffB[2];
#pragma unroll
    for (int i = 0; i < 2; ++i) { int R, C; stage_rc(tid * 16 + i * 8192, R, C); const int Rb = Epi::PERM ? ((R & ~31) + perm32(R & 31)) : R;
        voffA[i] = (unsigned)(R * K + C) * 2u; voffB[i] = (unsigned)(Rb * K + C) * 2u; }
    const size_t kstep = (size_t)(BK * 2);
    const size_t hstep = (size_t)HALF * K * 2;
    const size_t tstep = 2 * hstep;
    const unsigned ldsw = (unsigned)wid * 1024u;
    const int aoff = lds_byte(wr * 64 + fr, fq * 8), boff = lds_byte(wc * 32 + fr, fq * 8);
#define PG8_SA(b, h) (((b) * 2 + (h)) * HTB)
#define PG8_SB(b, h) ((4 + (b) * 2 + (h)) * HTB)
#define PG8_STAGE(bufoff, gbase, voff) do { _Pragma("unroll") for (int _i = 0; _i < 2; ++_i) \
        __builtin_amdgcn_global_load_lds((const unsigned*)((const char*)(gbase) + (voff)[_i]), (PG8_LAS unsigned*)(lds + (bufoff) + ldsw + _i * 8192), 16, 0, 0); } while (0)
#define PG8_LDA(dst, b, h) do { _Pragma("unroll") for (int m = 0; m < 4; ++m) _Pragma("unroll") for (int k = 0; k < 2; ++k) dst[m][k] = *(const PG8_LAS bf16x8*)(lds + PG8_SA(b, h) + aoff + m * 2048 + k * 1024); } while (0)
#define PG8_LDB(dst, b, h) do { _Pragma("unroll") for (int n = 0; n < 2; ++n) _Pragma("unroll") for (int k = 0; k < 2; ++k) dst[n][k] = *(const PG8_LAS bf16x8*)(lds + PG8_SB(b, h) + boff + n * 2048 + k * 1024); } while (0)
#define PG8_MMA(ai, bj, At, Bt) do { __builtin_amdgcn_s_setprio(1); _Pragma("unroll") for (int m = 0; m < 4; ++m) _Pragma("unroll") for (int n = 0; n < 2; ++n) _Pragma("unroll") for (int k = 0; k < 2; ++k) \
        acc[ai][bj][m][n] = __builtin_amdgcn_mfma_f32_16x16x32_bf16(Bt[n][k], At[m][k], acc[ai][bj][m][n], 0, 0, 0); __builtin_amdgcn_s_setprio(0); } while (0)
#define PG8_WAIT_V(n) asm volatile("s_waitcnt vmcnt(" #n ")" ::: "memory")
#define PG8_WAIT_L(n) asm volatile("s_waitcnt lgkmcnt(" #n ")" ::: "memory")
#define PG8_BAR __builtin_amdgcn_s_barrier()
#define PG8_SCHED __builtin_amdgcn_sched_barrier(0)
    Unit cur, nxt; int ui = 0;
    if (!S.next(0, cur)) return;
    f32x4 acc[2][2][4][2];
#pragma unroll
    for (int a = 0; a < 2; ++a)
#pragma unroll
        for (int b = 0; b < 2; ++b)
#pragma unroll
            for (int m = 0; m < 4; ++m)
#pragma unroll
                for (int n = 0; n < 2; ++n) acc[a][b][m][n] = (f32x4){0.f, 0.f, 0.f, 0.f};
    bf16x8 At[4][2], B0[2][2], B1[2][2];
    const char* cA = (const char*)g.A + (size_t)cur.pm * tstep; const char* cB = (const char*)g.Bt + (size_t)cur.pn * tstep;
    S.a_ready(cur);
    if constexpr (SP2) {
        PG8_STAGE(PG8_SB(0, 0), cB, voffB); PG8_STAGE(PG8_SB(0, 1), cB + hstep, voffB); PG8_STAGE(PG8_SA(0, 0), cA, voffA); PG8_STAGE(PG8_SA(0, 1), cA + hstep, voffA);
        if (wr == 1) PG8_BAR;
        PG8_WAIT_V(2); PG8_BAR;
        PG8_STAGE(PG8_SB(1, 0), cB + kstep, voffB); PG8_STAGE(PG8_SA(1, 0), cA + kstep, voffA); PG8_STAGE(PG8_SB(1, 1), cB + hstep + kstep, voffB);
        PG8_WAIT_V(6); PG8_BAR;
    } else {
        PG8_STAGE(PG8_SB(0, 0), cB, voffB); PG8_STAGE(PG8_SA(0, 0), cA, voffA); PG8_STAGE(PG8_SB(0, 1), cB + hstep, voffB); PG8_STAGE(PG8_SA(0, 1), cA + hstep, voffA);
        if (wr == 1) PG8_BAR;
        PG8_WAIT_V(4); PG8_BAR;
        PG8_STAGE(PG8_SB(1, 0), cB + kstep, voffB); PG8_STAGE(PG8_SA(1, 0), cA + kstep, voffA); PG8_STAGE(PG8_SB(1, 1), cB + hstep + kstep, voffB);
        PG8_WAIT_V(6); PG8_BAR;
    }
    for (;;) {
        const bool has_next = S.next(ui + 1, nxt);
        const char* nA = has_next ? (const char*)g.A + (size_t)nxt.pm * tstep : cA; const char* nB = has_next ? (const char*)g.Bt + (size_t)nxt.pn * tstep : cB;
        if constexpr (Epi::HAS_MID) {
            int tmid = Epi::MID_T; asm volatile("" : "+s"(tmid));
#pragma unroll 1
            for (int t = 0; t < tmid; t += 2) {
            { const bool last = false;
            asm volatile("" : "+s"(cA), "+s"(cB));
            const char* a1 = cA + (size_t)(t + 1) * kstep;
            const char* a2 = last ? nA : cA + (size_t)(t + 2) * kstep; const char* b2 = last ? nB : cB + (size_t)(t + 2) * kstep;
            const char* a3 = a2 + kstep; const char* b3 = b2 + kstep;
            if (last && has_next) S.a_ready(nxt);
            PG8_LDB(B0, 0, 0); PG8_LDB(B1, 0, 1); PG8_SCHED; PG8_LDA(At, 0, 0); PG8_STAGE(PG8_SA(1, 1), a1 + hstep, voffA);
            PG8_WAIT_V(8); PG8_WAIT_L(0); PG8_BAR; PG8_MMA(0, 0, At, B0); PG8_MMA(0, 1, At, B1); PG8_BAR; PG8_SCHED;
            PG8_LDA(At, 0, 1); PG8_STAGE(PG8_SB(0, 0), b2, voffB); PG8_STAGE(PG8_SB(0, 1), b2 + hstep, voffB); PG8_STAGE(PG8_SA(0, 0), a2, voffA);
            PG8_WAIT_V(8); PG8_WAIT_L(0); PG8_BAR; PG8_MMA(1, 0, At, B0); PG8_MMA(1, 1, At, B1); PG8_BAR; PG8_SCHED;
            PG8_LDB(B0, 1, 0); PG8_LDB(B1, 1, 1); PG8_SCHED; PG8_LDA(At, 1, 0); PG8_STAGE(PG8_SA(0, 1), a2 + hstep, voffA);
            PG8_WAIT_V(8); PG8_WAIT_L(0); PG8_BAR; PG8_MMA(0, 0, At, B0); PG8_MMA(0, 1, At, B1); PG8_BAR; PG8_SCHED;
            PG8_LDA(At, 1, 1); PG8_STAGE(PG8_SB(1, 0), b3, voffB); PG8_STAGE(PG8_SB(1, 1), b3 + hstep, voffB); PG8_STAGE(PG8_SA(1, 0), a3, voffA);
            PG8_WAIT_V(8); PG8_WAIT_L(0); PG8_BAR; PG8_MMA(1, 0, At, B0); PG8_MMA(1, 1, At, B1); PG8_BAR; PG8_SCHED;
            }
            }
            E.mid(acc, cur, wr, wc, fr, fq);
#pragma unroll 1
            for (int t = tmid; t < nt; t += 2) {
            { const bool last = (t == nt - 2);
            asm volatile("" : "+s"(cA), "+s"(cB));
            const char* a1 = cA + (size_t)(t + 1) * kstep;
            const char* a2 = last ? nA : cA + (size_t)(t + 2) * kstep; const char* b2 = last ? nB : cB + (size_t)(t + 2) * kstep;
            const char* a3 = a2 + kstep; const char* b3 = b2 + kstep;
            if (last && has_next) S.a_ready(nxt);
            PG8_LDB(B0, 0, 0); PG8_LDB(B1, 0, 1); PG8_SCHED; PG8_LDA(At, 0, 0); PG8_STAGE(PG8_SA(1, 1), a1 + hstep, voffA);
            PG8_WAIT_V(8); PG8_WAIT_L(0); PG8_BAR; PG8_MMA(0, 0, At, B0); PG8_MMA(0, 1, At, B1); PG8_BAR; PG8_SCHED;
            PG8_LDA(At, 0, 1); PG8_STAGE(PG8_SB(0, 0), b2, voffB); PG8_STAGE(PG8_SB(0, 1), b2 + hstep, voffB); PG8_STAGE(PG8_SA(0, 0), a2, voffA);
            PG8_WAIT_V(8); PG8_WAIT_L(0); PG8_BAR; PG8_MMA(1, 0, At, B0); PG8_MMA(1, 1, At, B1); PG8_BAR; PG8_SCHED;
            PG8_LDB(B0, 1, 0); PG8_LDB(B1, 1, 1); PG8_SCHED; PG8_LDA(At, 1, 0); PG8_STAGE(PG8_SA(0, 1), a2 + hstep, voffA);
            PG8_WAIT_V(8); PG8_WAIT_L(0); PG8_BAR; PG8_MMA(0, 0, At, B0); PG8_MMA(0, 1, At, B1); PG8_BAR; PG8_SCHED;
            PG8_LDA(At, 1, 1); PG8_STAGE(PG8_SB(1, 0), b3, voffB); PG8_STAGE(PG8_SB(1, 1), b3 + hstep, voffB); PG8_STAGE(PG8_SA(1, 0), a3, voffA);
            PG8_WAIT_V(8); PG8_WAIT_L(0); PG8_BAR; PG8_MMA(1, 0, At, B0); PG8_MMA(1, 1, At, B1); PG8_BAR; PG8_SCHED;
            }
            }
        } else
        for (int t = 0; t < nt; t += 2) {
            const bool last = (t == nt - 2);
            const char* a1 = cA + (size_t)(t + 1) * kstep;
            const char* a2 = last ? nA : cA + (size_t)(t + 2) * kstep; const char* b2 = last ? nB : cB + (size_t)(t + 2) * kstep;
            const char* a3 = a2 + kstep; const char* b3 = b2 + kstep;
            if (last && has_next) S.a_ready(nxt);
            if constexpr (SP2) {
            PG8_LDB(B0, 0, 0); PG8_LDB(B1, 0, 1); PG8_SCHED; PG8_LDA(At, 0, 0); PG8_STAGE(PG8_SA(1, 1), a1 + hstep, voffA);
            PG8_WAIT_V(8); PG8_WAIT_L(0); PG8_BAR; PG8_MMA(0, 0, At, B0); PG8_MMA(0, 1, At, B1); PG8_BAR; PG8_SCHED;
            PG8_LDA(At, 0, 1); PG8_STAGE(PG8_SB(0, 0), b2, voffB); PG8_STAGE(PG8_SB(0, 1), b2 + hstep, voffB); PG8_STAGE(PG8_SA(0, 0), a2, voffA);
            PG8_WAIT_V(8); PG8_WAIT_L(0); PG8_BAR; PG8_MMA(1, 0, At, B0); PG8_MMA(1, 1, At, B1); PG8_BAR; PG8_SCHED;
            PG8_LDB(B0, 1, 0); PG8_LDB(B1, 1, 1); PG8_SCHED; PG8_LDA(At, 1, 0); PG8_STAGE(PG8_SA(0, 1), a2 + hstep, voffA);
            PG8_WAIT_V(8); PG8_WAIT_L(0); PG8_BAR; PG8_MMA(0, 0, At, B0); PG8_MMA(0, 1, At, B1); PG8_BAR; PG8_SCHED;
            PG8_LDA(At, 1, 1); PG8_STAGE(PG8_SB(1, 0), b3, voffB); PG8_STAGE(PG8_SB(1, 1), b3 + hstep, voffB); PG8_STAGE(PG8_SA(1, 0), a3, voffA);
            PG8_WAIT_V(8); PG8_WAIT_L(0); PG8_BAR; PG8_MMA(1, 0, At, B0); PG8_MMA(1, 1, At, B1); PG8_BAR; PG8_SCHED;
            } else {
            PG8_LDB(B0, 0, 0); PG8_SCHED; PG8_LDA(At, 0, 0); PG8_STAGE(PG8_SA(1, 1), a1 + hstep, voffA);
            PG8_WAIT_L(8); PG8_BAR; PG8_WAIT_L(0); PG8_MMA(0, 0, At, B0); PG8_BAR; PG8_SCHED;
            PG8_LDB(B1, 0, 1); PG8_STAGE(PG8_SB(0, 0), b2, voffB);
            PG8_BAR; PG8_WAIT_L(0); PG8_MMA(0, 1, At, B1); PG8_BAR;
            PG8_LDA(At, 0, 1); PG8_STAGE(PG8_SA(0, 0), a2, voffA);
            PG8_BAR; PG8_WAIT_L(0); PG8_MMA(1, 0, At, B0); PG8_BAR; PG8_SCHED;
            PG8_STAGE(PG8_SB(0, 1), b2 + hstep, voffB);
            PG8_WAIT_V(6); PG8_BAR; PG8_MMA(1, 1, At, B1); PG8_BAR;
            PG8_LDB(B0, 1, 0); PG8_SCHED; PG8_LDA(At, 1, 0); PG8_STAGE(PG8_SA(0, 1), a2 + hstep, voffA);
            PG8_WAIT_L(8); PG8_BAR; PG8_WAIT_L(0); PG8_MMA(0, 0, At, B0); PG8_BAR; PG8_SCHED;
            PG8_LDB(B1, 1, 1); PG8_STAGE(PG8_SB(1, 0), b3, voffB);
            PG8_BAR; PG8_WAIT_L(0); PG8_MMA(0, 1, At, B1); PG8_BAR;
            PG8_LDA(At, 1, 1); PG8_STAGE(PG8_SA(1, 0), a3, voffA);
            PG8_BAR; PG8_WAIT_L(0); PG8_MMA(1, 0, At, B0); PG8_BAR; PG8_SCHED;
            PG8_STAGE(PG8_SB(1, 1), b3 + hstep, voffB);
            PG8_WAIT_V(6); PG8_BAR; PG8_MMA(1, 1, At, B1); PG8_BAR;
            }
        }
        if constexpr (ALIGN_EPI) { if (wr == 0) PG8_BAR; }
        if constexpr (!Epi::AFTER_DRAIN) { E(acc, cur, wr, wc, fr, fq); S.done(cur); }
        if (!has_next) break;
#pragma unroll
        for (int a = 0; a < 2; ++a)
#pragma unroll
            for (int b = 0; b < 2; ++b)
#pragma unroll
                for (int m = 0; m < 4; ++m)
#pragma unroll
                    for (int n = 0; n < 2; ++n) acc[a][b][m][n] = (f32x4){0.f, 0.f, 0.f, 0.f};
        cur = nxt; cA = nA; cB = nB; ++ui;
        if constexpr (ALIGN_EPI) { if (wr == 1) PG8_BAR; }
    }
    PG8_WAIT_V(0);
    if constexpr (!ALIGN_EPI) { if (wr == 0) PG8_BAR; }
    PG8_BAR;
    if constexpr (Epi::AFTER_DRAIN) { E.fused(acc, cur, wr, wc, fr, fq, lds, wid, lane); S.done(cur); }
#undef PG8_SA
#undef PG8_SB
#undef PG8_STAGE
#undef PG8_LDA
#undef PG8_LDB
#undef PG8_MMA
#undef PG8_WAIT_V
#undef PG8_WAIT_L
#undef PG8_BAR
#undef PG8_SCHED
}
}
#define GAS __attribute__((address_space(1)))
#define LAS __attribute__((address_space(3)))
typedef unsigned short bf16;
typedef unsigned v4u __attribute__((ext_vector_type(4)));
typedef float f32x4 __attribute__((ext_vector_type(4)));
typedef short bf16x8 __attribute__((ext_vector_type(8)));
typedef GAS unsigned gu32;
typedef GAS unsigned long long gu64;
#define RLX_AGENT __ATOMIC_RELAXED, __HIP_MEMORY_SCOPE_AGENT
#define LDS_WAIT() asm volatile("s_waitcnt lgkmcnt(0)" ::: "memory")
#define VM_WAIT() asm volatile("s_waitcnt vmcnt(0)" ::: "memory")
__device__ __forceinline__ unsigned long long rt() { return __builtin_amdgcn_s_memrealtime(); }
__device__ __forceinline__ unsigned f2bf(float f) { unsigned u = __builtin_bit_cast(unsigned, f); return (u + 0x7fffu + ((u >> 16) & 1u)) >> 16; }
__device__ __forceinline__ unsigned pk2(float lo, float hi) { return f2bf(lo) | (f2bf(hi) << 16); }

#define XB_TMO      128
#define XB_XCNT(j)  (256  + 64 * (j))
#define XB_XSUB(j)  (1280 + 64 * (j))
#define XB_XGEN(j)  (2304 + 64 * (j))
#define XB_TOP      3328
#define XB_TOPGEN   3392
#define XCD_BAR_WORDS 3456
#define XB_SPIN_CAP (1u << 18)

__device__ __forceinline__ unsigned xb_ld(unsigned* p)              { return __hip_atomic_load(p, __ATOMIC_RELAXED, __HIP_MEMORY_SCOPE_AGENT); }
__device__ __forceinline__ unsigned xb_add(unsigned* p, unsigned v) { return __hip_atomic_fetch_add(p, v, __ATOMIC_RELAXED, __HIP_MEMORY_SCOPE_AGENT); }
__device__ __forceinline__ unsigned xb_xcc_id() { return (unsigned)__builtin_amdgcn_s_getreg((3 << 11) | 20) & 0xFu; }
#define XB_SPIN(cond, bar) do { unsigned _sp = 0; while (cond) { __builtin_amdgcn_s_sleep(1); \
    if ((++_sp & 255u) == 0u) { if (xb_ld(&(bar)[XB_TMO])) break; if (_sp > XB_SPIN_CAP) { atomicAdd(&(bar)[XB_TMO], 1u); break; } } } } while (0)

struct XcdBarrier {
    unsigned* bar; unsigned x;
    volatile LAS unsigned* st;
};

__device__ __forceinline__ XcdBarrier xcd_barrier_post(unsigned* bar, volatile LAS unsigned* st) {
    XcdBarrier b; b.bar = bar; b.x = xb_xcc_id(); b.st = st;
    if (threadIdx.x == 0) (void)xb_add(&bar[XB_XCNT(b.x)], 1u);
    return b;
}
__device__ __forceinline__ void xcd_barrier_complete(unsigned* bar, unsigned x, unsigned& nloc, unsigned& nx) {
    const unsigned G = gridDim.x * gridDim.y * gridDim.z;
    unsigned sum, cnt, mine, sp = 0u;
    for (;;) {
        sum = 0u; cnt = 0u; mine = 0u;
#pragma unroll
        for (unsigned j = 0; j < 16; ++j) { const unsigned c = xb_ld(&bar[XB_XCNT(j)]); sum += c; cnt += (c > 0u) ? 1u : 0u; mine = (j == x) ? c : mine; }
        if (sum == G) break;
        __builtin_amdgcn_s_sleep(1);
        if ((++sp & 255u) == 0u) { if (xb_ld(&bar[XB_TMO])) break; if (sp > XB_SPIN_CAP) { atomicAdd(&bar[XB_TMO], 1u); break; } }
    }
    nloc = mine > 0u ? mine : 1u; nx = cnt > 0u ? cnt : 1u;
}

__device__ __forceinline__ void xcd_barrier(const XcdBarrier& b) {
    asm volatile("s_waitcnt vmcnt(0)" ::: "memory");
    __syncthreads();
    if (threadIdx.x == 0) {
        unsigned* bar = b.bar;
        __builtin_amdgcn_s_waitcnt(0);
        unsigned nloc = b.st[0], nx = b.st[1];
        if (nloc == 0u) { xcd_barrier_complete(bar, b.x, nloc, nx); b.st[0] = nloc; b.st[1] = nx; }
        const unsigned old = xb_add(&bar[XB_XSUB(b.x)], 1u);
        const unsigned gen = old / nloc;
        if (old + 1u == (gen + 1u) * nloc) {
            __builtin_amdgcn_fence(__ATOMIC_RELEASE, "agent");
            asm volatile("s_waitcnt vmcnt(0)" ::: "memory");
            const unsigned og = xb_add(&bar[XB_TOP], 1u);
            const unsigned tg = og / nx;
            if (og + 1u == (tg + 1u) * nx) xb_add(&bar[XB_TOPGEN], 1u);
            else XB_SPIN(xb_ld(&bar[XB_TOPGEN]) == tg, bar);
            __builtin_amdgcn_fence(__ATOMIC_ACQUIRE, "agent");
            xb_add(&bar[XB_XGEN(b.x)], 1u);
            asm volatile("s_waitcnt vmcnt(0)" ::: "memory");
        } else {
            XB_SPIN(xb_ld(&bar[XB_XGEN(b.x)]) == gen, bar);
            __builtin_amdgcn_fence(__ATOMIC_ACQUIRE, "agent");
            asm volatile("s_waitcnt vmcnt(0)" ::: "memory");
        }
    }
    __syncthreads();
}

#ifndef PH_MASK
#define PH_MASK 0x1ff
#endif
constexpr int DM = 1024, NB = 8, SEQ = 4096, MP = NB * SEQ;
constexpr int SB = 32, SS_ = 4, MS = SB * SS_, MV = MP + MS;
constexpr int MR = 129 * 256;
constexpr int NIN = 6400, DFF = 2816, NGU = 2 * DFF, DAO = 256;
constexpr float RMS_EPS = 1e-6f, LN_EPS = 1e-5f;
constexpr int NWAVES = 8;

constexpr size_t O_Y = 0;
constexpr size_t O_KVP0 = 33685504, O_KVS0 = 34209792, O_KVP1 = 36306944, O_KVS1 = 38404096, O_KVP2 = 46792704, O_KVS2 = 55181312;
constexpr size_t O_CONVP = 88735744, O_CONVS = 88981504, O_TOTAL = 89964544;

constexpr size_t MiB = 1u << 20;
constexpr size_t WS_CTL = 0, CTL_ZERO_BYTES = 32768;
constexpr size_t WS_W1 = 1 * MiB;
constexpr size_t WS_WCAT = 14 * MiB;
constexpr size_t WS_WOUT = 17 * MiB;
constexpr size_t WS_WGU = 19 * MiB;
constexpr size_t WS_WD = 30 * MiB;
constexpr int KC = 1280;
constexpr size_t WS_A = 36 * MiB;
constexpr size_t WS_B = 117 * MiB;
constexpr size_t WS_GA = 182 * MiB, WS_GB = 215 * MiB;
constexpr size_t WS_Q = 248 * MiB, WS_K = 296 * MiB, WS_V = 344 * MiB;
constexpr size_t WS_OG = 392 * MiB;
constexpr size_t WS_LSE = 441 * MiB;
constexpr size_t WS_SS = 443 * MiB;
constexpr size_t WS_SQ = 446 * MiB;
constexpr size_t WS_SSS = 447 * MiB;
constexpr size_t WS_ACT = 248 * MiB;
constexpr size_t WS_END = 448 * MiB;
constexpr int CW_BAR = 4096;

constexpr int RING_BYTES = 131072, LDSCTL_OFF = RING_BYTES, MISC_OFF = LDSCTL_OFF + 320, LDS_BYTES = 147456;

typedef unsigned u32x4 __attribute__((ext_vector_type(4)));
typedef unsigned u32x2 __attribute__((ext_vector_type(2)));

struct Params {
    const float* in[20];
    float* out;
    unsigned char* ws;
    int ph_lo, ph_hi;
};

__device__ __forceinline__ float sigmoidf_(float x) { return __builtin_amdgcn_rcpf(1.0f + __expf(-x)); }
__device__ __forceinline__ float wave_sum(float v) {
#pragma unroll
    for (int o = 1; o < 64; o <<= 1) v += __shfl_xor(v, o);
    return v;
}


__device__ __forceinline__ u32x2 qgate8(const f32x4 a, const f32x4 b) {
    unsigned w0 = 0u, w1 = 0u;
    w0 = __builtin_amdgcn_cvt_pk_u8_f32(__builtin_rintf(a[0] * 255.f), 0, w0); w0 = __builtin_amdgcn_cvt_pk_u8_f32(__builtin_rintf(a[1] * 255.f), 1, w0);
    w0 = __builtin_amdgcn_cvt_pk_u8_f32(__builtin_rintf(a[2] * 255.f), 2, w0); w0 = __builtin_amdgcn_cvt_pk_u8_f32(__builtin_rintf(a[3] * 255.f), 3, w0);
    w1 = __builtin_amdgcn_cvt_pk_u8_f32(__builtin_rintf(b[0] * 255.f), 0, w1); w1 = __builtin_amdgcn_cvt_pk_u8_f32(__builtin_rintf(b[1] * 255.f), 1, w1);
    w1 = __builtin_amdgcn_cvt_pk_u8_f32(__builtin_rintf(b[2] * 255.f), 2, w1); w1 = __builtin_amdgcn_cvt_pk_u8_f32(__builtin_rintf(b[3] * 255.f), 3, w1);
    return (u32x2){w0, w1};
}
__device__ __forceinline__ void dqgate8(const u32x2 w, f32x4& a, f32x4& b) {
    constexpr float S = 1.0f / 255.0f;
    a = (f32x4){(float)(w.x & 0xffu) * S, (float)((w.x >> 8) & 0xffu) * S, (float)((w.x >> 16) & 0xffu) * S, (float)(w.x >> 24) * S};
    b = (f32x4){(float)(w.y & 0xffu) * S, (float)((w.y >> 8) & 0xffu) * S, (float)((w.y >> 16) & 0xffu) * S, (float)(w.y >> 24) * S};
}

constexpr int CP_CHUNKS = 5456;
struct CopyCtx { const float* s0; const float* s1; const float* s2; const float* s3; float* out; };
__device__ __forceinline__ void cp_addr(const CopyCtx& c, int chunk, int tid, int j, const GAS f32x4*& src, GAS f32x4*& dst) {
    int base, rows, per, rw; const float* sp; size_t oo;
    if (chunk < 248) { base = 0; rows = 124; per = 128; rw = 128; sp = c.s0; oo = O_KVS0; }
    else if (chunk < 1264) { base = 248; rows = 508; per = 512; rw = 128; sp = c.s1; oo = O_KVS1; }
    else if (chunk < 5352) { base = 1264; rows = 2044; per = 2048; rw = 128; sp = c.s2; oo = O_KVS2; }
    else { base = 5352; rows = 26; per = 30; rw = 256; sp = c.s3; oo = O_CONVS; }
    const int i0 = (chunk - base) * 2048, n4b = rows * rw, b0 = i0 / n4b, r0 = i0 - b0 * n4b;
    int r = r0 + j * 512 + tid, b = b0;
    if (r >= n4b) { r -= n4b; b += 1; }
    const unsigned idx = (unsigned)(b * per * rw + r);
    src = (const GAS f32x4*)sp + idx + 4 * rw;
    dst = (GAS f32x4*)(c.out + oo) + idx;
}
__device__ __forceinline__ void cp_load(const CopyCtx& c, int chunk, int tid, f32x4 (&v)[4]) {
    if (chunk < CP_CHUNKS) {
#pragma unroll
        for (int j = 0; j < 4; ++j) { const GAS f32x4* src; GAS f32x4* dst; cp_addr(c, chunk, tid, j, src, dst); v[j] = __builtin_nontemporal_load(src); }
    }
    __builtin_amdgcn_sched_barrier(0);
}
__device__ __forceinline__ void cp_store(const CopyCtx& c, int chunk, int tid, const f32x4 (&v)[4]) {
    __builtin_amdgcn_sched_barrier(0);
    if (chunk < CP_CHUNKS) {
#pragma unroll
        for (int j = 0; j < 4; ++j) { const GAS f32x4* src; GAS f32x4* dst; cp_addr(c, chunk, tid, j, src, dst); __builtin_nontemporal_store(v[j], dst); }
    }
}

struct EpiP1 {
    static constexpr bool PERM = true, AFTER_DRAIN = false, HAS_MID = false;
    bf16 *Q, *K, *V, *U, *GA, *GB; float* SQ; float* out; const float *qw, *kw; CopyCtx cc;
    __device__ __forceinline__ void operator()(const pg8::f32x4 (&acc)[2][2][4][2], const pg8::Unit& u, int wr, int wc, int fr, int fq) const {
        const int pn = u.pn, row0 = u.pm * 256 + wr * 64 + fr;
        const int cp_chunk = u.pm * 25 + pn, cp_tid = (wr * 4 + wc) * 64 + fq * 16 + fr; f32x4 cpv[4]; cp_load(cc, cp_chunk, cp_tid, cpv);
        if (pn < 9) {
            const int seg = pn / 3, g = pn - 3 * seg, sh = 2 * g, win = 128 << sh, head = wc;
            f32x4 w[2][2];
            const float* nw = (seg == 0) ? qw : kw;
#pragma unroll
            for (int bj = 0; bj < 2; ++bj)
#pragma unroll
                for (int n = 0; n < 2; ++n) w[bj][n] = (seg < 2) ? *(const f32x4*)(nw + 32 * bj + 8 * fq + 4 * n) : (f32x4){1.f, 1.f, 1.f, 1.f};
            const float post = (seg == 0) ? 0.125f * 1.4426950408889634f : 1.0f;
            bf16* dstb = Q + (size_t)seg * ((WS_K - WS_Q) / 2);
            const size_t okp = (g == 0) ? O_KVP0 : (g == 1) ? O_KVP1 : O_KVP2;
            const size_t oks = (g == 0) ? O_KVS0 : (g == 1) ? O_KVS1 : O_KVS2;
#pragma unroll
            for (int ai = 0; ai < 2; ++ai)
#pragma unroll
                for (int m = 0; m < 4; ++m) {
                    const int row = row0 + ai * 128 + m * 16;
                    if (ai == 1 && m == 0) cp_store(cc, cp_chunk, cp_tid, cpv);
                    f32x4 v[2][2];
#pragma unroll
                    for (int bj = 0; bj < 2; ++bj)
#pragma unroll
                        for (int n = 0; n < 2; ++n) v[bj][n] = acc[ai][bj][m][n];
                    if (seg < 2) {
                        float ss = 0.f;
#pragma unroll
                        for (int bj = 0; bj < 2; ++bj)
#pragma unroll
                            for (int n = 0; n < 2; ++n) { const f32x4 x = v[bj][n]; ss += (x[0] * x[0] + x[1] * x[1]) + (x[2] * x[2] + x[3] * x[3]); }
                        ss += __shfl_xor(ss, 16); ss += __shfl_xor(ss, 32);
                        const float rs = __builtin_amdgcn_rsqf(ss * (1.0f / 64.0f) + RMS_EPS) * post;
#pragma unroll
                        for (int bj = 0; bj < 2; ++bj)
#pragma unroll
                            for (int n = 0; n < 2; ++n) v[bj][n] = v[bj][n] * rs * w[bj][n];
                    }
                    if (row < MP) {
                        const int b = row >> 12, t = row & 4095;
                        const int pos = ((t & ((1 << sh) - 1)) << (12 - sh)) + (t >> sh);
                        bf16* d = dstb + ((size_t)((b * 3 + g) * 4 + head) * 4096 + pos) * 64 + 8 * fq;
#pragma unroll
                        for (int bj = 0; bj < 2; ++bj) {
                            u32x4 pk; pk.x = pg8::cvt_pk_bf16(v[bj][0][0], v[bj][0][1]); pk.y = pg8::cvt_pk_bf16(v[bj][0][2], v[bj][0][3]);
                            pk.z = pg8::cvt_pk_bf16(v[bj][1][0], v[bj][1][1]); pk.w = pg8::cvt_pk_bf16(v[bj][1][2], v[bj][1][3]);
                            *(u32x4*)(d + 32 * bj) = pk;
                        }
                        if (seg >= 1 && t >= 4096 - win) {
                            float* o = out + okp + ((size_t)(b * win + (t - (4096 - win))) * 2 + (seg - 1)) * 256 + head * 64 + 8 * fq;
#pragma unroll
                            for (int bj = 0; bj < 2; ++bj)
#pragma unroll
                                for (int n = 0; n < 2; ++n) __builtin_nontemporal_store(v[bj][n], (f32x4*)(o + 32 * bj + 4 * n));
                        }
                    } else if (row < MV) {
                        const int si = row - MP, sb = si >> 2, s = si & 3;
                        float* o = (seg == 0) ? SQ + ((size_t)si * 12 + g * 4 + head) * 64 + 8 * fq
                                              : out + oks + ((size_t)(sb * win + win - 4 + s) * 2 + (seg - 1)) * 256 + head * 64 + 8 * fq;
#pragma unroll
                        for (int bj = 0; bj < 2; ++bj)
#pragma unroll
                            for (int n = 0; n < 2; ++n) *(f32x4*)(o + 32 * bj + 4 * n) = v[bj][n];
                    }
                }
        } else if (pn < 17) {
            const int ch0 = 128 * (pn - 9) + 32 * wc + 8 * fq;
#pragma unroll
            for (int ai = 0; ai < 2; ++ai)
#pragma unroll
                for (int m = 0; m < 4; ++m) {
                    const int row = row0 + ai * 128 + m * 16;
                    if (ai == 1 && m == 0) cp_store(cc, cp_chunk, cp_tid, cpv);
                    f32x4 uu[2];
#pragma unroll
                    for (int n = 0; n < 2; ++n) {
                        const f32x4 a = acc[ai][0][m][n], b = acc[ai][1][m][n];
#pragma unroll
                        for (int i = 0; i < 4; ++i) uu[n][i] = a[i] * sigmoidf_(b[i]);
                    }
                    u32x4 pk; pk.x = pg8::cvt_pk_bf16(uu[0][0], uu[0][1]); pk.y = pg8::cvt_pk_bf16(uu[0][2], uu[0][3]);
                    pk.z = pg8::cvt_pk_bf16(uu[1][0], uu[1][1]); pk.w = pg8::cvt_pk_bf16(uu[1][2], uu[1][3]);
                    *(u32x4*)(U + (size_t)row * DM + ch0) = pk;
                    float* o = nullptr;
                    if (row < MP) { const int b = row >> 12, t = row & 4095; if (t >= 4066) o = out + O_CONVP + ((size_t)(b * 30 + t - 4066)) * DM + ch0; }
                    else if (row < MV) { const int si = row - MP; o = out + O_CONVS + ((size_t)((si >> 2) * 30 + 26 + (si & 3))) * DM + ch0; }
                    if (o) { *(f32x4*)o = uu[0]; *(f32x4*)(o + 4) = uu[1]; }
                }
        } else {
            const int q = pn - 17; unsigned char* G = (unsigned char*)((q >> 2) ? GB : GA);
            const int col0 = 256 * (q & 3) + 32 * wc + 8 * fq;
#pragma unroll
            for (int ai = 0; ai < 2; ++ai)
#pragma unroll
                for (int m = 0; m < 4; ++m) {
                    const int row = row0 + ai * 128 + m * 16;
                    if (ai == 1 && m == 0) cp_store(cc, cp_chunk, cp_tid, cpv);
#pragma unroll
                    for (int bj = 0; bj < 2; ++bj) {
                        f32x4 a = acc[ai][bj][m][0], b = acc[ai][bj][m][1];
#pragma unroll
                        for (int i = 0; i < 4; ++i) { a[i] = sigmoidf_(a[i]); b[i] = sigmoidf_(b[i]); }
                        __builtin_nontemporal_store(qgate8(a, b), (u32x2*)(G + (size_t)row * DM + col0 + 128 * bj));
                    }
                }
        }
    }
};

__device__ __forceinline__ float bf_lo(unsigned w) { return __builtin_bit_cast(float, w << 16); }
__device__ __forceinline__ float bf_hi(unsigned w) { return __builtin_bit_cast(float, w & 0xffff0000u); }
__device__ __forceinline__ void unpack8(const u32x4 w, f32x4& a, f32x4& b) {
    a = (f32x4){bf_lo(w.x), bf_hi(w.x), bf_lo(w.y), bf_hi(w.y)}; b = (f32x4){bf_lo(w.z), bf_hi(w.z), bf_lo(w.w), bf_hi(w.w)};
}
__device__ __forceinline__ u32x4 pack8(const f32x4 a, const f32x4 b) {
    u32x4 pk; pk.x = pg8::cvt_pk_bf16(a[0], a[1]); pk.y = pg8::cvt_pk_bf16(a[2], a[3]); pk.z = pg8::cvt_pk_bf16(b[0], b[1]); pk.w = pg8::cvt_pk_bf16(b[2], b[3]); return pk;
}

__device__ __forceinline__ u32x2 ld8nt(const void* pz) { return __builtin_nontemporal_load((const u32x2*)pz); }
struct EpiGateF {
    static constexpr bool PERM = true, AFTER_DRAIN = false, HAS_MID = true; static constexpr int MID_T = DAO / 64;
    const unsigned char* GA; const unsigned char* GB; bf16* H;
    __device__ __forceinline__ void mid(pg8::f32x4 (&acc)[2][2][4][2], const pg8::Unit& u, int wr, int wc, int fr, int fq) const {
        const int row0 = u.pm * 256 + wr * 64 + fr, col0 = u.pn * 256 + 32 * wc + 8 * fq;
#pragma unroll
        for (int ai = 0; ai < 2; ++ai)
#pragma unroll
            for (int m = 0; m < 4; ++m) {
                const unsigned off = (unsigned)(row0 + ai * 128 + m * 16) * DM + col0;
#pragma unroll
                for (int bj = 0; bj < 2; ++bj) {
                    f32x4 a0, a1, b0, b1; dqgate8(ld8nt(GA + off + 128 * bj), a0, a1); dqgate8(*(const u32x2*)(GB + off + 128 * bj), b0, b1);
#pragma unroll
                    for (int i = 0; i < 4; ++i) {
                        acc[ai][bj][m][0][i] *= a0[i] * __builtin_amdgcn_rcpf(fmaxf(b0[i], 8.6736174e-19f));
                        acc[ai][bj][m][1][i] *= a1[i] * __builtin_amdgcn_rcpf(fmaxf(b1[i], 8.6736174e-19f));
                    }
                }
                if (m & 1) asm volatile("" ::: "memory");
            }
    }
    __device__ __forceinline__ void operator()(const pg8::f32x4 (&acc)[2][2][4][2], const pg8::Unit& u, int wr, int wc, int fr, int fq) const {
        int row0 = u.pm * 256 + wr * 64 + fr, col0 = u.pn * 256 + 32 * wc + 8 * fq;
        asm volatile("" : "+v"(row0), "+v"(col0));
#pragma unroll
        for (int ai = 0; ai < 2; ++ai)
#pragma unroll
            for (int m = 0; m < 4; ++m) {
                const unsigned off = (unsigned)(row0 + ai * 128 + m * 16) * DM + col0;
#pragma unroll
                for (int bj = 0; bj < 2; ++bj) {
                    f32x4 b0, b1; dqgate8(ld8nt(GB + off + 128 * bj), b0, b1);
#pragma unroll
                    for (int i = 0; i < 4; ++i) { b0[i] = fmaxf(b0[i], 8.6736174e-19f); b1[i] = fmaxf(b1[i], 8.6736174e-19f); }
                    *(u32x4*)(H + off + 128 * bj) = pack8(acc[ai][bj][m][0] * b0, acc[ai][bj][m][1] * b1);
                }
                if (m & 1) asm volatile("" ::: "memory");
            }
    }
};
struct EpiX1 {
    static constexpr bool PERM = true, AFTER_DRAIN = false, HAS_MID = false;
    const float *xp, *xs; float* out; bf16* X1B; float* SS;
    __device__ __forceinline__ void operator()(const pg8::f32x4 (&acc)[2][2][4][2], const pg8::Unit& u, int wr, int wc, int fr, int fq) const {
        const int row0 = u.pm * 256 + wr * 64 + fr, col0 = u.pn * 256 + 32 * wc + 8 * fq;
#pragma unroll
        for (int ai = 0; ai < 2; ++ai) {
            f32x4 xv[4][2][2];
#pragma unroll
            for (int m = 0; m < 4; ++m) {
                const float* xr = xp + (size_t)(row0 + ai * 128 + m * 16) * DM + col0;
#pragma unroll
                for (int bj = 0; bj < 2; ++bj)
#pragma unroll
                    for (int n = 0; n < 2; ++n) xv[m][bj][n] = __builtin_nontemporal_load((const f32x4*)(xr + 128 * bj + 4 * n));
            }
#pragma unroll
            for (int m = 0; m < 4; ++m) {
                const int row = row0 + ai * 128 + m * 16;
                float ss = 0.f;
#pragma unroll
                for (int bj = 0; bj < 2; ++bj) {
                    f32x4 v[2];
#pragma unroll
                    for (int n = 0; n < 2; ++n) {
                        v[n] = xv[m][bj][n] + acc[ai][bj][m][n];
                        ss += (v[n][0] * v[n][0] + v[n][1] * v[n][1]) + (v[n][2] * v[n][2] + v[n][3] * v[n][3]);
                    }
                    *(u32x4*)(X1B + (size_t)row * DM + col0 + 128 * bj) = pack8(v[0], v[1]);
                }
                ss += __shfl_xor(ss, 16); ss += __shfl_xor(ss, 32);
                if (fq == 0) SS[(size_t)row * 16 + u.pn * 4 + wc] = ss;
            }
            asm volatile("" ::: "memory");
        }
    }
};
struct EpiAct {
    static constexpr bool PERM = true, AFTER_DRAIN = false, HAS_MID = false;
    const float* SS; bf16* ACT; CopyCtx cc;
    __device__ __forceinline__ void operator()(const pg8::f32x4 (&acc)[2][2][4][2], const pg8::Unit& u, int wr, int wc, int fr, int fq) const {
        const int row0 = u.pm * 256 + wr * 64 + fr, ch0 = u.pn * 128 + 32 * wc + 8 * fq;
        const int cp_q = u.pm * 22 + u.pn, cp_c0 = (cp_q * (CP_CHUNKS - 3225)) / 2816, cp_c1 = ((cp_q + 1) * (CP_CHUNKS - 3225)) / 2816;
        const int cp_chunk = (cp_c1 != cp_c0) ? 3225 + cp_c0 : CP_CHUNKS, cp_tid = (wr * 4 + wc) * 64 + fq * 16 + fr; f32x4 cpv[4]; cp_load(cc, cp_chunk, cp_tid, cpv);
#pragma unroll
        for (int ai = 0; ai < 2; ++ai)
#pragma unroll
            for (int m = 0; m < 4; ++m) {
                const int row = row0 + ai * 128 + m * 16;
                    if (ai == 1 && m == 0) cp_store(cc, cp_chunk, cp_tid, cpv);
                const f32x4 sv = *((const f32x4*)(SS + (size_t)row * 16) + fq);
                float tot = (sv[0] + sv[1]) + (sv[2] + sv[3]);
                tot += __shfl_xor(tot, 16); tot += __shfl_xor(tot, 32);
                const float rstd = __builtin_amdgcn_rsqf(tot * (1.0f / DM) + RMS_EPS);
                f32x4 a[2];
#pragma unroll
                for (int n = 0; n < 2; ++n)
#pragma unroll
                    for (int i = 0; i < 4; ++i) { const float g = acc[ai][0][m][n][i] * rstd, up = acc[ai][1][m][n][i] * rstd; a[n][i] = g * sigmoidf_(g) * up; }
                *(u32x4*)(ACT + (size_t)row * DFF + ch0) = pack8(a[0], a[1]);
            }
    }
};
struct EpiOut {
    static constexpr bool PERM = true, AFTER_DRAIN = false, HAS_MID = false;
    float* out; const bf16* X1B;
    __device__ __forceinline__ void operator()(const pg8::f32x4 (&acc)[2][2][4][2], const pg8::Unit& u, int wr, int wc, int fr, int fq) const {
        const int row0 = u.pm * 256 + wr * 64 + fr, col0 = u.pn * 256 + 32 * wc + 8 * fq;
#pragma unroll
        for (int ai = 0; ai < 2; ++ai)
#pragma unroll
            for (int m = 0; m < 4; ++m) {
                const int row = row0 + ai * 128 + m * 16;
                float* o = out + (size_t)row * DM + col0;
#pragma unroll
                for (int bj = 0; bj < 2; ++bj) {
                    f32x4 xa, xb; unpack8(__builtin_nontemporal_load((const u32x4*)(X1B + (size_t)row * DM + col0 + 128 * bj)), xa, xb);
                    __builtin_nontemporal_store(xa + acc[ai][bj][m][0], (f32x4*)(o + 128 * bj)); __builtin_nontemporal_store(xb + acc[ai][bj][m][1], (f32x4*)(o + 128 * bj + 4));
                }
            }
    }
};

__device__ __forceinline__ void attn_sample_unit(const Params& p, LAS float* sS, int it, int lane) {
    unsigned char* ws = p.ws;
    const int h = it & 3, g = (it >> 2) % 3, si = it / 12, b = si >> 2, s = si & 3, sh = 2 * g, win = 128 << sh;
    const float* cache = p.in[2 + g];
    const float* newr = p.out + ((g == 0) ? O_KVS0 : (g == 1) ? O_KVS1 : O_KVS2);
    const f32x4* qp = (const f32x4*)((const float*)(ws + WS_SQ) + ((size_t)si * 12 + g * 4 + h) * 64);
    const float* kr[2];
#pragma unroll
    for (int c = 0; c < 2; ++c) {
        const int idx = win + s - ((lane + 64 * c) << sh);
        kr[c] = (idx < win) ? cache + (size_t)(b * win + idx) * 512 + h * 64 : newr + (size_t)(b * win + idx - 4) * 512 + h * 64;
    }
    f32x4 kv[2][16];
#pragma unroll
    for (int c = 0; c < 2; ++c)
#pragma unroll
        for (int c16 = 0; c16 < 16; ++c16) kv[c][c16] = *((const f32x4*)kr[c] + c16);
    const f32x4 k128 = *((const f32x4*)(cache + (size_t)(b * win + s) * 512 + h * 64) + (lane & 15));
    float d[2];
#pragma unroll
    for (int c = 0; c < 2; ++c) {
        float a0 = 0.f, a1 = 0.f;
#pragma unroll
        for (int c16 = 0; c16 < 16; c16 += 2) {
            const f32x4 pa = kv[c][c16] * qp[c16], pb = kv[c][c16 + 1] * qp[c16 + 1];
            a0 += (pa[0] + pa[1]) + (pa[2] + pa[3]); a1 += (pb[0] + pb[1]) + (pb[2] + pb[3]);
        }
        d[c] = a0 + a1;
    }
    float d2;
    { const f32x4 pa = k128 * qp[lane & 15]; d2 = (pa[0] + pa[1]) + (pa[2] + pa[3]); d2 += __shfl_xor(d2, 1); d2 += __shfl_xor(d2, 2); d2 += __shfl_xor(d2, 4); d2 += __shfl_xor(d2, 8); }
    float mx = fmaxf(fmaxf(d[0], d[1]), d2);
#pragma unroll
    for (int o = 1; o < 64; o <<= 1) mx = fmaxf(mx, __shfl_xor(mx, o));
    const float p0 = __builtin_amdgcn_exp2f(d[0] - mx), p1 = __builtin_amdgcn_exp2f(d[1] - mx), p2 = __builtin_amdgcn_exp2f(d2 - mx);
    sS[lane] = p0; sS[lane + 64] = p1; if (lane == 0) sS[128] = p2;
    const float p2b = __builtin_bit_cast(float, __builtin_amdgcn_readfirstlane(__builtin_bit_cast(int, p2)));
    const float l = wave_sum(p0 + p1) + p2b;
    LDS_WAIT();
    const int kg = lane >> 4, dc = lane & 15;
    const size_t voff = (size_t)h * 64 + 4 * dc + 256;
    f32x4 vv[33];
#pragma unroll
    for (int i = 0; i < 33; ++i) {
        const int jj = kg + 4 * i, jc = (jj <= 128) ? jj : 128;
        const int idx = win + s - (jc << sh);
        const float* vr = (idx < win) ? cache + (size_t)(b * win + idx) * 512 + voff : newr + (size_t)(b * win + idx - 4) * 512 + voff;
        vv[i] = *(const f32x4*)vr;
    }
    f32x4 o = {0.f, 0.f, 0.f, 0.f};
#pragma unroll
    for (int i = 0; i < 33; ++i) { const int jj = kg + 4 * i; const float pj = (jj <= 128) ? sS[(jj <= 128) ? jj : 128] : 0.f; o = o + vv[i] * pj; }
#pragma unroll
    for (int e = 0; e < 4; ++e) { o[e] += __shfl_xor(o[e], 16); o[e] += __shfl_xor(o[e], 32); }
    const float inv = 1.0f / l;
    if (lane < 16) {
        u32x2 w; w.x = pg8::cvt_pk_bf16(o[0] * inv, o[1] * inv); w.y = pg8::cvt_pk_bf16(o[2] * inv, o[3] * inv);
        *(u32x2*)((bf16*)(ws + WS_OG) + ((size_t)g * MR + MP + si) * DAO + h * 64 + 4 * dc) = w;
    }
    if (lane == 0) ((float*)(ws + WS_LSE))[((size_t)g * MR + MP + si) * 4 + h] = mx + __builtin_amdgcn_logf(l);
    LDS_WAIT();
}

typedef short s16x8 __attribute__((ext_vector_type(8)));
typedef short s16x4 __attribute__((ext_vector_type(4)));
typedef float f32x16 __attribute__((ext_vector_type(16)));
constexpr int AT_ROWB = 144, AT_VROWB = 192, AT_V0 = 384 * AT_ROWB, AT_UNITS = NB * 12 * 16, AT_PER_WG = 6;
__device__ __forceinline__ s16x4 vtr(const LAS unsigned char* p) { return __builtin_bit_cast(s16x4, __builtin_amdgcn_ds_read_tr16_b64_v4i16((LAS s16x4*)p)); }
__device__ __forceinline__ float shfl32(float v) { return __shfl_xor(v, 32); }

struct AttnPf { u32x4 k[6], v[6], q[4]; };
__device__ __forceinline__ void attn_prefetch(AttnPf& pf, const bf16* Q, const bf16* K, const bf16* V, int u, int tid, int wave, int lane) {
    const int bgh = u >> 4, c = u & 15, g = (bgh >> 2) % 3, sh = 2 * g, pos0 = 256 * c;
    const bool has_prev = (pos0 & ((4096 >> sh) - 1)) != 0;
    const size_t hb = (size_t)bgh * 4096 * 64;
#pragma unroll
    for (int i = 0; i < 6; ++i) {
        const int rel = (tid >> 3) + 64 * i - 128;
        if (has_prev || i >= 2) {
            const size_t off = hb + (size_t)(pos0 + rel) * 64 + (tid & 7) * 8;
            pf.k[i] = *(const u32x4*)(K + off); pf.v[i] = *(const u32x4*)(V + off);
        }
    }
    const bf16* qp = Q + hb + (size_t)(pos0 + 32 * wave + (lane & 31)) * 64 + (lane >> 5) * 8;
#pragma unroll
    for (int ks = 0; ks < 4; ++ks) pf.q[ks] = *(const u32x4*)(qp + ks * 16);
}
__device__ __forceinline__ void attn_stage(const AttnPf& pf, LAS unsigned char* lds, int u, int tid) {
    const int bgh = u >> 4, c = u & 15, g = (bgh >> 2) % 3, sh = 2 * g, pos0 = 256 * c;
    const bool has_prev = (pos0 & ((4096 >> sh) - 1)) != 0;
#pragma unroll
    for (int i = 0; i < 6; ++i) {
        const int kr = (tid >> 3) + 64 * i;
        const bool ld = has_prev || i >= 2;
        *(LAS u32x4*)(lds + kr * AT_ROWB + (tid & 7) * 16) = ld ? pf.k[i] : (u32x4){0u, 0u, 0u, 0u};
        *(LAS u32x4*)(lds + AT_V0 + kr * AT_VROWB + (tid & 7) * 16) = ld ? pf.v[i] : (u32x4){0u, 0u, 0u, 0u};
    }
}
__device__ __forceinline__ void attn_compute(const AttnPf& pf, LAS unsigned char* lds, bf16* OG, float* LSE, int u, int wave, int lane) {
    const int bgh = u >> 4, c = u & 15, b = bgh / 12, g = (bgh >> 2) % 3, hh = bgh & 3, sh = 2 * g, pos0 = 256 * c;
    const bool has_prev = (pos0 & ((4096 >> sh) - 1)) != 0;
    const int r32 = lane & 31, h = lane >> 5;
    const int jmin = has_prev ? 0 : ((wave < 4) ? 4 - wave : 0);
    f32x16 S[5];
    const LAS unsigned char* kbase = lds + (32 * wave + r32) * AT_ROWB + h * 16;
    s16x8 kf[2][4];
#pragma unroll
    for (int ks = 0; ks < 4; ++ks) kf[0][ks] = *(const LAS s16x8*)(kbase + ks * 32);
#pragma unroll
    for (int j = 0; j < 5; ++j) {
        if (j < 4) {
#pragma unroll
            for (int ks = 0; ks < 4; ++ks) kf[(j + 1) & 1][ks] = *(const LAS s16x8*)(kbase + (j + 1) * 32 * AT_ROWB + ks * 32);
        }
        f32x16 a = {0.f, 0.f, 0.f, 0.f, 0.f, 0.f, 0.f, 0.f, 0.f, 0.f, 0.f, 0.f, 0.f, 0.f, 0.f, 0.f};
#pragma unroll
        for (int ks = 0; ks < 4; ++ks) a = __builtin_amdgcn_mfma_f32_32x32x16_bf16(kf[j & 1][ks], __builtin_bit_cast(s16x8, pf.q[ks]), a, 0, 0, 0);
        S[j] = a;
    }
    float m = -1e30f;
#pragma unroll
    for (int j = 0; j < 5; ++j) {
        const bool tile_ok = j >= jmin;
#pragma unroll
        for (int r = 0; r < 16; ++r) {
            const int cr = (r & 3) + 8 * (r >> 2) + 4 * h;
            const bool valid = tile_ok && ((j == 0) ? (cr >= r32) : (j == 4) ? (cr <= r32) : true);
            const float v = valid ? S[j][r] : -1e30f;
            S[j][r] = v; m = fmaxf(m, v);
        }
    }
    m = fmaxf(m, shfl32(m));
    float l = 0.f;
#pragma unroll
    for (int j = 0; j < 5; ++j) {
#pragma unroll
        for (int r = 0; r < 16; ++r) { const float pe = __builtin_amdgcn_exp2f(S[j][r] - m); S[j][r] = pe; l += pe; }
    }
    l += shfl32(l);
    f32x16 o0 = {0.f, 0.f, 0.f, 0.f, 0.f, 0.f, 0.f, 0.f, 0.f, 0.f, 0.f, 0.f, 0.f, 0.f, 0.f, 0.f}, o1 = o0;
    const int a4 = lane & 15, G4 = lane >> 4;
    const LAS unsigned char* vbase = lds + AT_V0 + (32 * wave + 4 * (G4 >> 1) + (a4 >> 2)) * AT_VROWB + (16 * (G4 & 1) + 4 * (a4 & 3)) * 2;
#pragma unroll
    for (int j = 0; j < 5; ++j) {
        {
#pragma unroll
            for (int s2 = 0; s2 < 2; ++s2) {
                u32x4 pw;
                pw.x = pg8::cvt_pk_bf16(S[j][8 * s2 + 0], S[j][8 * s2 + 1]); pw.y = pg8::cvt_pk_bf16(S[j][8 * s2 + 2], S[j][8 * s2 + 3]);
                pw.z = pg8::cvt_pk_bf16(S[j][8 * s2 + 4], S[j][8 * s2 + 5]); pw.w = pg8::cvt_pk_bf16(S[j][8 * s2 + 6], S[j][8 * s2 + 7]);
                const s16x8 pfrag = __builtin_bit_cast(s16x8, pw);
                const LAS unsigned char* vp = vbase + (32 * j + 16 * s2) * AT_VROWB;
                const s16x4 a0 = vtr(vp), a1 = vtr(vp + 8 * AT_VROWB), b0 = vtr(vp + 64), b1 = vtr(vp + 8 * AT_VROWB + 64);
                const s16x8 va = {a0[0], a0[1], a0[2], a0[3], a1[0], a1[1], a1[2], a1[3]};
                const s16x8 vb = {b0[0], b0[1], b0[2], b0[3], b1[0], b1[1], b1[2], b1[3]};
                o0 = __builtin_amdgcn_mfma_f32_32x32x16_bf16(va, pfrag, o0, 0, 0, 0);
                o1 = __builtin_amdgcn_mfma_f32_32x32x16_bf16(vb, pfrag, o1, 0, 0, 0);
            }
        }
    }
    const int pos = pos0 + 32 * wave + r32;
    const int t = ((pos & ((4096 >> sh) - 1)) << sh) + (pos >> (12 - sh));
    const size_t row = (size_t)b * 4096 + t;
    const float inv = 1.0f / l;
    bf16* op = OG + ((size_t)g * MR + row) * DAO + hh * 64 + 4 * h;
#pragma unroll
    for (int i = 0; i < 4; ++i) {
        u32x2 w0, w1;
        w0.x = pg8::cvt_pk_bf16(o0[4 * i] * inv, o0[4 * i + 1] * inv); w0.y = pg8::cvt_pk_bf16(o0[4 * i + 2] * inv, o0[4 * i + 3] * inv);
        w1.x = pg8::cvt_pk_bf16(o1[4 * i] * inv, o1[4 * i + 1] * inv); w1.y = pg8::cvt_pk_bf16(o1[4 * i + 2] * inv, o1[4 * i + 3] * inv);
        *(u32x2*)(op + 8 * i) = w0; *(u32x2*)(op + 32 + 8 * i) = w1;
    }
    if (h == 0) LSE[((size_t)g * MR + row) * 4 + hh] = m + __builtin_amdgcn_logf(l);
}
__device__ __forceinline__ void attn_phase_mfma(const Params& p, LAS unsigned char* lds, int vcu, int tid, int wave, int lane) {
    unsigned char* ws = p.ws;
    const bf16* Q = (const bf16*)(ws + WS_Q); const bf16* K = (const bf16*)(ws + WS_K); const bf16* V = (const bf16*)(ws + WS_V);
    bf16* OG = (bf16*)(ws + WS_OG); float* LSE = (float*)(ws + WS_LSE);
    AttnPf pf;
    const int u0 = vcu * AT_PER_WG;
    attn_prefetch(pf, Q, K, V, u0, tid, wave, lane);
#pragma unroll 1
    for (int i = 0; i < AT_PER_WG; ++i) {
        const int u = u0 + i;
        attn_stage(pf, lds, u, tid);
        AttnPf cur;
#pragma unroll
        for (int ks = 0; ks < 4; ++ks) cur.q[ks] = pf.q[ks];
        __syncthreads();
        if (i + 1 < AT_PER_WG) attn_prefetch(pf, Q, K, V, u + 1, tid, wave, lane);
        attn_compute(cur, lds, OG, LSE, u, wave, lane);
        __syncthreads();
    }
}
__device__ __forceinline__ void merge_phase(const Params& p, int vcu, int G, int tid) {
    unsigned char* ws = p.ws;
    const bf16* OG = (const bf16*)(ws + WS_OG); const float* LSE = (const float*)(ws + WS_LSE); bf16* OATT = (bf16*)(ws + WS_A);
    constexpr int TOT = MV * 32;
    for (int it0 = vcu * 512 + tid; it0 < TOT; it0 += 4 * G * 512) {
        float l[4][3]; u32x4 og[4][3];
#pragma unroll
        for (int q = 0; q < 4; ++q) {
            const int it = it0 + q * G * 512;
            if (it < TOT) {
                const int row = it >> 5, ch = it & 31, hh = ch >> 3;
#pragma unroll
                for (int g = 0; g < 3; ++g) { l[q][g] = LSE[((size_t)g * MR + row) * 4 + hh]; og[q][g] = __builtin_nontemporal_load((const u32x4*)(OG + ((size_t)g * MR + row) * DAO + ch * 8)); }
            }
        }
#pragma unroll
        for (int q = 0; q < 4; ++q) {
            const int it = it0 + q * G * 512;
            if (it < TOT) {
                const int row = it >> 5, ch = it & 31;
                const float mx = fmaxf(l[q][0], fmaxf(l[q][1], l[q][2]));
                float e0 = __builtin_amdgcn_exp2f(l[q][0] - mx), e1 = __builtin_amdgcn_exp2f(l[q][1] - mx), e2 = __builtin_amdgcn_exp2f(l[q][2] - mx);
                const float inv = 1.0f / (e0 + e1 + e2); e0 *= inv; e1 *= inv; e2 *= inv;
                f32x4 a0, b0, a1, b1, a2, b2;
                unpack8(og[q][0], a0, b0); unpack8(og[q][1], a1, b1); unpack8(og[q][2], a2, b2);
                *(u32x4*)(OATT + (size_t)row * KC + ch * 8) = pack8(a0 * e0 + a1 * e1 + a2 * e2, b0 * e0 + b1 * e1 + b2 * e2);
            }
        }
    }
}

typedef float f32x2 __attribute__((ext_vector_type(2)));
constexpr int CV_T = 32, CV_UNITS = MP / CV_T, CV_PER_WG = CV_UNITS / 256;
template <int E> __device__ __forceinline__ void conv_loads(unsigned (&uw)[62], const bf16* up, bool has_left) {
    if constexpr (E < 62) {
        uw[E] = 0u;
        if (E >= 30 || has_left) uw[E] = *(const unsigned*)(up + (size_t)E * DM);
        conv_loads<E + 1>(uw, up, has_left);
    }
}
template <int E> __device__ __forceinline__ void conv_steps(f32x2 (&acc)[32], const f32x2 (&w)[31], const unsigned (&uw)[62]) {
    if constexpr (E < 62) {
        const f32x2 uv = {bf_lo(uw[E]), bf_hi(uw[E])};
        constexpr int TLO = (E - 30 > 0) ? E - 30 : 0, THI = (E < 31) ? E : 31;
#pragma unroll
        for (int t = TLO; t <= THI; ++t) acc[t] = acc[t] + w[E - t] * uv;
        conv_steps<E + 1>(acc, w, uw);
    }
}
__device__ __forceinline__ void conv_unit(const Params& p, LAS unsigned char* lds, const bf16* U, bf16* CACT, int unit, int tid, int wave, int lane,
                                          const f32x2 (&w)[31], f32x2 cb, f32x2 lw, f32x2 lb) {
    const int row0 = unit * CV_T, t0 = row0 & 4095, ch = 2 * tid;
    f32x2 acc[CV_T];
#pragma unroll
    for (int t = 0; t < CV_T; ++t) acc[t] = cb;
    const bf16* up = U + (size_t)(row0 - 30) * DM + ch;
    unsigned uw[62];
    conv_loads<0>(uw, up, t0 != 0);
    conv_steps<0>(acc, w, uw);
    float v[64];
#pragma unroll
    for (int t = 0; t < CV_T; ++t) { v[t] = acc[t].x + acc[t].y; v[32 + t] = acc[t].x * acc[t].x + acc[t].y * acc[t].y; }
#define CV_BFLY(n) { const bool up_half = (lane & (n)) != 0; _Pragma("unroll") for (int i = 0; i < (n); ++i) { \
        const float keep = up_half ? v[i + (n)] : v[i], send = up_half ? v[i] : v[i + (n)]; v[i] = keep + __shfl_xor(send, (n)); } }
    CV_BFLY(32) CV_BFLY(16) CV_BFLY(8) CV_BFLY(4) CV_BFLY(2) CV_BFLY(1)
#undef CV_BFLY
    LAS float* red = (LAS float*)lds;
    red[wave * 64 + lane] = v[0];
    __syncthreads();
    float tot = 0.f;
#pragma unroll
    for (int w8 = 0; w8 < 8; ++w8) tot += red[w8 * 64 + lane];
    __syncthreads();
    const float sq = __shfl(tot, (lane & 31) + 32);
    const float mean = tot * (1.0f / DM);
    const float var = sq * (1.0f / DM) - mean * mean;
    const float rstd = __builtin_amdgcn_rsqf(fmaxf(var, 0.f) + LN_EPS);
#pragma unroll
    for (int t = 0; t < CV_T; ++t) {
        const float mt = __builtin_bit_cast(float, __builtin_amdgcn_readlane(__builtin_bit_cast(int, mean), t));
        const float rt = __builtin_bit_cast(float, __builtin_amdgcn_readlane(__builtin_bit_cast(int, rstd), t));
        float y0 = (acc[t].x - mt) * rt * lw.x + lb.x, y1 = (acc[t].y - mt) * rt * lw.y + lb.y;
        y0 = y0 * sigmoidf_(y0); y1 = y1 * sigmoidf_(y1);
        *(unsigned*)(CACT + (size_t)(row0 + t) * KC + ch) = pg8::cvt_pk_bf16(y0, y1);
    }
}
__device__ __forceinline__ void conv_phase(const Params& p, LAS unsigned char* lds, int vcu, int tid, int wave, int lane) {
    unsigned char* ws = p.ws;
    const bf16* U = (const bf16*)(ws + WS_B); bf16* CACT = (bf16*)(ws + WS_A) + DAO;
    const int ch = 2 * tid;
    f32x2 w[31];
#pragma unroll
    for (int i = 0; i < 31; ++i) w[i] = *(const f32x2*)(p.in[11] + (size_t)i * DM + ch);
    const f32x2 cb = *(const f32x2*)(p.in[12] + ch), lw = *(const f32x2*)(p.in[13] + ch), lb = *(const f32x2*)(p.in[14] + ch);
#pragma unroll 1
    for (int i = 0; i < CV_PER_WG; ++i) conv_unit(p, lds, U, CACT, vcu * CV_PER_WG + i, tid, wave, lane, w, cb, lw, lb);
    if (vcu < SB) {
        const int b = vcu;
        f32x2 u[34];
#pragma unroll
        for (int e = 0; e < 30; ++e) u[e] = *(const f32x2*)(p.in[5] + ((size_t)b * 30 + e) * DM + ch);
#pragma unroll
        for (int e = 30; e < 34; ++e) { const unsigned wv = *(const unsigned*)(U + (size_t)(MP + 4 * b + e - 30) * DM + ch); u[e] = (f32x2){bf_lo(wv), bf_hi(wv)}; }
        f32x2 acc[4]; float v[8];
#pragma unroll
        for (int s4 = 0; s4 < 4; ++s4) {
            acc[s4] = cb;
#pragma unroll
            for (int i = 0; i < 31; ++i) acc[s4] = acc[s4] + w[i] * u[s4 + i];
            v[s4] = acc[s4].x + acc[s4].y; v[4 + s4] = acc[s4].x * acc[s4].x + acc[s4].y * acc[s4].y;
        }
#pragma unroll
        for (int o = 1; o < 64; o <<= 1)
#pragma unroll
            for (int j = 0; j < 8; ++j) v[j] += __shfl_xor(v[j], o);
        LAS float* red = (LAS float*)lds;
        __syncthreads();
        if (lane < 8) {
            float mine = v[0];
#pragma unroll
            for (int j = 1; j < 8; ++j) mine = (lane == j) ? v[j] : mine;
            red[wave * 8 + lane] = mine;
        }
        __syncthreads();
#pragma unroll
        for (int s4 = 0; s4 < 4; ++s4) {
            float sm = 0.f, sq = 0.f;
#pragma unroll
            for (int w8 = 0; w8 < 8; ++w8) { sm += red[w8 * 8 + s4]; sq += red[w8 * 8 + 4 + s4]; }
            const float mean = sm * (1.0f / DM), var = sq * (1.0f / DM) - mean * mean, rstd = __builtin_amdgcn_rsqf(fmaxf(var, 0.f) + LN_EPS);
            float y0 = (acc[s4].x - mean) * rstd * lw.x + lb.x, y1 = (acc[s4].y - mean) * rstd * lw.y + lb.y;
            y0 = y0 * sigmoidf_(y0); y1 = y1 * sigmoidf_(y1);
            *(unsigned*)(CACT + (size_t)(MP + 4 * b + s4) * KC + ch) = pg8::cvt_pk_bf16(y0, y1);
        }
        __syncthreads();
    }
}

typedef float f32x4v __attribute__((ext_vector_type(4)));
template <int NRB, int NCB, int K>
__device__ __forceinline__ void thin_partial(LAS float* P, const bf16* A, int lda, const bf16* B0, const bf16* B1, int ldb, int wave, int lane) {
    constexpr int KW = K / 8, STEPS = KW / 32, ROWS = 16 * NRB, COLS = 16 * NCB;
    const int r16 = lane & 15, k8 = lane >> 4;
    f32x4v acc[NRB][NCB];
#pragma unroll
    for (int rb = 0; rb < NRB; ++rb)
#pragma unroll
        for (int cb = 0; cb < NCB; ++cb) acc[rb][cb] = (f32x4v){0.f, 0.f, 0.f, 0.f};
    const bf16* ap = A + (size_t)r16 * lda + wave * KW + 8 * k8;
    const bf16* bp0 = B0 + (size_t)r16 * ldb + wave * KW + 8 * k8;
    const bf16* bp1 = B1 + (size_t)r16 * ldb + wave * KW + 8 * k8;
#pragma unroll
    for (int st = 0; st < STEPS; ++st) {
        bf16x8 b[NCB];
        b[0] = *(const bf16x8*)(bp0 + 32 * st);
        if (NCB > 1) b[NCB - 1] = *(const bf16x8*)(bp1 + 32 * st);
#pragma unroll
        for (int rb = 0; rb < NRB; ++rb) {
            const bf16x8 a = *(const bf16x8*)(ap + (size_t)(16 * rb) * lda + 32 * st);
#pragma unroll
            for (int cb = 0; cb < NCB; ++cb) acc[rb][cb] = __builtin_amdgcn_mfma_f32_16x16x32_bf16(a, b[cb], acc[rb][cb], 0, 0, 0);
        }
    }
#pragma unroll
    for (int rb = 0; rb < NRB; ++rb)
#pragma unroll
        for (int cb = 0; cb < NCB; ++cb)
#pragma unroll
            for (int r = 0; r < 4; ++r) P[(wave * ROWS + 16 * rb + 4 * k8 + r) * COLS + 16 * cb + r16] = acc[rb][cb][r];
}
template <int ROWS, int COLS> __device__ __forceinline__ float thin_sum(const LAS float* P, int r, int c) {
    float v = 0.f;
#pragma unroll
    for (int w = 0; w < 8; ++w) v += P[(w * ROWS + r) * COLS + c];
    return v;
}
template <int STAGE> __device__ __forceinline__ void thin_stage(const Params& p, LAS unsigned char* lds, int vcu, int tid, int wave, int lane) {
    unsigned char* ws = p.ws;
    LAS float* P = (LAS float*)lds;
    if constexpr (STAGE == 0 || STAGE == 1 || STAGE == 2 || STAGE == 4) {
        constexpr int K = (STAGE == 0) ? DAO : (STAGE == 4) ? DFF : DM;
        constexpr int LDA = (STAGE <= 1) ? KC : K, LDB = (STAGE <= 1) ? KC : K;
        const bf16* A = (STAGE == 0) ? (const bf16*)(ws + WS_A) : (STAGE == 1) ? (const bf16*)(ws + WS_A) + DAO : (STAGE == 2) ? (const bf16*)(ws + WS_B) : (const bf16*)(ws + WS_ACT);
        const bf16* B = (STAGE == 0) ? (const bf16*)(ws + WS_WCAT) : (STAGE == 1) ? (const bf16*)(ws + WS_WCAT) + DAO : (STAGE == 2) ? (const bf16*)(ws + WS_WOUT) : (const bf16*)(ws + WS_WD);
        const int ct = vcu & 63, rb = vcu >> 6, row0 = MP + 32 * rb, col0 = 16 * ct;
        thin_partial<2, 1, K>(P, A + (size_t)row0 * LDA, LDA, B + (size_t)col0 * LDB, B + (size_t)col0 * LDB, LDB, wave, lane);
        __syncthreads();
        const int r = tid >> 4, c = tid & 15, row = row0 + r, col = col0 + c;
        const float acc = thin_sum<32, 16>(P, r, c);
        if constexpr (STAGE == 0) {
            const bf16* GA = (const bf16*)(ws + WS_GA); bf16* HA = (bf16*)(ws + WS_B);
            HA[(size_t)row * DM + col] = (bf16)f2bf(acc * ((float)((const unsigned char*)GA)[(size_t)row * DM + col] * (1.0f / 255.0f)));
        } else if constexpr (STAGE == 1) {
            const bf16* GB = (const bf16*)(ws + WS_GB); bf16* H = (bf16*)(ws + WS_B);
            H[(size_t)row * DM + col] = (bf16)f2bf(acc * ((float)((const unsigned char*)GB)[(size_t)row * DM + col] * (1.0f / 255.0f)) + bf_lo((unsigned)H[(size_t)row * DM + col]));
        } else if constexpr (STAGE == 2) {
            const float x1 = p.in[1][(size_t)(row - MP) * DM + col] + acc;
            p.out[(size_t)row * DM + col] = x1;
            ((bf16*)(ws + WS_A))[(size_t)row * DM + col] = (bf16)f2bf(x1);
            float ss = x1 * x1;
            ss += __shfl_xor(ss, 1); ss += __shfl_xor(ss, 2); ss += __shfl_xor(ss, 4); ss += __shfl_xor(ss, 8);
            if (c == 0) ((float*)(ws + WS_SSS))[(size_t)(row - MP) * 64 + ct] = ss;
        } else {
            p.out[(size_t)row * DM + col] += acc;
        }
        __syncthreads();
    } else {
        const bf16* A = (const bf16*)(ws + WS_A); const bf16* B = (const bf16*)(ws + WS_WGU); bf16* ACT = (bf16*)(ws + WS_ACT);
        const float* SSS = (const float*)(ws + WS_SSS);
        for (int u = vcu; u < 352; u += 256) {
            const int ct = u % 176, rb = u / 176, row0 = MP + 64 * rb, ch0 = 16 * ct;
            const int bpos = (ch0 >> 7) * 256 + (ch0 & 127);
            thin_partial<4, 2, DM>(P, A + (size_t)row0 * DM, DM, B + (size_t)bpos * DM, B + (size_t)(bpos + 128) * DM, DM, wave, lane);
            __syncthreads();
#pragma unroll
            for (int i = 0; i < 2; ++i) {
                const int e = tid + 512 * i, r = e >> 4, c = e & 15, row = row0 + r;
                const f32x4 sv = *(const f32x4*)(SSS + (size_t)(row - MP) * 64 + 4 * c);
                float tot = (sv[0] + sv[1]) + (sv[2] + sv[3]);
                tot += __shfl_xor(tot, 1); tot += __shfl_xor(tot, 2); tot += __shfl_xor(tot, 4); tot += __shfl_xor(tot, 8);
                const float rstd = __builtin_amdgcn_rsqf(tot * (1.0f / DM) + RMS_EPS);
                const float g = thin_sum<64, 32>(P, r, c) * rstd, up = thin_sum<64, 32>(P, r, 16 + c) * rstd;
                ACT[(size_t)row * DFF + ch0 + c] = (bf16)f2bf(g * sigmoidf_(g) * up);
            }
            __syncthreads();
        }
    }
}

__device__ __forceinline__ void tr_item(const float* W, int ldw, int K, bf16* WT, int k0, int pos0, int src0, const float* ksc, LAS float* scr, int lane, int kdst = 0) {
    const int kr = lane >> 3, n4 = lane & 7;
    f32x4 v[8];
#pragma unroll
    for (int i = 0; i < 8; ++i) v[i] = __builtin_nontemporal_load((const GAS f32x4*)(W + (size_t)(k0 + kr + 8 * i) * ldw + src0 + 4 * n4));
#pragma unroll
    for (int i = 0; i < 8; ++i) {
        const int kk = kr + 8 * i;
        const float sc = ksc ? ksc[k0 + kk] : 1.0f;
        LAS float* d = scr + kk * 33 + 4 * n4;
        d[0] = v[i].x * sc; d[1] = v[i].y * sc; d[2] = v[i].z * sc; d[3] = v[i].w * sc;
    }
    LDS_WAIT(); asm volatile("" ::: "memory");
    const int c = lane & 7;
#pragma unroll
    for (int j = 0; j < 4; ++j) { const int n = (lane >> 3) + 8 * j; const LAS float* s = scr + (8 * c) * 33 + n;
        v4u o; o.x = pk2(s[0 * 33], s[1 * 33]); o.y = pk2(s[2 * 33], s[3 * 33]); o.z = pk2(s[4 * 33], s[5 * 33]); o.w = pk2(s[6 * 33], s[7 * 33]);
        *(GAS v4u*)(WT + (size_t)(pos0 + n) * K + kdst + k0 + 8 * c) = o; }
    LDS_WAIT(); asm volatile("" ::: "memory");
}
__device__ __forceinline__ int w1_src(int pos0) {
    const int pn = pos0 >> 8, p = pos0 & 255;
    if (pn < 9) { const int seg = pn / 3, g = pn - 3 * seg; return seg * 768 + g * 256 + 64 * ((p >> 5) & 3) + 32 * (p >> 7); }
    if (pn < 17) { return ((p < 128) ? 2304 : 3328) + 128 * (pn - 9) + (p & 127); }
    return pos0;
}
__device__ __forceinline__ int wgu_src(int pos0) { const int pn = pos0 >> 8, p = pos0 & 255; return ((p < 128) ? 0 : DFF) + 128 * pn + (p & 127); }

__device__ __forceinline__ void tr_load(const float* W, int ldw, int k0, int src0, int lane, f32x4 (&v)[8]) {
    const int kr = lane >> 3, n4 = lane & 7;
#pragma unroll
    for (int i = 0; i < 8; ++i) v[i] = __builtin_nontemporal_load((const GAS f32x4*)(W + (size_t)(k0 + kr + 8 * i) * ldw + src0 + 4 * n4));
}
__device__ __forceinline__ void tr_store(const f32x4 (&v)[8], int K, bf16* WT, int k0, int pos0, const float* ksc, LAS float* scr, int lane, int kdst) {
    const int kr = lane >> 3, n4 = lane & 7;
#pragma unroll
    for (int i = 0; i < 8; ++i) {
        const int kk = kr + 8 * i;
        const float sc = ksc ? ksc[k0 + kk] : 1.0f;
        LAS float* d = scr + kk * 33 + 4 * n4;
        d[0] = v[i].x * sc; d[1] = v[i].y * sc; d[2] = v[i].z * sc; d[3] = v[i].w * sc;
    }
    LDS_WAIT(); asm volatile("" ::: "memory");
    const int c = lane & 7;
#pragma unroll
    for (int j = 0; j < 4; ++j) { const int n = (lane >> 3) + 8 * j; const LAS float* s = scr + (8 * c) * 33 + n;
        v4u o; o.x = pk2(s[0 * 33], s[1 * 33]); o.y = pk2(s[2 * 33], s[3 * 33]); o.z = pk2(s[4 * 33], s[5 * 33]); o.w = pk2(s[6 * 33], s[7 * 33]);
        *(GAS v4u*)(WT + (size_t)(pos0 + n) * K + kdst + k0 + 8 * c) = o; }
    LDS_WAIT(); asm volatile("" ::: "memory");
}
constexpr int LW_ATT = 4 * 32, LW_CO = 16 * 32, LW_OUT = 16 * 32, LW_GU = 16 * (NGU / 32), LW_D = (DFF / 64) * 32, LW_ITEMS = LW_ATT + LW_CO + LW_OUT + LW_GU + LW_D;
__device__ __forceinline__ void lw_load(const Params& p, int it, int lane, f32x4 (&v)[8]) {
    int r = it;
    if (r >= LW_ITEMS) return;
    if (r < LW_ATT) { tr_load(p.in[10], DM, 64 * (r / 32), 32 * (r % 32), lane, v); return; } r -= LW_ATT;
    if (r < LW_CO) { tr_load(p.in[15], DM, 64 * (r / 32), 32 * (r % 32), lane, v); return; } r -= LW_CO;
    if (r < LW_OUT) { tr_load(p.in[16], DM, 64 * (r / 32), 32 * (r % 32), lane, v); return; } r -= LW_OUT;
    if (r < LW_GU) { tr_load(p.in[18], NGU, 64 * (r / (NGU / 32)), wgu_src(32 * (r % (NGU / 32))), lane, v); return; } r -= LW_GU;
    tr_load(p.in[19], DM, 64 * (r / 32), 32 * (r % 32), lane, v);
}
__device__ __forceinline__ void lw_store(const Params& p, int it, int lane, const f32x4 (&v)[8], LAS float* scr) {
    unsigned char* ws = p.ws;
    int r = it;
    if (r >= LW_ITEMS) return;
    if (r < LW_ATT) { tr_store(v, KC, (bf16*)(ws + WS_WCAT), 64 * (r / 32), 32 * (r % 32), nullptr, scr, lane, 0); return; } r -= LW_ATT;
    if (r < LW_CO) { tr_store(v, KC, (bf16*)(ws + WS_WCAT), 64 * (r / 32), 32 * (r % 32), nullptr, scr, lane, DAO); return; } r -= LW_CO;
    if (r < LW_OUT) { tr_store(v, DM, (bf16*)(ws + WS_WOUT), 64 * (r / 32), 32 * (r % 32), nullptr, scr, lane, 0); return; } r -= LW_OUT;
    if (r < LW_GU) { tr_store(v, DM, (bf16*)(ws + WS_WGU), 64 * (r / (NGU / 32)), 32 * (r % (NGU / 32)), p.in[17], scr, lane, 0); return; } r -= LW_GU;
    tr_store(v, DFF, (bf16*)(ws + WS_WD), 64 * (r / 32), 32 * (r % 32), nullptr, scr, lane, 0);
}
__device__ __forceinline__ void late_weights(const Params& p, LAS unsigned char* lds, int idx, int nwk, int wave, int lane) {
    LAS float* scr = (LAS float*)(lds + wave * 16384);
    const int stride = nwk * NWAVES;
    for (int it = idx * NWAVES + wave; it < LW_ITEMS; it += 4 * stride) {
        f32x4 v[4][8];
#pragma unroll
        for (int q = 0; q < 4; ++q) lw_load(p, it + q * stride, lane, v[q]);
#pragma unroll
        for (int q = 0; q < 4; ++q) lw_store(p, it + q * stride, lane, v[q], scr);
    }
}
__device__ __forceinline__ void copy_rows(const float* src, float* dst, int rows, int per, int rw, int gt, int NGT) {
    const int n4b = rows * rw, tot = SB * n4b;
    for (int i0 = gt; i0 < tot; i0 += 8 * NGT) {
        f32x4 v[8];
#pragma unroll
        for (int j = 0; j < 8; ++j) { const int i = i0 + j * NGT; if (i < tot) { const int b = i / n4b, r = i - b * n4b; v[j] = __builtin_nontemporal_load((const GAS f32x4*)src + (size_t)b * per * rw + 4 * rw + r); } }
#pragma unroll
        for (int j = 0; j < 8; ++j) { const int i = i0 + j * NGT; if (i < tot) { const int b = i / n4b, r = i - b * n4b; __builtin_nontemporal_store(v[j], (GAS f32x4*)dst + (size_t)b * per * rw + r); } }
    }
}
__device__ __forceinline__ void p0_prologue(const Params& p, LAS unsigned char* lds, int vcu, int G, int wave, int lane) {
    unsigned char* ws = p.ws;
    LAS float* scr = (LAS float*)(lds + wave * 16384);
    const int gw = vcu * NWAVES + wave, NGW = G * NWAVES;
    constexpr int I_W1 = 16 * (NIN / 32);
    for (int r = gw; r < I_W1; r += NGW) { const int nb = r % (NIN / 32), kb = r / (NIN / 32); tr_item(p.in[7], NIN, DM, (bf16*)(ws + WS_W1), 64 * kb, 32 * nb, w1_src(32 * nb), nullptr, scr, lane); }
    bf16* XN = (bf16*)(ws + WS_A);
    const float* nw = p.in[6];
    f32x4 wv[4];
#pragma unroll
    for (int j = 0; j < 4; ++j) wv[j] = *((const f32x4*)nw + lane + 64 * j);
    for (int m0 = gw; m0 < MR; m0 += 2 * NGW) {
        f32x4 v[2][4];
#pragma unroll
        for (int q = 0; q < 2; ++q) {
            const int m = m0 + q * NGW;
            if (m < MV) {
                const float* xrow = (m < MP) ? p.in[0] + (size_t)m * DM : p.in[1] + (size_t)(m - MP) * DM;
                const GAS f32x4* xr = (const GAS f32x4*)xrow + lane;
#pragma unroll
                for (int j = 0; j < 4; ++j) v[q][j] = __builtin_nontemporal_load(xr + 64 * j);
            } else {
#pragma unroll
                for (int j = 0; j < 4; ++j) v[q][j] = (f32x4){0.f, 0.f, 0.f, 0.f};
            }
        }
#pragma unroll
        for (int q = 0; q < 2; ++q) {
            const int m = m0 + q * NGW;
            if (m < MR) {
                float s = 0.f;
#pragma unroll
                for (int j = 0; j < 4; ++j) s += (v[q][j].x * v[q][j].x + v[q][j].y * v[q][j].y) + (v[q][j].z * v[q][j].z + v[q][j].w * v[q][j].w);
                const float rstd = __builtin_amdgcn_rsqf(wave_sum(s) * (1.f / DM) + RMS_EPS);
                GAS unsigned long long* o8 = (GAS unsigned long long*)(XN + (size_t)m * DM) + lane;
#pragma unroll
                for (int j = 0; j < 4; ++j) { const f32x4 y = v[q][j] * rstd * wv[j]; o8[64 * j] = (unsigned long long)pk2(y.x, y.y) | ((unsigned long long)pk2(y.z, y.w) << 32); }
            }
        }
    }
}

__global__ void __launch_bounds__(NWAVES * 64, 2) fwd_kernel(Params p) {
    extern __shared__ __attribute__((aligned(16))) unsigned char lds_raw[];
    LAS unsigned char* lds = (LAS unsigned char*)lds_raw;
    volatile LAS unsigned* MISC = (volatile LAS unsigned*)(lds + MISC_OFF);
    const int tid = threadIdx.x, lane = tid & 63, wave = __builtin_amdgcn_readfirstlane(tid >> 6);
    const int G = gridDim.x; const int bx = blockIdx.x; const int vcu = (G % 8 == 0) ? (bx % 8) * (G / 8) + bx / 8 : bx;
    unsigned char* ws = p.ws;
    gu32* ctl = (gu32*)(ws + WS_CTL);
    for (int u = tid; u < (LDS_BYTES - LDSCTL_OFF) / 4; u += NWAVES * 64) ((LAS unsigned*)(lds + LDSCTL_OFF))[u] = 0u;
    __syncthreads();
    XcdBarrier bar = xcd_barrier_post((unsigned*)(ctl + CW_BAR), MISC + 8);
    const int lo = p.ph_lo, hi = p.ph_hi;
#define IN(k) (lo <= (k) && (k) < hi)
#define BOTH(k) (IN(k) && IN((k) + 1))

#if PH_MASK & 1
    if (IN(0)) { p0_prologue(p, lds, vcu, G, wave, lane); if (BOTH(0)) xcd_barrier(bar); }
#endif

#if PH_MASK & (1 << 1)
    if (IN(1)) {
        pg8::Gemm g{(const bf16*)(ws + WS_A), (const bf16*)(ws + WS_W1), MR, NIN, DM}; pg8::StaticOrder S; S.init(MR, NIN, G, bx);
        EpiP1 E{(bf16*)(ws + WS_Q), (bf16*)(ws + WS_K), (bf16*)(ws + WS_V), (bf16*)(ws + WS_B), (bf16*)(ws + WS_GA), (bf16*)(ws + WS_GB), (float*)(ws + WS_SQ), p.out, p.in[8], p.in[9], CopyCtx{p.in[2], p.in[3], p.in[4], p.in[5], p.out}};
        {
            const int nwg = (MR / 256) * (NIN / 256), nfull = nwg % G;
            if (nfull == 0) late_weights(p, lds, bx, G, wave, lane);
            else if (bx >= nfull) late_weights(p, lds, bx - nfull, G - nfull, wave, lane);
        }
        __syncthreads();
        pg8::gemm_phase<EpiP1, pg8::StaticOrder, true, true>(lds, g, S, E);
        if (BOTH(1)) xcd_barrier(bar);
    }
#endif

#if PH_MASK & (1 << 2)
    if (IN(2)) {
        attn_phase_mfma(p, lds, vcu, tid, wave, lane);
        if (wave < 6) attn_sample_unit(p, (LAS float*)(lds + 8192 + wave * 1024), wave * 256 + vcu, lane);
        __syncthreads();
        if (BOTH(2)) xcd_barrier(bar);
    }
#endif
#if PH_MASK & (1 << 3)
    if (IN(3)) {
        if (vcu & 1) { conv_phase(p, lds, vcu, tid, wave, lane); merge_phase(p, vcu, G, tid); }
        else { merge_phase(p, vcu, G, tid); conv_phase(p, lds, vcu, tid, wave, lane); }
        if (BOTH(3)) xcd_barrier(bar);
    }
#endif
#if PH_MASK & (1 << 4)
    if (IN(4)) {
        thin_stage<0>(p, lds, vcu, tid, wave, lane);
        thin_stage<1>(p, lds, vcu, tid, wave, lane);
        int k_cat = KC; asm volatile("" : "+s"(k_cat));
        pg8::Gemm g{(const bf16*)(ws + WS_A), (const bf16*)(ws + WS_WCAT), MP, DM, k_cat}; pg8::StaticOrder S; S.init(MP, DM, G, bx);
        EpiGateF E{(const unsigned char*)(ws + WS_GA), (const unsigned char*)(ws + WS_GB), (bf16*)(ws + WS_B)};
        pg8::gemm_phase<EpiGateF, pg8::StaticOrder, true, true>(lds, g, S, E);
        if (BOTH(4)) xcd_barrier(bar);
    }
#endif
#if PH_MASK & (1 << 6)
    if (IN(6)) {
        thin_stage<2>(p, lds, vcu, tid, wave, lane);
        pg8::Gemm g{(const bf16*)(ws + WS_B), (const bf16*)(ws + WS_WOUT), MP, DM, DM}; pg8::StaticOrder S; S.init(MP, DM, G, bx);
        EpiX1 E{p.in[0], p.in[1], p.out, (bf16*)(ws + WS_A), (float*)(ws + WS_SS)};
        pg8::gemm_phase<EpiX1, pg8::StaticOrder, true, true>(lds, g, S, E);
        if (BOTH(6)) xcd_barrier(bar);
    }
#endif
#if PH_MASK & (1 << 7)
    if (IN(7)) {
        thin_stage<3>(p, lds, vcu, tid, wave, lane);
        pg8::Gemm g{(const bf16*)(ws + WS_A), (const bf16*)(ws + WS_WGU), MP, NGU, DM}; pg8::StaticOrder S; S.init(MP, NGU, G, bx);
        EpiAct E{(const float*)(ws + WS_SS), (bf16*)(ws + WS_ACT), CopyCtx{p.in[2], p.in[3], p.in[4], p.in[5], p.out}};
        pg8::gemm_phase<EpiAct, pg8::StaticOrder, true, true>(lds, g, S, E);
        if (BOTH(7)) xcd_barrier(bar);
    }
#endif
#if PH_MASK & (1 << 8)
    if (IN(8)) {
        thin_stage<4>(p, lds, vcu, tid, wave, lane);
        pg8::Gemm g{(const bf16*)(ws + WS_ACT), (const bf16*)(ws + WS_WD), MP, DM, DFF}; pg8::StaticOrder S; S.init(MP, DM, G, bx);
        EpiOut E{p.out, (const bf16*)(ws + WS_A)};
        pg8::gemm_phase<EpiOut, pg8::StaticOrder, true, true>(lds, g, S, E);
    }
#endif
#undef IN
#undef BOTH
}

extern "C" void kernel_launch(void* const* d_in, const int* in_sizes, int n_in, void* d_out, int out_size, void* d_ws, size_t ws_size, hipStream_t stream) {
    static int grid = 0;
    if (grid == 0) {
        if (n_in != 20 || (size_t)out_size != O_TOTAL || ws_size < WS_END) { fprintf(stderr, "kernel_launch: unexpected sizes n_in %d out %d ws %zu\n", n_in, out_size, ws_size); grid = -1; return; }
        int dev = 0, cus = 0, per_cu = 0;
        if (hipGetDevice(&dev) != hipSuccess || hipDeviceGetAttribute(&cus, hipDeviceAttributeMultiprocessorCount, dev) != hipSuccess) { grid = -1; return; }
        if (hipFuncSetAttribute((const void*)fwd_kernel, hipFuncAttributeMaxDynamicSharedMemorySize, LDS_BYTES) != hipSuccess) { fprintf(stderr, "kernel_launch: hipFuncSetAttribute failed\n"); grid = -1; return; }
        if (hipOccupancyMaxActiveBlocksPerMultiprocessor(&per_cu, (const void*)fwd_kernel, NWAVES * 64, LDS_BYTES) != hipSuccess || per_cu < 1)
            fprintf(stderr, "kernel_launch: occupancy query reports %d\n", per_cu);
        (void)hipGetLastError();
        if (cus < 256) { fprintf(stderr, "kernel_launch: needs 256 CUs (one resident workgroup each), device has %d\n", cus); grid = -1; return; }
        grid = 256;
    }
    if (grid < 0) return;
    if (hipMemsetAsync((char*)d_ws + WS_CTL, 0, CTL_ZERO_BYTES, stream) != hipSuccess) return;
    Params a{};
    for (int i = 0; i < 20; ++i) a.in[i] = (const float*)d_in[i];
    a.out = (float*)d_out; a.ws = (unsigned char*)d_ws; a.ph_lo = 0; a.ph_hi = 16;
    hipLaunchKernelGGL(fwd_kernel, dim3(grid), dim3(NWAVES * 64), LDS_BYTES, stream, a);
}
```

```cpp
#include <hip/hip_runtime.h>
#include <cstdio>
#include <cstdint>
namespace pg8 {
#define PG8_LAS __attribute__((address_space(3)))
typedef unsigned short bf16_t;
typedef short bf16x8 __attribute__((ext_vector_type(8)));
typedef float f32x4 __attribute__((ext_vector_type(4)));
typedef unsigned u32x4 __attribute__((ext_vector_type(4)));
constexpr int BM = 256, BK = 64, HALF = 128, HTB = HALF * BK * 2  , STAGE_BYTES = 8 * HTB, NXCD = 8, WGM = 8;

__host__ __device__ __forceinline__ int lds_byte(int r, int c) { const int st = (r >> 4) * 2 + (c >> 5), rr = r & 15, cc = c & 31, ob = rr * 64 + cc * 2; return st * 1024 + (ob ^ (((ob >> 9) & 1) << 5)); }
__host__ __device__ __forceinline__ void stage_rc(int b, int& R, int& C) { const int st = b / 1024, sb = b % 1024, swz = sb ^ (((sb >> 9) & 1) << 5); R = (st >> 1) * 16 + swz / 64; C = (st & 1) * 32 + (swz % 64) / 2; }
__host__ __device__ __forceinline__ int perm32(int rho) { const int n = rho >> 4, i = rho & 15; return 8 * (i >> 2) + 4 * n + (i & 3); }

struct Unit { int pm, pn; };
struct Gemm { const bf16_t* A; const bf16_t* Bt; int M, N, K; };

struct StaticOrder {
    int nM, nN, nwg, G, c;
    __host__ __device__ void init(int M, int N, int G_, int c_) { nM = M / BM; nN = N / BM; nwg = nM * nN; G = G_; c = c_; }
    __host__ __device__ bool next(int i, Unit& u) const {
        const long L = (long)i * G + c; if (L >= nwg) return false;
        int wgid = (int)L; { const int q = nwg / NXCD, r = nwg % NXCD, xcd = wgid % NXCD, off = wgid / NXCD; wgid = (xcd < r ? xcd * (q + 1) : r * (q + 1) + (xcd - r) * q) + off; }
        const int nig = WGM * nN, gid = wgid / nig, fm = gid * WGM, gsz = (nM - fm) < WGM ? (nM - fm) : WGM;
        u.pm = fm + ((wgid % nig) % gsz); u.pn = (wgid % nig) / gsz; return true;
    }
    __device__ __forceinline__ void a_ready(const Unit&) const {}
    __device__ __forceinline__ void done(const Unit&) const {}
};
typedef float f32x2_cv __attribute__((ext_vector_type(2))); typedef __bf16 bf16x2_cv __attribute__((ext_vector_type(2)));
__device__ __forceinline__ unsigned cvt_pk_bf16(float lo, float hi) { f32x2_cv v = {lo, hi}; bf16x2_cv b = __builtin_convertvector(v, bf16x2_cv); return __builtin_bit_cast(unsigned, b); }
typedef float f32x2 __attribute__((ext_vector_type(2)));
template <class Epi, class Sched, bool ALIGN_EPI = false, bool SP2 = false>
__device__ __forceinline__ void gemm_phase(PG8_LAS unsigned char* lds, const Gemm g, const Sched& S, const Epi& E) {
    const int tid = threadIdx.x, wid = __builtin_amdgcn_readfirstlane(tid >> 6), lane = tid & 63, wr = wid >> 2, wc = wid & 3, fr = lane & 15, fq = lane >> 4;
    const int K = g.K, nt = K / BK;
    unsigned voffA[2], voffB[2];
#pragma unroll
    for (int i = 0; i < 2; ++i) { int R, C; stage_rc(tid * 16 + i * 8192, R, C); const int Rb = Epi::PERM ? ((R & ~31) + perm32(R & 31)) : R;
        voffA[i] = (unsigned)(R * K + C) * 2u; voffB[i] = (unsigned)(Rb * K + C) * 2u; }
    const size_t kstep = (size_t)(BK * 2);
    const size_t hstep = (size_t)HALF * K * 2;
    const size_t tstep = 2 * hstep;
    const unsigned ldsw = (unsigned)wid * 1024u;
    const int aoff = lds_byte(wr * 64 + fr, fq * 8), boff = lds_byte(wc * 32 + fr, fq * 8);
#define PG8_SA(b, h) (((b) * 2 + (h)) * HTB)
#define PG8_SB(b, h) ((4 + (b) * 2 + (h)) * HTB)
#define PG8_STAGE(bufoff, gbase, voff) do { _Pragma("unroll") for (int _i = 0; _i < 2; ++_i) \
        __builtin_amdgcn_global_load_lds((const unsigned*)((const char*)(gbase) + (voff)[_i]), (PG8_LAS unsigned*)(lds + (bufoff) + ldsw + _i * 8192), 16, 0, 0); } while (0)
#define PG8_LDA(dst, b, h) do { _Pragma("unroll") for (int m = 0; m < 4; ++m) _Pragma("unroll") for (int k = 0; k < 2; ++k) dst[m][k] = *(const PG8_LAS bf16x8*)(lds + PG8_SA(b, h) + aoff + m * 2048 + k * 1024); } while (0)
#define PG8_LDB(dst, b, h) do { _Pragma("unroll") for (int n = 0; n < 2; ++n) _Pragma("unroll") for (int k = 0; k < 2; ++k) dst[n][k] = *(const PG8_LAS bf16x8*)(lds + PG8_SB(b, h) + boff + n * 2048 + k * 1024); } while (0)
#define PG8_MMA(ai, bj, At, Bt) do { __builtin_amdgcn_s_setprio(1); _Pragma("unroll") for (int m = 0; m < 4; ++m) _Pragma("unroll") for (int n = 0; n < 2; ++n) _Pragma("unroll") for (int k = 0; k < 2; ++k) \
        acc[ai][bj][m][n] = __builtin_amdgcn_mfma_f32_16x16x32_bf16(Bt[n][k], At[m][k], acc[ai][bj][m][n], 0, 0, 0); __builtin_amdgcn_s_setprio(0); } while (0)
#define PG8_WAIT_V(n) asm volatile("s_waitcnt vmcnt(" #n ")" ::: "memory")
#define PG8_WAIT_L(n) asm volatile("s_waitcnt lgkmcnt(" #n ")" ::: "memory")
#define PG8_BAR __builtin_amdgcn_s_barrier()
#define PG8_SCHED __builtin_amdgcn_sched_barrier(0)
    Unit cur, nxt; int ui = 0;
    if (!S.next(0, cur)) return;
    f32x4 acc[2][2][4][2];
#pragma unroll
    for (int a = 0; a < 2; ++a)
#pragma unroll
        for (int b = 0; b < 2; ++b)
#pragma unroll
            for (int m = 0; m < 4; ++m)
#pragma unroll
                for (int n = 0; n < 2; ++n) acc[a][b][m][n] = (f32x4){0.f, 0.f, 0.f, 0.f};
    bf16x8 At[4][2], B0[2][2], B1[2][2];
    const char* cA = (const char*)g.A + (size_t)cur.pm * tstep; const char* cB = (const char*)g.Bt + (size_t)cur.pn * tstep;
    S.a_ready(cur);
    if constexpr (SP2) {
        PG8_STAGE(PG8_SB(0, 0), cB, voffB); PG8_STAGE(PG8_SB(0, 1), cB + hstep, voffB); PG8_STAGE(PG8_SA(0, 0), cA, voffA); PG8_STAGE(PG8_SA(0, 1), cA + hstep, voffA);
        if (wr == 1) PG8_BAR;
        PG8_WAIT_V(2); PG8_BAR;
        PG8_STAGE(PG8_SB(1, 0), cB + kstep, voffB); PG8_STAGE(PG8_SA(1, 0), cA + kstep, voffA); PG8_STAGE(PG8_SB(1, 1), cB + hstep + kstep, voffB);
        PG8_WAIT_V(6); PG8_BAR;
    } else {
        PG8_STAGE(PG8_SB(0, 0), cB, voffB); PG8_STAGE(PG8_SA(0, 0), cA, voffA); PG8_STAGE(PG8_SB(0, 1), cB + hstep, voffB); PG8_STAGE(PG8_SA(0, 1), cA + hstep, voffA);
        if (wr == 1) PG8_BAR;
        PG8_WAIT_V(4); PG8_BAR;
        PG8_STAGE(PG8_SB(1, 0), cB + kstep, voffB); PG8_STAGE(PG8_SA(1, 0), cA + kstep, voffA); PG8_STAGE(PG8_SB(1, 1), cB + hstep + kstep, voffB);
        PG8_WAIT_V(6); PG8_BAR;
    }
    for (;;) {
        const bool has_next = S.next(ui + 1, nxt);
        const char* nA = has_next ? (const char*)g.A + (size_t)nxt.pm * tstep : cA; const char* nB = has_next ? (const char*)g.Bt + (size_t)nxt.pn * tstep : cB;
        if constexpr (Epi::HAS_MID) {
            int tmid = Epi::MID_T; asm volatile("" : "+s"(tmid));
#pragma unroll 1
            for (int t = 0; t < tmid; t += 2) {
            { const bool last = false;
            asm volatile("" : "+s"(cA), "+s"(cB));
            const char* a1 = cA + (size_t)(t + 1) * kstep;
            const char* a2 = last ? nA : cA + (size_t)(t + 2) * kstep; const char* b2 = last ? nB : cB + (size_t)(t + 2) * kstep;
            const char* a3 = a2 + kstep; const char* b3 = b2 + kstep;
            if (last && has_next) S.a_ready(nxt);
            PG8_LDB(B0, 0, 0); PG8_LDB(B1, 0, 1); PG8_SCHED; PG8_LDA(At, 0, 0); PG8_STAGE(PG8_SA(1, 1), a1 + hstep, voffA);
            PG8_WAIT_V(8); PG8_WAIT_L(0); PG8_BAR; PG8_MMA(0, 0, At, B0); PG8_MMA(0, 1, At, B1); PG8_BAR; PG8_SCHED;
            PG8_LDA(At, 0, 1); PG8_STAGE(PG8_SB(0, 0), b2, voffB); PG8_STAGE(PG8_SB(0, 1), b2 + hstep, voffB); PG8_STAGE(PG8_SA(0, 0), a2, voffA);
            PG8_WAIT_V(8); PG8_WAIT_L(0); PG8_BAR; PG8_MMA(1, 0, At, B0); PG8_MMA(1, 1, At, B1); PG8_BAR; PG8_SCHED;
            PG8_LDB(B0, 1, 0); PG8_LDB(B1, 1, 1); PG8_SCHED; PG8_LDA(At, 1, 0); PG8_STAGE(PG8_SA(0, 1), a2 + hstep, voffA);
            PG8_WAIT_V(8); PG8_WAIT_L(0); PG8_BAR; PG8_MMA(0, 0, At, B0); PG8_MMA(0, 1, At, B1); PG8_BAR; PG8_SCHED;
            PG8_LDA(At, 1, 1); PG8_STAGE(PG8_SB(1, 0), b3, voffB); PG8_STAGE(PG8_SB(1, 1), b3 + hstep, voffB); PG8_STAGE(PG8_SA(1, 0), a3, voffA);
            PG8_WAIT_V(8); PG8_WAIT_L(0); PG8_BAR; PG8_MMA(1, 0, At, B0); PG8_MMA(1, 1, At, B1); PG8_BAR; PG8_SCHED;
            }
            }
            E.mid(acc, cur, wr, wc, fr, fq);
#pragma unroll 1
            for (int t = tmid; t < nt; t += 2) {
            { const bool last = (t == nt - 2);
            asm volatile("" : "+s"(cA), "+s"(cB));
            const char* a1 = cA + (size_t)(t + 1) * kstep;
            const char* a2 = last ? nA : cA + (size_t)(t + 2) * kstep; const char* b2 = last ? nB : cB + (size_t)(t + 2) * kstep;
            const char* a3 = a2 + kstep; const char* b3 = b2 + kstep;
            if (last && has_next) S.a_ready(nxt);
            PG8_LDB(B0, 0, 0); PG8_LDB(B1, 0, 1); PG8_SCHED; PG8_LDA(At, 0, 0); PG8_STAGE(PG8_SA(1, 1), a1 + hstep, voffA);
            PG8_WAIT_V(8); PG8_WAIT_L(0); PG8_BAR; PG8_MMA(0, 0, At, B0); PG8_MMA(0, 1, At, B1); PG8_BAR; PG8_SCHED;
            PG8_LDA(At, 0, 1); PG8_STAGE(PG8_SB(0, 0), b2, voffB); PG8_STAGE(PG8_SB(0, 1), b2 + hstep, voffB); PG8_STAGE(PG8_SA(0, 0), a2, voffA);
            PG8_WAIT_V(8); PG8_WAIT_L(0); PG8_BAR; PG8_MMA(1, 0, At, B0); PG8_MMA(1, 1, At, B1); PG8_BAR; PG8_SCHED;
            PG8_LDB(B0, 1, 0); PG8_LDB(B1, 1, 1); PG8_SCHED; PG8_LDA(At, 1, 0); PG8_STAGE(PG8_SA(0, 1), a2 + hstep, voffA);
            PG8_WAIT_V(8); PG8_WAIT_L(0); PG8_BAR; PG8_MMA(0, 0, At, B0); PG8_MMA(0, 1, At, B1); PG8_BAR; PG8_SCHED;
            PG8_LDA(At, 1, 1); PG8_STAGE(PG8_SB(1, 0), b3, voffB); PG8_STAGE(PG8_SB(1, 1), b3 + hstep, voffB); PG8_STAGE(PG8_SA(1, 0), a3, voffA);
            PG8_WAIT_V(8); PG8_WAIT_L(0); PG8_BAR; PG8_MMA(1, 0, At, B0); PG8_MMA(1, 1, At, B1); PG8_BAR; PG8_SCHED;
            }
            }
        } else
        for (int t = 0; t < nt; t += 2) {
            const bool last = (t == nt - 2);
            const char* a1 = cA + (size_t)(t + 1) * kstep;
            const char* a2 = last ? nA : cA + (size_t)(t + 2) * kstep; const char* b2 = last ? nB : cB + (size_t)(t + 2) * kstep;
            const char* a3 = a2 + kstep; const char* b3 = b2 + kstep;
            if (last && has_next) S.a_ready(nxt);
            if constexpr (SP2) {
            PG8_LDB(B0, 0, 0); PG8_LDB(B1, 0, 1); PG8_SCHED; PG8_LDA(At, 0, 0); PG8_STAGE(PG8_SA(1, 1), a1 + hstep, voffA);
            PG8_WAIT_V(8); PG8_WAIT_L(0); PG8_BAR; PG8_MMA(0, 0, At, B0); PG8_MMA(0, 1, At, B1); PG8_BAR; PG8_SCHED;
            PG8_LDA(At, 0, 1); PG8_STAGE(PG8_SB(0, 0), b2, voffB); PG8_STAGE(PG8_SB(0, 1), b2 + hstep, voffB); PG8_STAGE(PG8_SA(0, 0), a2, voffA);
            PG8_WAIT_V(8); PG8_WAIT_L(0); PG8_BAR; PG8_MMA(1, 0, At, B0); PG8_MMA(1, 1, At, B1); PG8_BAR; PG8_SCHED;
            PG8_LDB(B0, 1, 0); PG8_LDB(B1, 1, 1); PG8_SCHED; PG8_LDA(At, 1, 0); PG8_STAGE(PG8_SA(0, 1), a2 + hstep, voffA);
            PG8_WAIT_V(8); PG8_WAIT_L(0); PG8_BAR; PG8_MMA(0, 0, At, B0); PG8_MMA(0, 1, At, B1); PG8_BAR; PG8_SCHED;
            PG8_LDA(At, 1, 1); PG8_STAGE(PG8_SB(1, 0), b3, voffB); PG8_STAGE(PG8_SB(1, 1), b3 + hstep, voffB); PG8_STAGE(PG8_SA(1, 0), a3, voffA);
            PG8_WAIT_V(8); PG8_WAIT_L(0); PG8_BAR; PG8_MMA(1, 0, At, B0); PG8_MMA(1, 1, At, B1); PG8_BAR; PG8_SCHED;
            } else {
            PG8_LDB(B0, 0, 0); PG8_SCHED; PG8_LDA(At, 0, 0); PG8_STAGE(PG8_SA(1, 1), a1 + hstep, voffA);
            PG8_WAIT_L(8); PG8_BAR; PG8_WAIT_L(0); PG8_MMA(0, 0, At, B0); PG8_BAR; PG8_SCHED;
            PG8_LDB(B1, 0, 1); PG8_STAGE(PG8_SB(0, 0), b2, voffB);
            PG8_BAR; PG8_WAIT_L(0); PG8_MMA(0, 1, At, B1); PG8_BAR;
            PG8_LDA(At, 0, 1); PG8_STAGE(PG8_SA(0, 0), a2, voffA);
            PG8_BAR; PG8_WAIT_L(0); PG8_MMA(1, 0, At, B0); PG8_BAR; PG8_SCHED;
            PG8_STAGE(PG8_SB(0, 1), b2 + hstep, voffB);
            PG8_WAIT_V(6); PG8_BAR; PG8_MMA(1, 1, At, B1); PG8_BAR;
            PG8_LDB(B0, 1, 0); PG8_SCHED; PG8_LDA(At, 1, 0); PG8_STAGE(PG8_SA(0, 1), a2 + hstep, voffA);
            PG8_WAIT_L(8); PG8_BAR; PG8_WAIT_L(0); PG8_MMA(0, 0, At, B0); PG8_BAR; PG8_SCHED;
            PG8_LDB(B1, 1, 1); PG8_STAGE(PG8_SB(1, 0), b3, voffB);
            PG8_BAR; PG8_WAIT_L(0); PG8_MMA(0, 1, At, B1); PG8_BAR;
            PG8_LDA(At, 1, 1); PG8_STAGE(PG8_SA(1, 0), a3, voffA);
            PG8_BAR; PG8_WAIT_L(0); PG8_MMA(1, 0, At, B0); PG8_BAR; PG8_SCHED;
            PG8_STAGE(PG8_SB(1, 1), b3 + hstep, voffB);
            PG8_WAIT_V(6); PG8_BAR; PG8_MMA(1, 1, At, B1); PG8_BAR;
            }
        }
        if constexpr (ALIGN_EPI) { if (wr == 0) PG8_BAR; }
        if constexpr (!Epi::AFTER_DRAIN) { E(acc, cur, wr, wc, fr, fq); S.done(cur); }
        if (!has_next) break;
#pragma unroll
        for (int a = 0; a < 2; ++a)
#pragma unroll
            for (int b = 0; b < 2; ++b)
#pragma unroll
                for (int m = 0; m < 4; ++m)
#pragma unroll
                    for (int n = 0; n < 2; ++n) acc[a][b][m][n] = (f32x4){0.f, 0.f, 0.f, 0.f};
        cur = nxt; cA = nA; cB = nB; ++ui;
        if constexpr (ALIGN_EPI) { if (wr == 1) PG8_BAR; }
    }
    PG8_WAIT_V(0);
    if constexpr (!ALIGN_EPI) { if (wr == 0) PG8_BAR; }
    PG8_BAR;
    if constexpr (Epi::AFTER_DRAIN) { E.fused(acc, cur, wr, wc, fr, fq, lds, wid, lane); S.done(cur); }
#undef PG8_SA
#undef PG8_SB
#undef PG8_STAGE
#undef PG8_LDA
#undef PG8_LDB
#undef PG8_MMA
#undef PG8_WAIT_V
#undef PG8_WAIT_L
#undef PG8_BAR
#undef PG8_SCHED
}
}
#define GAS __attribute__((address_space(1)))
#define LAS __attribute__((address_space(3)))
typedef unsigned short bf16;
typedef unsigned v4u __attribute__((ext_vector_type(4)));
typedef float f32x4 __attribute__((ext_vector_type(4)));
typedef short bf16x8 __attribute__((ext_vector_type(8)));
typedef GAS unsigned gu32;
typedef GAS unsigned long long gu64;
#define RLX_AGENT __ATOMIC_RELAXED, __HIP_MEMORY_SCOPE_AGENT
#define LDS_WAIT() asm volatile("s_waitcnt lgkmcnt(0)" ::: "memory")
#define VM_WAIT() asm volatile("s_waitcnt vmcnt(0)" ::: "memory")
__device__ __forceinline__ unsigned long long rt() { return __builtin_amdgcn_s_memrealtime(); }
__device__ __forceinline__ unsigned f2bf(float f) { unsigned u = __builtin_bit_cast(unsigned, f); return (u + 0x7fffu + ((u >> 16) & 1u)) >> 16; }
__device__ __forceinline__ unsigned pk2(float lo, float hi) { return f2bf(lo) | (f2bf(hi) << 16); }

#define XB_TMO      128
#define XB_XCNT(j)  (256  + 64 * (j))
#define XB_XSUB(j)  (1280 + 64 * (j))
#define XB_XGEN(j)  (2304 + 64 * (j))
#define XB_TOP      3328
#define XB_TOPGEN   3392
#define XCD_BAR_WORDS 3456
#define XB_SPIN_CAP (1u << 18)

__device__ __forceinline__ unsigned xb_ld(unsigned* p)              { return __hip_atomic_load(p, __ATOMIC_RELAXED, __HIP_MEMORY_SCOPE_AGENT); }
__device__ __forceinline__ unsigned xb_add(unsigned* p, unsigned v) { return __hip_atomic_fetch_add(p, v, __ATOMIC_RELAXED, __HIP_MEMORY_SCOPE_AGENT); }
__device__ __forceinline__ unsigned xb_xcc_id() { return (unsigned)__builtin_amdgcn_s_getreg((3 << 11) | 20) & 0xFu; }
#define XB_SPIN(cond, bar) do { unsigned _sp = 0; while (cond) { __builtin_amdgcn_s_sleep(1); \
    if ((++_sp & 255u) == 0u) { if (xb_ld(&(bar)[XB_TMO])) break; if (_sp > XB_SPIN_CAP) { atomicAdd(&(bar)[XB_TMO], 1u); break; } } } } while (0)

struct XcdBarrier {
    unsigned* bar; unsigned x;
    volatile LAS unsigned* st;
};

__device__ __forceinline__ XcdBarrier xcd_barrier_post(unsigned* bar, volatile LAS unsigned* st) {
    XcdBarrier b; b.bar = bar; b.x = xb_xcc_id(); b.st = st;
    if (threadIdx.x == 0) (void)xb_add(&bar[XB_XCNT(b.x)], 1u);
    return b;
}
__device__ __forceinline__ void xcd_barrier_complete(unsigned* bar, unsigned x, unsigned& nloc, unsigned& nx) {
    const unsigned G = gridDim.x * gridDim.y * gridDim.z;
    unsigned sum, cnt, mine, sp = 0u;
    for (;;) {
        sum = 0u; cnt = 0u; mine = 0u;
#pragma unroll
        for (unsigned j = 0; j < 16; ++j) { const unsigned c = xb_ld(&bar[XB_XCNT(j)]); sum += c; cnt += (c > 0u) ? 1u : 0u; mine = (j == x) ? c : mine; }
        if (sum == G) break;
        __builtin_amdgcn_s_sleep(1);
        if ((++sp & 255u) == 0u) { if (xb_ld(&bar[XB_TMO])) break; if (sp > XB_SPIN_CAP) { atomicAdd(&bar[XB_TMO], 1u); break; } }
    }
    nloc = mine > 0u ? mine : 1u; nx = cnt > 0u ? cnt : 1u;
}

__device__ __forceinline__ void xcd_barrier(const XcdBarrier& b) {
    asm volatile("s_waitcnt vmcnt(0)" ::: "memory");
    __syncthreads();
    if (threadIdx.x == 0) {
        unsigned* bar = b.bar;
        __builtin_amdgcn_s_waitcnt(0);
        unsigned nloc = b.st[0], nx = b.st[1];
        if (nloc == 0u) { xcd_barrier_complete(bar, b.x, nloc, nx); b.st[0] = nloc; b.st[1] = nx; }
        const unsigned old = xb_add(&bar[XB_XSUB(b.x)], 1u);
        const unsigned gen = old / nloc;
        if (old + 1u == (gen + 1u) * nloc) {
            __builtin_amdgcn_fence(__ATOMIC_RELEASE, "agent");
            asm volatile("s_waitcnt vmcnt(0)" ::: "memory");
            const unsigned og = xb_add(&bar[XB_TOP], 1u);
            const unsigned tg = og / nx;
            if (og + 1u == (tg + 1u) * nx) xb_add(&bar[XB_TOPGEN], 1u);
            else XB_SPIN(xb_ld(&bar[XB_TOPGEN]) == tg, bar);
            __builtin_amdgcn_fence(__ATOMIC_ACQUIRE, "agent");
            xb_add(&bar[XB_XGEN(b.x)], 1u);
            asm volatile("s_waitcnt vmcnt(0)" ::: "memory");
        } else {
            XB_SPIN(xb_ld(&bar[XB_XGEN(b.x)]) == gen, bar);
            __builtin_amdgcn_fence(__ATOMIC_ACQUIRE, "agent");
            asm volatile("s_waitcnt vmcnt(0)" ::: "memory");
        }
    }
    __syncthreads();
}

#ifndef PH_MASK
#define PH_MASK 0x1ff
#endif
constexpr int DM = 1024, NB = 8, SEQ = 4096, MP = NB * SEQ;
constexpr int SB = 32, SS_ = 4, MS = SB * SS_, MV = MP + MS;
constexpr int MR = 129 * 256;
constexpr int NIN = 6400, DFF = 2816, NGU = 2 * DFF, DAO = 256;
constexpr float RMS_EPS = 1e-6f, LN_EPS = 1e-5f;
constexpr int NWAVES = 8;

constexpr size_t O_Y = 0;
constexpr size_t O_KVP0 = 33685504, O_KVS0 = 34209792, O_KVP1 = 36306944, O_KVS1 = 38404096, O_KVP2 = 46792704, O_KVS2 = 55181312;
constexpr size_t O_CONVP = 88735744, O_CONVS = 88981504, O_TOTAL = 89964544;

constexpr size_t MiB = 1u << 20;
constexpr size_t WS_CTL = 0, CTL_ZERO_BYTES = 32768;
constexpr size_t WS_W1 = 1 * MiB;
constexpr size_t WS_WCAT = 14 * MiB;
constexpr size_t WS_WOUT = 17 * MiB;
constexpr size_t WS_WGU = 19 * MiB;
constexpr size_t WS_WD = 30 * MiB;
constexpr int KC = 1280;
constexpr size_t WS_A = 36 * MiB;
constexpr size_t WS_B = 117 * MiB;
constexpr size_t WS_GA = 182 * MiB, WS_GB = WS_GA + 1024;
constexpr int GP = 2048;
constexpr size_t WS_X1B = WS_GA;
constexpr size_t WS_Q = 248 * MiB, WS_K = 296 * MiB, WS_V = 344 * MiB;
constexpr size_t WS_OG = 392 * MiB;
constexpr size_t WS_LSE = 441 * MiB;
constexpr size_t WS_SS = 443 * MiB;
constexpr size_t WS_SQ = 446 * MiB;
constexpr size_t WS_SSS = 447 * MiB;
constexpr size_t WS_ACT = 248 * MiB;
constexpr size_t WS_END = 448 * MiB;
constexpr int CW_BAR = 4096;

constexpr int RING_BYTES = 131072, LDSCTL_OFF = RING_BYTES, MISC_OFF = LDSCTL_OFF + 320, LDS_BYTES = 147456;

typedef unsigned u32x4 __attribute__((ext_vector_type(4)));
typedef unsigned u32x2 __attribute__((ext_vector_type(2)));

struct Params {
    const float* in[20];
    float* out;
    unsigned char* ws;
    int ph_lo, ph_hi;
};

__device__ __forceinline__ float sigmoidf_(float x) { return __builtin_amdgcn_rcpf(1.0f + __expf(-x)); }
__device__ __forceinline__ float wave_sum(float v) {
#pragma unroll
    for (int o = 1; o < 64; o <<= 1) v += __shfl_xor(v, o);
    return v;
}


__device__ __forceinline__ u32x2 qgate8(const f32x4 a, const f32x4 b) {
    unsigned w0 = 0u, w1 = 0u;
    w0 = __builtin_amdgcn_cvt_pk_u8_f32(__builtin_rintf(a[0] * 255.f), 0, w0); w0 = __builtin_amdgcn_cvt_pk_u8_f32(__builtin_rintf(a[1] * 255.f), 1, w0);
    w0 = __builtin_amdgcn_cvt_pk_u8_f32(__builtin_rintf(a[2] * 255.f), 2, w0); w0 = __builtin_amdgcn_cvt_pk_u8_f32(__builtin_rintf(a[3] * 255.f), 3, w0);
    w1 = __builtin_amdgcn_cvt_pk_u8_f32(__builtin_rintf(b[0] * 255.f), 0, w1); w1 = __builtin_amdgcn_cvt_pk_u8_f32(__builtin_rintf(b[1] * 255.f), 1, w1);
    w1 = __builtin_amdgcn_cvt_pk_u8_f32(__builtin_rintf(b[2] * 255.f), 2, w1); w1 = __builtin_amdgcn_cvt_pk_u8_f32(__builtin_rintf(b[3] * 255.f), 3, w1);
    return (u32x2){w0, w1};
}
__device__ __forceinline__ void dqgate8(const u32x2 w, f32x4& a, f32x4& b) {
    constexpr float S = 1.0f / 255.0f;
    a = (f32x4){(float)(w.x & 0xffu) * S, (float)((w.x >> 8) & 0xffu) * S, (float)((w.x >> 16) & 0xffu) * S, (float)(w.x >> 24) * S};
    b = (f32x4){(float)(w.y & 0xffu) * S, (float)((w.y >> 8) & 0xffu) * S, (float)((w.y >> 16) & 0xffu) * S, (float)(w.y >> 24) * S};
}

constexpr int CP_CHUNKS = 5456;
struct CopyCtx { const float* s0; const float* s1; const float* s2; const float* s3; float* out; };
__device__ __forceinline__ void cp_addr(const CopyCtx& c, int chunk, int tid, int j, const GAS f32x4*& src, GAS f32x4*& dst) {
    int base, rows, per, rw; const float* sp; size_t oo;
    if (chunk < 248) { base = 0; rows = 124; per = 128; rw = 128; sp = c.s0; oo = O_KVS0; }
    else if (chunk < 1264) { base = 248; rows = 508; per = 512; rw = 128; sp = c.s1; oo = O_KVS1; }
    else if (chunk < 5352) { base = 1264; rows = 2044; per = 2048; rw = 128; sp = c.s2; oo = O_KVS2; }
    else { base = 5352; rows = 26; per = 30; rw = 256; sp = c.s3; oo = O_CONVS; }
    const int i0 = (chunk - base) * 2048, n4b = rows * rw, b0 = i0 / n4b, r0 = i0 - b0 * n4b;
    int r = r0 + j * 512 + tid, b = b0;
    if (r >= n4b) { r -= n4b; b += 1; }
    const unsigned idx = (unsigned)(b * per * rw + r);
    src = (const GAS f32x4*)sp + idx + 4 * rw;
    dst = (GAS f32x4*)(c.out + oo) + idx;
}
__device__ __forceinline__ void cp_load(const CopyCtx& c, int chunk, int tid, f32x4 (&v)[4]) {
    if (chunk < CP_CHUNKS) {
#pragma unroll
        for (int j = 0; j < 4; ++j) { const GAS f32x4* src; GAS f32x4* dst; cp_addr(c, chunk, tid, j, src, dst); v[j] = __builtin_nontemporal_load(src); }
    }
    __builtin_amdgcn_sched_barrier(0);
}
__device__ __forceinline__ void cp_store(const CopyCtx& c, int chunk, int tid, const f32x4 (&v)[4]) {
    __builtin_amdgcn_sched_barrier(0);
    if (chunk < CP_CHUNKS) {
#pragma unroll
        for (int j = 0; j < 4; ++j) { const GAS f32x4* src; GAS f32x4* dst; cp_addr(c, chunk, tid, j, src, dst); __builtin_nontemporal_store(v[j], dst); }
    }
}

struct EpiP1 {
    static constexpr bool PERM = true, AFTER_DRAIN = false, HAS_MID = false;
    bf16 *Q, *K, *V, *U, *GA, *GB; float* SQ; float* out; const float *qw, *kw; CopyCtx cc;
    __device__ __forceinline__ void operator()(const pg8::f32x4 (&acc)[2][2][4][2], const pg8::Unit& u, int wr, int wc, int fr, int fq) const {
        const int pn = u.pn, row0 = u.pm * 256 + wr * 64 + fr;
        const int cp_chunk = u.pm * 25 + pn, cp_tid = (wr * 4 + wc) * 64 + fq * 16 + fr; f32x4 cpv[4]; cp_load(cc, cp_chunk, cp_tid, cpv);
        if (pn < 9) {
            const int seg = pn / 3, g = pn - 3 * seg, sh = 2 * g, win = 128 << sh, head = wc;
            f32x4 w[2][2];
            const float* nw = (seg == 0) ? qw : kw;
#pragma unroll
            for (int bj = 0; bj < 2; ++bj)
#pragma unroll
                for (int n = 0; n < 2; ++n) w[bj][n] = (seg < 2) ? *(const f32x4*)(nw + 32 * bj + 8 * fq + 4 * n) : (f32x4){1.f, 1.f, 1.f, 1.f};
            const float post = (seg == 0) ? 0.125f * 1.4426950408889634f : 1.0f;
            bf16* dstb = Q + (size_t)seg * ((WS_K - WS_Q) / 2);
            const size_t okp = (g == 0) ? O_KVP0 : (g == 1) ? O_KVP1 : O_KVP2;
            const size_t oks = (g == 0) ? O_KVS0 : (g == 1) ? O_KVS1 : O_KVS2;
#pragma unroll
            for (int ai = 0; ai < 2; ++ai)
#pragma unroll
                for (int m = 0; m < 4; ++m) {
                    const int row = row0 + ai * 128 + m * 16;
                    if (ai == 1 && m == 0) cp_store(cc, cp_chunk, cp_tid, cpv);
                    f32x4 v[2][2];
#pragma unroll
                    for (int bj = 0; bj < 2; ++bj)
#pragma unroll
                        for (int n = 0; n < 2; ++n) v[bj][n] = acc[ai][bj][m][n];
                    if (seg < 2) {
                        float ss = 0.f;
#pragma unroll
                        for (int bj = 0; bj < 2; ++bj)
#pragma unroll
                            for (int n = 0; n < 2; ++n) { const f32x4 x = v[bj][n]; ss += (x[0] * x[0] + x[1] * x[1]) + (x[2] * x[2] + x[3] * x[3]); }
                        ss += __shfl_xor(ss, 16); ss += __shfl_xor(ss, 32);
                        const float rs = __builtin_amdgcn_rsqf(ss * (1.0f / 64.0f) + RMS_EPS) * post;
#pragma unroll
                        for (int bj = 0; bj < 2; ++bj)
#pragma unroll
                            for (int n = 0; n < 2; ++n) v[bj][n] = v[bj][n] * rs * w[bj][n];
                    }
                    if (row < MP) {
                        const int b = row >> 12, t = row & 4095;
                        const int pos = ((t & ((1 << sh) - 1)) << (12 - sh)) + (t >> sh);
                        bf16* d = dstb + ((size_t)((b * 3 + g) * 4 + head) * 4096 + pos) * 64 + 8 * fq;
#pragma unroll
                        for (int bj = 0; bj < 2; ++bj) {
                            u32x4 pk; pk.x = pg8::cvt_pk_bf16(v[bj][0][0], v[bj][0][1]); pk.y = pg8::cvt_pk_bf16(v[bj][0][2], v[bj][0][3]);
                            pk.z = pg8::cvt_pk_bf16(v[bj][1][0], v[bj][1][1]); pk.w = pg8::cvt_pk_bf16(v[bj][1][2], v[bj][1][3]);
                            *(u32x4*)(d + 32 * bj) = pk;
                        }
                        if (seg >= 1 && t >= 4096 - win) {
                            float* o = out + okp + ((size_t)(b * win + (t - (4096 - win))) * 2 + (seg - 1)) * 256 + head * 64 + 8 * fq;
#pragma unroll
                            for (int bj = 0; bj < 2; ++bj)
#pragma unroll
                                for (int n = 0; n < 2; ++n) __builtin_nontemporal_store(v[bj][n], (f32x4*)(o + 32 * bj + 4 * n));
                        }
                    } else if (row < MV) {
                        const int si = row - MP, sb = si >> 2, s = si & 3;
                        float* o = (seg == 0) ? SQ + ((size_t)si * 12 + g * 4 + head) * 64 + 8 * fq
                                              : out + oks + ((size_t)(sb * win + win - 4 + s) * 2 + (seg - 1)) * 256 + head * 64 + 8 * fq;
#pragma unroll
                        for (int bj = 0; bj < 2; ++bj)
#pragma unroll
                            for (int n = 0; n < 2; ++n) *(f32x4*)(o + 32 * bj + 4 * n) = v[bj][n];
                    }
                }
        } else if (pn < 17) {
            const int ch0 = 128 * (pn - 9) + 32 * wc + 8 * fq;
#pragma unroll
            for (int ai = 0; ai < 2; ++ai)
#pragma unroll
                for (int m = 0; m < 4; ++m) {
                    const int row = row0 + ai * 128 + m * 16;
                    if (ai == 1 && m == 0) cp_store(cc, cp_chunk, cp_tid, cpv);
                    f32x4 uu[2];
#pragma unroll
                    for (int n = 0; n < 2; ++n) {
                        const f32x4 a = acc[ai][0][m][n], b = acc[ai][1][m][n];
#pragma unroll
                        for (int i = 0; i < 4; ++i) uu[n][i] = a[i] * sigmoidf_(b[i]);
                    }
                    u32x4 pk; pk.x = pg8::cvt_pk_bf16(uu[0][0], uu[0][1]); pk.y = pg8::cvt_pk_bf16(uu[0][2], uu[0][3]);
                    pk.z = pg8::cvt_pk_bf16(uu[1][0], uu[1][1]); pk.w = pg8::cvt_pk_bf16(uu[1][2], uu[1][3]);
                    *(u32x4*)(U + (size_t)row * DM + ch0) = pk;
                    float* o = nullptr;
                    if (row < MP) { const int b = row >> 12, t = row & 4095; if (t >= 4066) o = out + O_CONVP + ((size_t)(b * 30 + t - 4066)) * DM + ch0; }
                    else if (row < MV) { const int si = row - MP; o = out + O_CONVS + ((size_t)((si >> 2) * 30 + 26 + (si & 3))) * DM + ch0; }
                    if (o) { *(f32x4*)o = uu[0]; *(f32x4*)(o + 4) = uu[1]; }
                }
        } else {
            const int q = pn - 17; unsigned char* G = (unsigned char*)((q >> 2) ? GB : GA);
            const int col0 = 256 * (q & 3) + 32 * wc + 8 * fq;
#pragma unroll
            for (int ai = 0; ai < 2; ++ai)
#pragma unroll
                for (int m = 0; m < 4; ++m) {
                    const int row = row0 + ai * 128 + m * 16;
                    if (ai == 1 && m == 0) cp_store(cc, cp_chunk, cp_tid, cpv);
#pragma unroll
                    for (int bj = 0; bj < 2; ++bj) {
                        f32x4 a = acc[ai][bj][m][0], b = acc[ai][bj][m][1];
#pragma unroll
                        for (int i = 0; i < 4; ++i) { a[i] = sigmoidf_(a[i]); b[i] = sigmoidf_(b[i]); }
                        __builtin_nontemporal_store(qgate8(a, b), (u32x2*)(G + (size_t)row * GP + col0 + 128 * bj));
                    }
                }
        }
    }
};

__device__ __forceinline__ float bf_lo(unsigned w) { return __builtin_bit_cast(float, w << 16); }
__device__ __forceinline__ float bf_hi(unsigned w) { return __builtin_bit_cast(float, w & 0xffff0000u); }
__device__ __forceinline__ void unpack8(const u32x4 w, f32x4& a, f32x4& b) {
    a = (f32x4){bf_lo(w.x), bf_hi(w.x), bf_lo(w.y), bf_hi(w.y)}; b = (f32x4){bf_lo(w.z), bf_hi(w.z), bf_lo(w.w), bf_hi(w.w)};
}
__device__ __forceinline__ u32x4 pack8(const f32x4 a, const f32x4 b) {
    u32x4 pk; pk.x = pg8::cvt_pk_bf16(a[0], a[1]); pk.y = pg8::cvt_pk_bf16(a[2], a[3]); pk.z = pg8::cvt_pk_bf16(b[0], b[1]); pk.w = pg8::cvt_pk_bf16(b[2], b[3]); return pk;
}

__device__ __forceinline__ u32x2 ld8nt(const void* pz) { return __builtin_nontemporal_load((const u32x2*)pz); }
struct EpiGateF {
    static constexpr bool PERM = true, AFTER_DRAIN = false, HAS_MID = true; static constexpr int MID_T = DAO / 64;
    const unsigned char* GA; const unsigned char* GB; bf16* H;
    __device__ __forceinline__ void mid(pg8::f32x4 (&acc)[2][2][4][2], const pg8::Unit& u, int wr, int wc, int fr, int fq) const {
        const int row0 = u.pm * 256 + wr * 64 + fr, col0 = u.pn * 256 + 32 * wc + 8 * fq;
#pragma unroll
        for (int ai = 0; ai < 2; ++ai)
#pragma unroll
            for (int m = 0; m < 4; ++m) {
                const unsigned off = (unsigned)(row0 + ai * 128 + m * 16) * GP + col0;
#pragma unroll
                for (int bj = 0; bj < 2; ++bj) {
                    f32x4 a0, a1, b0, b1; dqgate8(ld8nt(GA + off + 128 * bj), a0, a1); dqgate8(*(const u32x2*)(GB + off + 128 * bj), b0, b1);
#pragma unroll
                    for (int i = 0; i < 4; ++i) {
                        acc[ai][bj][m][0][i] *= a0[i] * __builtin_amdgcn_rcpf(fmaxf(b0[i], 8.6736174e-19f));
                        acc[ai][bj][m][1][i] *= a1[i] * __builtin_amdgcn_rcpf(fmaxf(b1[i], 8.6736174e-19f));
                    }
                }
                if (m & 1) asm volatile("" ::: "memory");
            }
    }
    __device__ __forceinline__ void operator()(const pg8::f32x4 (&acc)[2][2][4][2], const pg8::Unit& u, int wr, int wc, int fr, int fq) const {
        int row0 = u.pm * 256 + wr * 64 + fr, col0 = u.pn * 256 + 32 * wc + 8 * fq;
        asm volatile("" : "+v"(row0), "+v"(col0));
#pragma unroll
        for (int ai = 0; ai < 2; ++ai)
#pragma unroll
            for (int m = 0; m < 4; ++m) {
                const unsigned off = (unsigned)(row0 + ai * 128 + m * 16) * DM + col0, goff = (unsigned)(row0 + ai * 128 + m * 16) * GP + col0;
#pragma unroll
                for (int bj = 0; bj < 2; ++bj) {
                    f32x4 b0, b1; dqgate8(ld8nt(GB + goff + 128 * bj), b0, b1);
#pragma unroll
                    for (int i = 0; i < 4; ++i) { b0[i] = fmaxf(b0[i], 8.6736174e-19f); b1[i] = fmaxf(b1[i], 8.6736174e-19f); }
                    *(u32x4*)(H + off + 128 * bj) = pack8(acc[ai][bj][m][0] * b0, acc[ai][bj][m][1] * b1);
                }
                if (m & 1) asm volatile("" ::: "memory");
            }
    }
};
struct EpiX1 {
    static constexpr bool PERM = true, AFTER_DRAIN = false, HAS_MID = false;
    const float *xp, *xs; float* out; bf16* X1B; float* SS;
    __device__ __forceinline__ void operator()(const pg8::f32x4 (&acc)[2][2][4][2], const pg8::Unit& u, int wr, int wc, int fr, int fq) const {
        const int row0 = u.pm * 256 + wr * 64 + fr, col0 = u.pn * 256 + 32 * wc + 8 * fq;
#pragma unroll
        for (int ai = 0; ai < 2; ++ai) {
            f32x4 xv[4][2][2];
#pragma unroll
            for (int m = 0; m < 4; ++m) {
                const float* xr = xp + (size_t)(row0 + ai * 128 + m * 16) * DM + col0;
#pragma unroll
                for (int bj = 0; bj < 2; ++bj)
#pragma unroll
                    for (int n = 0; n < 2; ++n) xv[m][bj][n] = __builtin_nontemporal_load((const f32x4*)(xr + 128 * bj + 4 * n));
            }
#pragma unroll
            for (int m = 0; m < 4; ++m) {
                const int row = row0 + ai * 128 + m * 16;
                float ss = 0.f;
#pragma unroll
                for (int bj = 0; bj < 2; ++bj) {
                    f32x4 v[2];
#pragma unroll
                    for (int n = 0; n < 2; ++n) {
                        v[n] = xv[m][bj][n] + acc[ai][bj][m][n];
                        ss += (v[n][0] * v[n][0] + v[n][1] * v[n][1]) + (v[n][2] * v[n][2] + v[n][3] * v[n][3]);
                    }
                    *(u32x4*)(X1B + (size_t)row * DM + col0 + 128 * bj) = pack8(v[0], v[1]);
                }
                ss += __shfl_xor(ss, 16); ss += __shfl_xor(ss, 32);
                if (fq == 0) SS[(size_t)row * 16 + u.pn * 4 + wc] = ss;
            }
            asm volatile("" ::: "memory");
        }
    }
};
struct EpiAct {
    static constexpr bool PERM = true, AFTER_DRAIN = false, HAS_MID = false;
    const float* SS; bf16* ACT; CopyCtx cc;
    __device__ __forceinline__ void operator()(const pg8::f32x4 (&acc)[2][2][4][2], const pg8::Unit& u, int wr, int wc, int fr, int fq) const {
        const int row0 = u.pm * 256 + wr * 64 + fr, ch0 = u.pn * 128 + 32 * wc + 8 * fq;
        const int cp_q = u.pm * 22 + u.pn, cp_c0 = (cp_q * (CP_CHUNKS - 3225)) / 2816, cp_c1 = ((cp_q + 1) * (CP_CHUNKS - 3225)) / 2816;
        const int cp_chunk = (cp_c1 != cp_c0) ? 3225 + cp_c0 : CP_CHUNKS, cp_tid = (wr * 4 + wc) * 64 + fq * 16 + fr; f32x4 cpv[4]; cp_load(cc, cp_chunk, cp_tid, cpv);
#pragma unroll
        for (int ai = 0; ai < 2; ++ai)
#pragma unroll
            for (int m = 0; m < 4; ++m) {
                const int row = row0 + ai * 128 + m * 16;
                    if (ai == 1 && m == 0) cp_store(cc, cp_chunk, cp_tid, cpv);
                const f32x4 sv = *((const f32x4*)(SS + (size_t)row * 16) + fq);
                float tot = (sv[0] + sv[1]) + (sv[2] + sv[3]);
                tot += __shfl_xor(tot, 16); tot += __shfl_xor(tot, 32);
                const float rstd = __builtin_amdgcn_rsqf(tot * (1.0f / DM) + RMS_EPS);
                f32x4 a[2];
#pragma unroll
                for (int n = 0; n < 2; ++n)
#pragma unroll
                    for (int i = 0; i < 4; ++i) { const float g = acc[ai][0][m][n][i] * rstd, up = acc[ai][1][m][n][i] * rstd; a[n][i] = g * sigmoidf_(g) * up; }
                *(u32x4*)(ACT + (size_t)row * DFF + ch0) = pack8(a[0], a[1]);
            }
    }
};
struct EpiOut {
    static constexpr bool PERM = true, AFTER_DRAIN = false, HAS_MID = false;
    float* out; const bf16* X1B;
    __device__ __forceinline__ void operator()(const pg8::f32x4 (&acc)[2][2][4][2], const pg8::Unit& u, int wr, int wc, int fr, int fq) const {
        const int row0 = u.pm * 256 + wr * 64 + fr, col0 = u.pn * 256 + 32 * wc + 8 * fq;
#pragma unroll
        for (int ai = 0; ai < 2; ++ai)
#pragma unroll
            for (int m = 0; m < 4; ++m) {
                const int row = row0 + ai * 128 + m * 16;
                float* o = out + (size_t)row * DM + col0;
#pragma unroll
                for (int bj = 0; bj < 2; ++bj) {
                    f32x4 xa, xb; unpack8(__builtin_nontemporal_load((const u32x4*)(X1B + (size_t)row * DM + col0 + 128 * bj)), xa, xb);
                    __builtin_nontemporal_store(xa + acc[ai][bj][m][0], (f32x4*)(o + 128 * bj)); __builtin_nontemporal_store(xb + acc[ai][bj][m][1], (f32x4*)(o + 128 * bj + 4));
                }
            }
    }
};

__device__ __forceinline__ void attn_sample_unit(const Params& p, LAS float* sS, int it, int lane) {
    unsigned char* ws = p.ws;
    const int h = it & 3, g = (it >> 2) % 3, si = it / 12, b = si >> 2, s = si & 3, sh = 2 * g, win = 128 << sh;
    const float* cache = p.in[2 + g];
    const float* newr = p.out + ((g == 0) ? O_KVS0 : (g == 1) ? O_KVS1 : O_KVS2);
    const f32x4* qp = (const f32x4*)((const float*)(ws + WS_SQ) + ((size_t)si * 12 + g * 4 + h) * 64);
    const float* kr[2];
#pragma unroll
    for (int c = 0; c < 2; ++c) {
        const int idx = win + s - ((lane + 64 * c) << sh);
        kr[c] = (idx < win) ? cache + (size_t)(b * win + idx) * 512 + h * 64 : newr + (size_t)(b * win + idx - 4) * 512 + h * 64;
    }
    f32x4 kv[2][16];
#pragma unroll
    for (int c = 0; c < 2; ++c)
#pragma unroll
        for (int c16 = 0; c16 < 16; ++c16) kv[c][c16] = *((const f32x4*)kr[c] + c16);
    const f32x4 k128 = *((const f32x4*)(cache + (size_t)(b * win + s) * 512 + h * 64) + (lane & 15));
    float d[2];
#pragma unroll
    for (int c = 0; c < 2; ++c) {
        float a0 = 0.f, a1 = 0.f;
#pragma unroll
        for (int c16 = 0; c16 < 16; c16 += 2) {
            const f32x4 pa = kv[c][c16] * qp[c16], pb = kv[c][c16 + 1] * qp[c16 + 1];
            a0 += (pa[0] + pa[1]) + (pa[2] + pa[3]); a1 += (pb[0] + pb[1]) + (pb[2] + pb[3]);
        }
        d[c] = a0 + a1;
    }
    float d2;
    { const f32x4 pa = k128 * qp[lane & 15]; d2 = (pa[0] + pa[1]) + (pa[2] + pa[3]); d2 += __shfl_xor(d2, 1); d2 += __shfl_xor(d2, 2); d2 += __shfl_xor(d2, 4); d2 += __shfl_xor(d2, 8); }
    float mx = fmaxf(fmaxf(d[0], d[1]), d2);
#pragma unroll
    for (int o = 1; o < 64; o <<= 1) mx = fmaxf(mx, __shfl_xor(mx, o));
    const float p0 = __builtin_amdgcn_exp2f(d[0] - mx), p1 = __builtin_amdgcn_exp2f(d[1] - mx), p2 = __builtin_amdgcn_exp2f(d2 - mx);
    sS[lane] = p0; sS[lane + 64] = p1; if (lane == 0) sS[128] = p2;
    const float p2b = __builtin_bit_cast(float, __builtin_amdgcn_readfirstlane(__builtin_bit_cast(int, p2)));
    const float l = wave_sum(p0 + p1) + p2b;
    LDS_WAIT();
    const int kg = lane >> 4, dc = lane & 15;
    const size_t voff = (size_t)h * 64 + 4 * dc + 256;
    f32x4 vv[33];
#pragma unroll
    for (int i = 0; i < 33; ++i) {
        const int jj = kg + 4 * i, jc = (jj <= 128) ? jj : 128;
        const int idx = win + s - (jc << sh);
        const float* vr = (idx < win) ? cache + (size_t)(b * win + idx) * 512 + voff : newr + (size_t)(b * win + idx - 4) * 512 + voff;
        vv[i] = *(const f32x4*)vr;
    }
    f32x4 o = {0.f, 0.f, 0.f, 0.f};
#pragma unroll
    for (int i = 0; i < 33; ++i) { const int jj = kg + 4 * i; const float pj = (jj <= 128) ? sS[(jj <= 128) ? jj : 128] : 0.f; o = o + vv[i] * pj; }
#pragma unroll
    for (int e = 0; e < 4; ++e) { o[e] += __shfl_xor(o[e], 16); o[e] += __shfl_xor(o[e], 32); }
    const float inv = 1.0f / l;
    if (lane < 16) {
        u32x2 w; w.x = pg8::cvt_pk_bf16(o[0] * inv, o[1] * inv); w.y = pg8::cvt_pk_bf16(o[2] * inv, o[3] * inv);
        *(u32x2*)((bf16*)(ws + WS_OG) + ((size_t)g * MR + MP + si) * DAO + h * 64 + 4 * dc) = w;
    }
    if (lane == 0) ((float*)(ws + WS_LSE))[((size_t)g * MR + MP + si) * 4 + h] = mx + __builtin_amdgcn_logf(l);
    LDS_WAIT();
}

typedef short s16x8 __attribute__((ext_vector_type(8)));
typedef short s16x4 __attribute__((ext_vector_type(4)));
typedef float f32x16 __attribute__((ext_vector_type(16)));
constexpr int AT_ROWB = 144, AT_VROWB = 192, AT_V0 = 384 * AT_ROWB, AT_UNITS = NB * 12 * 16, AT_PER_WG = 6;
__device__ __forceinline__ s16x4 vtr(const LAS unsigned char* p) { return __builtin_bit_cast(s16x4, __builtin_amdgcn_ds_read_tr16_b64_v4i16((LAS s16x4*)p)); }
__device__ __forceinline__ float shfl32(float v) { return __shfl_xor(v, 32); }

struct AttnPf { u32x4 k[6], v[6], q[4]; };
__device__ __forceinline__ void attn_prefetch(AttnPf& pf, const bf16* Q, const bf16* K, const bf16* V, int u, int tid, int wave, int lane) {
    const int bgh = u >> 4, c = u & 15, g = (bgh >> 2) % 3, sh = 2 * g, pos0 = 256 * c;
    const bool has_prev = (pos0 & ((4096 >> sh) - 1)) != 0;
    const size_t hb = (size_t)bgh * 4096 * 64;
#pragma unroll
    for (int i = 0; i < 6; ++i) {
        const int rel = (tid >> 3) + 64 * i - 128;
        if (has_prev || i >= 2) {
            const size_t off = hb + (size_t)(pos0 + rel) * 64 + (tid & 7) * 8;
            pf.k[i] = *(const u32x4*)(K + off); pf.v[i] = *(const u32x4*)(V + off);
        }
    }
    const bf16* qp = Q + hb + (size_t)(pos0 + 32 * wave + (lane & 31)) * 64 + (lane >> 5) * 8;
#pragma unroll
    for (int ks = 0; ks < 4; ++ks) pf.q[ks] = *(const u32x4*)(qp + ks * 16);
}
__device__ __forceinline__ void attn_stage(const AttnPf& pf, LAS unsigned char* lds, int u, int tid) {
    const int bgh = u >> 4, c = u & 15, g = (bgh >> 2) % 3, sh = 2 * g, pos0 = 256 * c;
    const bool has_prev = (pos0 & ((4096 >> sh) - 1)) != 0;
#pragma unroll
    for (int i = 0; i < 6; ++i) {
        const int kr = (tid >> 3) + 64 * i;
        const bool ld = has_prev || i >= 2;
        *(LAS u32x4*)(lds + kr * AT_ROWB + (tid & 7) * 16) = ld ? pf.k[i] : (u32x4){0u, 0u, 0u, 0u};
        *(LAS u32x4*)(lds + AT_V0 + kr * AT_VROWB + (tid & 7) * 16) = ld ? pf.v[i] : (u32x4){0u, 0u, 0u, 0u};
    }
}
__device__ __forceinline__ void attn_compute(const AttnPf& pf, LAS unsigned char* lds, bf16* OG, float* LSE, int u, int wave, int lane) {
    const int bgh = u >> 4, c = u & 15, b = bgh / 12, g = (bgh >> 2) % 3, hh = bgh & 3, sh = 2 * g, pos0 = 256 * c;
    const bool has_prev = (pos0 & ((4096 >> sh) - 1)) != 0;
    const int r32 = lane & 31, h = lane >> 5;
    const int jmin = has_prev ? 0 : ((wave < 4) ? 4 - wave : 0);
    f32x16 S[5];
    const LAS unsigned char* kbase = lds + (32 * wave + r32) * AT_ROWB + h * 16;
    s16x8 kf[2][4];
#pragma unroll
    for (int ks = 0; ks < 4; ++ks) kf[0][ks] = *(const LAS s16x8*)(kbase + ks * 32);
#pragma unroll
    for (int j = 0; j < 5; ++j) {
        if (j < 4) {
#pragma unroll
            for (int ks = 0; ks < 4; ++ks) kf[(j + 1) & 1][ks] = *(const LAS s16x8*)(kbase + (j + 1) * 32 * AT_ROWB + ks * 32);
        }
        f32x16 a = {0.f, 0.f, 0.f, 0.f, 0.f, 0.f, 0.f, 0.f, 0.f, 0.f, 0.f, 0.f, 0.f, 0.f, 0.f, 0.f};
#pragma unroll
        for (int ks = 0; ks < 4; ++ks) a = __builtin_amdgcn_mfma_f32_32x32x16_bf16(kf[j & 1][ks], __builtin_bit_cast(s16x8, pf.q[ks]), a, 0, 0, 0);
        S[j] = a;
    }
    float m = -1e30f;
#pragma unroll
    for (int j = 0; j < 5; ++j) {
        const bool tile_ok = j >= jmin;
#pragma unroll
        for (int r = 0; r < 16; ++r) {
            const int cr = (r & 3) + 8 * (r >> 2) + 4 * h;
            const bool valid = tile_ok && ((j == 0) ? (cr >= r32) : (j == 4) ? (cr <= r32) : true);
            const float v = valid ? S[j][r] : -1e30f;
            S[j][r] = v; m = fmaxf(m, v);
        }
    }
    m = fmaxf(m, shfl32(m));
    float l = 0.f;
#pragma unroll
    for (int j = 0; j < 5; ++j) {
#pragma unroll
        for (int r = 0; r < 16; ++r) { const float pe = __builtin_amdgcn_exp2f(S[j][r] - m); S[j][r] = pe; l += pe; }
    }
    l += shfl32(l);
    f32x16 o0 = {0.f, 0.f, 0.f, 0.f, 0.f, 0.f, 0.f, 0.f, 0.f, 0.f, 0.f, 0.f, 0.f, 0.f, 0.f, 0.f}, o1 = o0;
    const int a4 = lane & 15, G4 = lane >> 4;
    const LAS unsigned char* vbase = lds + AT_V0 + (32 * wave + 4 * (G4 >> 1) + (a4 >> 2)) * AT_VROWB + (16 * (G4 & 1) + 4 * (a4 & 3)) * 2;
#pragma unroll
    for (int j = 0; j < 5; ++j) {
        {
#pragma unroll
            for (int s2 = 0; s2 < 2; ++s2) {
                u32x4 pw;
                pw.x = pg8::cvt_pk_bf16(S[j][8 * s2 + 0], S[j][8 * s2 + 1]); pw.y = pg8::cvt_pk_bf16(S[j][8 * s2 + 2], S[j][8 * s2 + 3]);
                pw.z = pg8::cvt_pk_bf16(S[j][8 * s2 + 4], S[j][8 * s2 + 5]); pw.w = pg8::cvt_pk_bf16(S[j][8 * s2 + 6], S[j][8 * s2 + 7]);
                const s16x8 pfrag = __builtin_bit_cast(s16x8, pw);
                const LAS unsigned char* vp = vbase + (32 * j + 16 * s2) * AT_VROWB;
                const s16x4 a0 = vtr(vp), a1 = vtr(vp + 8 * AT_VROWB), b0 = vtr(vp + 64), b1 = vtr(vp + 8 * AT_VROWB + 64);
                const s16x8 va = {a0[0], a0[1], a0[2], a0[3], a1[0], a1[1], a1[2], a1[3]};
                const s16x8 vb = {b0[0], b0[1], b0[2], b0[3], b1[0], b1[1], b1[2], b1[3]};
                o0 = __builtin_amdgcn_mfma_f32_32x32x16_bf16(va, pfrag, o0, 0, 0, 0);
                o1 = __builtin_amdgcn_mfma_f32_32x32x16_bf16(vb, pfrag, o1, 0, 0, 0);
            }
        }
    }
    const int pos = pos0 + 32 * wave + r32;
    const int t = ((pos & ((4096 >> sh) - 1)) << sh) + (pos >> (12 - sh));
    const size_t row = (size_t)b * 4096 + t;
    const float inv = 1.0f / l;
    bf16* op = OG + ((size_t)g * MR + row) * DAO + hh * 64 + 4 * h;
#pragma unroll
    for (int i = 0; i < 4; ++i) {
        u32x2 w0, w1;
        w0.x = pg8::cvt_pk_bf16(o0[4 * i] * inv, o0[4 * i + 1] * inv); w0.y = pg8::cvt_pk_bf16(o0[4 * i + 2] * inv, o0[4 * i + 3] * inv);
        w1.x = pg8::cvt_pk_bf16(o1[4 * i] * inv, o1[4 * i + 1] * inv); w1.y = pg8::cvt_pk_bf16(o1[4 * i + 2] * inv, o1[4 * i + 3] * inv);
        *(u32x2*)(op + 8 * i) = w0; *(u32x2*)(op + 32 + 8 * i) = w1;
    }
    if (h == 0) LSE[((size_t)g * MR + row) * 4 + hh] = m + __builtin_amdgcn_logf(l);
}
__device__ __forceinline__ void attn_phase_mfma(const Params& p, LAS unsigned char* lds, int vcu, int tid, int wave, int lane) {
    unsigned char* ws = p.ws;
    const bf16* Q = (const bf16*)(ws + WS_Q); const bf16* K = (const bf16*)(ws + WS_K); const bf16* V = (const bf16*)(ws + WS_V);
    bf16* OG = (bf16*)(ws + WS_OG); float* LSE = (float*)(ws + WS_LSE);
    AttnPf pf;
    const int u0 = vcu * AT_PER_WG;
    attn_prefetch(pf, Q, K, V, u0, tid, wave, lane);
#pragma unroll 1
    for (int i = 0; i < AT_PER_WG; ++i) {
        const int u = u0 + i;
        attn_stage(pf, lds, u, tid);
        AttnPf cur;
#pragma unroll
        for (int ks = 0; ks < 4; ++ks) cur.q[ks] = pf.q[ks];
        __syncthreads();
        if (i + 1 < AT_PER_WG) attn_prefetch(pf, Q, K, V, u + 1, tid, wave, lane);
        attn_compute(cur, lds, OG, LSE, u, wave, lane);
        __syncthreads();
    }
}
__device__ __forceinline__ void merge4(const bf16* OG, const float* LSE, bf16* OATT, int row0, int rstep, int ch, int n) {
    float l[4][3]; u32x4 og[4][3];
    const int hh = ch >> 3;
#pragma unroll
    for (int q = 0; q < 4; ++q) {
        if (q < n) {
            const int row = row0 + q * rstep;
#pragma unroll
            for (int g = 0; g < 3; ++g) { l[q][g] = LSE[((size_t)g * MR + row) * 4 + hh]; og[q][g] = __builtin_nontemporal_load((const u32x4*)(OG + ((size_t)g * MR + row) * DAO + ch * 8)); }
        }
    }
#pragma unroll
    for (int q = 0; q < 4; ++q) {
        if (q < n) {
            const int row = row0 + q * rstep;
            const float mx = fmaxf(l[q][0], fmaxf(l[q][1], l[q][2]));
            float e0 = __builtin_amdgcn_exp2f(l[q][0] - mx), e1 = __builtin_amdgcn_exp2f(l[q][1] - mx), e2 = __builtin_amdgcn_exp2f(l[q][2] - mx);
            const float inv = 1.0f / (e0 + e1 + e2); e0 *= inv; e1 *= inv; e2 *= inv;
            f32x4 a0, b0, a1, b1, a2, b2;
            unpack8(og[q][0], a0, b0); unpack8(og[q][1], a1, b1); unpack8(og[q][2], a2, b2);
            *(u32x4*)(OATT + (size_t)row * KC + ch * 8) = pack8(a0 * e0 + a1 * e1 + a2 * e2, b0 * e0 + b1 * e1 + b2 * e2);
        }
    }
}
__device__ __forceinline__ void merge_phase(const Params& p, int vcu, int tid) {
    unsigned char* ws = p.ws;
    const bf16* OG = (const bf16*)(ws + WS_OG); const float* LSE = (const float*)(ws + WS_LSE); bf16* OATT = (bf16*)(ws + WS_A);
    const int r0 = 128 * vcu + (tid >> 5), ch = tid & 31;
    merge4(OG, LSE, OATT, r0, 16, ch, 4);
    merge4(OG, LSE, OATT, r0 + 64, 16, ch, 4);
    const int it = vcu * 16 + (tid & 15);
    merge4(OG, LSE, OATT, MP + (it >> 5), 0, it & 31, (tid < 16) ? 1 : 0);
}

typedef float f32x2 __attribute__((ext_vector_type(2)));
constexpr int CV_T = 32, CV_UNITS = MP / CV_T, CV_PER_WG = CV_UNITS / 256;
template <int E> __device__ __forceinline__ void conv_loads(unsigned (&uw)[62], const bf16* up, bool has_left) {
    if constexpr (E < 62) {
        uw[E] = 0u;
        if (E >= 30 || has_left) uw[E] = *(const unsigned*)(up + (size_t)E * DM);
        conv_loads<E + 1>(uw, up, has_left);
    }
}
template <int E> __device__ __forceinline__ void conv_steps(f32x2 (&acc)[32], const f32x2 (&w)[31], const unsigned (&uw)[62]) {
    if constexpr (E < 62) {
        const f32x2 uv = {bf_lo(uw[E]), bf_hi(uw[E])};
        constexpr int TLO = (E - 30 > 0) ? E - 30 : 0, THI = (E < 31) ? E : 31;
#pragma unroll
        for (int t = TLO; t <= THI; ++t) acc[t] = acc[t] + w[E - t] * uv;
        conv_steps<E + 1>(acc, w, uw);
    }
}
__device__ __forceinline__ void conv_unit(const Params& p, LAS unsigned char* lds, const bf16* U, bf16* CACT, int unit, int tid, int wave, int lane,
                                          const f32x2 (&w)[31], f32x2 cb, f32x2 lw, f32x2 lb) {
    const int row0 = unit * CV_T, t0 = row0 & 4095, ch = 2 * tid;
    f32x2 acc[CV_T];
#pragma unroll
    for (int t = 0; t < CV_T; ++t) acc[t] = cb;
    const bf16* up = U + (size_t)(row0 - 30) * DM + ch;
    unsigned uw[62];
    conv_loads<0>(uw, up, t0 != 0);
    conv_steps<0>(acc, w, uw);
    float v[64];
#pragma unroll
    for (int t = 0; t < CV_T; ++t) { v[t] = acc[t].x + acc[t].y; v[32 + t] = acc[t].x * acc[t].x + acc[t].y * acc[t].y; }
#define CV_BFLY(n) { const bool up_half = (lane & (n)) != 0; _Pragma("unroll") for (int i = 0; i < (n); ++i) { \
        const float keep = up_half ? v[i + (n)] : v[i], send = up_half ? v[i] : v[i + (n)]; v[i] = keep + __shfl_xor(send, (n)); } }
    CV_BFLY(32) CV_BFLY(16) CV_BFLY(8) CV_BFLY(4) CV_BFLY(2) CV_BFLY(1)
#undef CV_BFLY
    LAS float* red = (LAS float*)lds;
    red[wave * 64 + lane] = v[0];
    __syncthreads();
    float tot = 0.f;
#pragma unroll
    for (int w8 = 0; w8 < 8; ++w8) tot += red[w8 * 64 + lane];
    __syncthreads();
    const float sq = __shfl(tot, (lane & 31) + 32);
    const float mean = tot * (1.0f / DM);
    const float var = sq * (1.0f / DM) - mean * mean;
    const float rstd = __builtin_amdgcn_rsqf(fmaxf(var, 0.f) + LN_EPS);
#pragma unroll
    for (int t = 0; t < CV_T; ++t) {
        const float mt = __builtin_bit_cast(float, __builtin_amdgcn_readlane(__builtin_bit_cast(int, mean), t));
        const float rt = __builtin_bit_cast(float, __builtin_amdgcn_readlane(__builtin_bit_cast(int, rstd), t));
        float y0 = (acc[t].x - mt) * rt * lw.x + lb.x, y1 = (acc[t].y - mt) * rt * lw.y + lb.y;
        y0 = y0 * sigmoidf_(y0); y1 = y1 * sigmoidf_(y1);
        *(unsigned*)(CACT + (size_t)(row0 + t) * KC + ch) = pg8::cvt_pk_bf16(y0, y1);
    }
}
__device__ __forceinline__ void conv_phase(const Params& p, LAS unsigned char* lds, int vcu, int tid, int wave, int lane) {
    unsigned char* ws = p.ws;
    const bf16* U = (const bf16*)(ws + WS_B); bf16* CACT = (bf16*)(ws + WS_A) + DAO;
    const int ch = 2 * tid;
    f32x2 w[31];
#pragma unroll
    for (int i = 0; i < 31; ++i) w[i] = *(const f32x2*)(p.in[11] + (size_t)i * DM + ch);
    const f32x2 cb = *(const f32x2*)(p.in[12] + ch), lw = *(const f32x2*)(p.in[13] + ch), lb = *(const f32x2*)(p.in[14] + ch);
#pragma unroll 1
    for (int i = 0; i < CV_PER_WG; ++i) conv_unit(p, lds, U, CACT, vcu * CV_PER_WG + i, tid, wave, lane, w, cb, lw, lb);
    if (vcu < SB) {
        const int b = vcu;
        f32x2 u[34];
#pragma unroll
        for (int e = 0; e < 30; ++e) u[e] = *(const f32x2*)(p.in[5] + ((size_t)b * 30 + e) * DM + ch);
#pragma unroll
        for (int e = 30; e < 34; ++e) { const unsigned wv = *(const unsigned*)(U + (size_t)(MP + 4 * b + e - 30) * DM + ch); u[e] = (f32x2){bf_lo(wv), bf_hi(wv)}; }
        f32x2 acc[4]; float v[8];
#pragma unroll
        for (int s4 = 0; s4 < 4; ++s4) {
            acc[s4] = cb;
#pragma unroll
            for (int i = 0; i < 31; ++i) acc[s4] = acc[s4] + w[i] * u[s4 + i];
            v[s4] = acc[s4].x + acc[s4].y; v[4 + s4] = acc[s4].x * acc[s4].x + acc[s4].y * acc[s4].y;
        }
#pragma unroll
        for (int o = 1; o < 64; o <<= 1)
#pragma unroll
            for (int j = 0; j < 8; ++j) v[j] += __shfl_xor(v[j], o);
        LAS float* red = (LAS float*)lds;
        __syncthreads();
        if (lane < 8) {
            float mine = v[0];
#pragma unroll
            for (int j = 1; j < 8; ++j) mine = (lane == j) ? v[j] : mine;
            red[wave * 8 + lane] = mine;
        }
        __syncthreads();
#pragma unroll
        for (int s4 = 0; s4 < 4; ++s4) {
            float sm = 0.f, sq = 0.f;
#pragma unroll
            for (int w8 = 0; w8 < 8; ++w8) { sm += red[w8 * 8 + s4]; sq += red[w8 * 8 + 4 + s4]; }
            const float mean = sm * (1.0f / DM), var = sq * (1.0f / DM) - mean * mean, rstd = __builtin_amdgcn_rsqf(fmaxf(var, 0.f) + LN_EPS);
            float y0 = (acc[s4].x - mean) * rstd * lw.x + lb.x, y1 = (acc[s4].y - mean) * rstd * lw.y + lb.y;
            y0 = y0 * sigmoidf_(y0); y1 = y1 * sigmoidf_(y1);
            *(unsigned*)(CACT + (size_t)(MP + 4 * b + s4) * KC + ch) = pg8::cvt_pk_bf16(y0, y1);
        }
        __syncthreads();
    }
}

typedef float f32x4v __attribute__((ext_vector_type(4)));
template <int NRB, int NCB, int K>
__device__ __forceinline__ void thin_partial(LAS float* P, const bf16* A, int lda, const bf16* B0, const bf16* B1, int ldb, int wave, int lane) {
    constexpr int KW = K / 8, STEPS = KW / 32, ROWS = 16 * NRB, COLS = 16 * NCB;
    const int r16 = lane & 15, k8 = lane >> 4;
    f32x4v acc[NRB][NCB];
#pragma unroll
    for (int rb = 0; rb < NRB; ++rb)
#pragma unroll
        for (int cb = 0; cb < NCB; ++cb) acc[rb][cb] = (f32x4v){0.f, 0.f, 0.f, 0.f};
    const bf16* ap = A + (size_t)r16 * lda + wave * KW + 8 * k8;
    const bf16* bp0 = B0 + (size_t)r16 * ldb + wave * KW + 8 * k8;
    const bf16* bp1 = B1 + (size_t)r16 * ldb + wave * KW + 8 * k8;
#pragma unroll
    for (int st = 0; st < STEPS; ++st) {
        bf16x8 b[NCB];
        b[0] = *(const bf16x8*)(bp0 + 32 * st);
        if (NCB > 1) b[NCB - 1] = *(const bf16x8*)(bp1 + 32 * st);
#pragma unroll
        for (int rb = 0; rb < NRB; ++rb) {
            const bf16x8 a = *(const bf16x8*)(ap + (size_t)(16 * rb) * lda + 32 * st);
#pragma unroll
            for (int cb = 0; cb < NCB; ++cb) acc[rb][cb] = __builtin_amdgcn_mfma_f32_16x16x32_bf16(a, b[cb], acc[rb][cb], 0, 0, 0);
        }
    }
#pragma unroll
    for (int rb = 0; rb < NRB; ++rb)
#pragma unroll
        for (int cb = 0; cb < NCB; ++cb)
#pragma unroll
            for (int r = 0; r < 4; ++r) P[(wave * ROWS + 16 * rb + 4 * k8 + r) * COLS + 16 * cb + r16] = acc[rb][cb][r];
}
template <int ROWS, int COLS> __device__ __forceinline__ float thin_sum(const LAS float* P, int r, int c) {
    float v = 0.f;
#pragma unroll
    for (int w = 0; w < 8; ++w) v += P[(w * ROWS + r) * COLS + c];
    return v;
}
template <int STAGE> __device__ __forceinline__ void thin_stage(const Params& p, LAS unsigned char* lds, int vcu, int tid, int wave, int lane) {
    unsigned char* ws = p.ws;
    LAS float* P = (LAS float*)lds;
    if constexpr (STAGE == 0 || STAGE == 1 || STAGE == 2 || STAGE == 4) {
        constexpr int K = (STAGE == 0) ? DAO : (STAGE == 4) ? DFF : DM;
        constexpr int LDA = (STAGE <= 1) ? KC : K, LDB = (STAGE <= 1) ? KC : K;
        const bf16* A = (STAGE == 0) ? (const bf16*)(ws + WS_A) : (STAGE == 1) ? (const bf16*)(ws + WS_A) + DAO : (STAGE == 2) ? (const bf16*)(ws + WS_B) : (const bf16*)(ws + WS_ACT);
        const bf16* B = (STAGE == 0) ? (const bf16*)(ws + WS_WCAT) : (STAGE == 1) ? (const bf16*)(ws + WS_WCAT) + DAO : (STAGE == 2) ? (const bf16*)(ws + WS_WOUT) : (const bf16*)(ws + WS_WD);
        const int ct = vcu & 63, rb = vcu >> 6, row0 = MP + 32 * rb, col0 = 16 * ct;
        thin_partial<2, 1, K>(P, A + (size_t)row0 * LDA, LDA, B + (size_t)col0 * LDB, B + (size_t)col0 * LDB, LDB, wave, lane);
        __syncthreads();
        const int r = tid >> 4, c = tid & 15, row = row0 + r, col = col0 + c;
        const float acc = thin_sum<32, 16>(P, r, c);
        if constexpr (STAGE == 0) {
            const bf16* GA = (const bf16*)(ws + WS_GA); bf16* HA = (bf16*)(ws + WS_B);
            HA[(size_t)row * DM + col] = (bf16)f2bf(acc * ((float)((const unsigned char*)GA)[(size_t)row * GP + col] * (1.0f / 255.0f)));
        } else if constexpr (STAGE == 1) {
            const bf16* GB = (const bf16*)(ws + WS_GB); bf16* H = (bf16*)(ws + WS_B);
            H[(size_t)row * DM + col] = (bf16)f2bf(acc * ((float)((const unsigned char*)GB)[(size_t)row * GP + col] * (1.0f / 255.0f)) + bf_lo((unsigned)H[(size_t)row * DM + col]));
        } else if constexpr (STAGE == 2) {
            const float x1 = p.in[1][(size_t)(row - MP) * DM + col] + acc;
            p.out[(size_t)row * DM + col] = x1;
            ((bf16*)(ws + WS_X1B))[(size_t)row * DM + col] = (bf16)f2bf(x1);
            float ss = x1 * x1;
            ss += __shfl_xor(ss, 1); ss += __shfl_xor(ss, 2); ss += __shfl_xor(ss, 4); ss += __shfl_xor(ss, 8);
            if (c == 0) ((float*)(ws + WS_SSS))[(size_t)(row - MP) * 64 + ct] = ss;
        } else {
            p.out[(size_t)row * DM + col] += acc;
        }
        __syncthreads();
    } else {
        const bf16* A = (const bf16*)(ws + WS_X1B); const bf16* B = (const bf16*)(ws + WS_WGU); bf16* ACT = (bf16*)(ws + WS_ACT);
        const float* SSS = (const float*)(ws + WS_SSS);
        for (int u = vcu; u < 352; u += 256) {
            const int ct = u % 176, rb = u / 176, row0 = MP + 64 * rb, ch0 = 16 * ct;
            const int bpos = (ch0 >> 7) * 256 + (ch0 & 127);
            thin_partial<4, 2, DM>(P, A + (size_t)row0 * DM, DM, B + (size_t)bpos * DM, B + (size_t)(bpos + 128) * DM, DM, wave, lane);
            __syncthreads();
#pragma unroll
            for (int i = 0; i < 2; ++i) {
                const int e = tid + 512 * i, r = e >> 4, c = e & 15, row = row0 + r;
                const f32x4 sv = *(const f32x4*)(SSS + (size_t)(row - MP) * 64 + 4 * c);
                float tot = (sv[0] + sv[1]) + (sv[2] + sv[3]);
                tot += __shfl_xor(tot, 1); tot += __shfl_xor(tot, 2); tot += __shfl_xor(tot, 4); tot += __shfl_xor(tot, 8);
                const float rstd = __builtin_amdgcn_rsqf(tot * (1.0f / DM) + RMS_EPS);
                const float g = thin_sum<64, 32>(P, r, c) * rstd, up = thin_sum<64, 32>(P, r, 16 + c) * rstd;
                ACT[(size_t)row * DFF + ch0 + c] = (bf16)f2bf(g * sigmoidf_(g) * up);
            }
            __syncthreads();
        }
    }
}

__device__ __forceinline__ void tr_item(const float* W, int ldw, int K, bf16* WT, int k0, int pos0, int src0, const float* ksc, LAS float* scr, int lane, int kdst = 0) {
    const int kr = lane >> 3, n4 = lane & 7;
    f32x4 v[8];
#pragma unroll
    for (int i = 0; i < 8; ++i) v[i] = __builtin_nontemporal_load((const GAS f32x4*)(W + (size_t)(k0 + kr + 8 * i) * ldw + src0 + 4 * n4));
#pragma unroll
    for (int i = 0; i < 8; ++i) {
        const int kk = kr + 8 * i;
        const float sc = ksc ? ksc[k0 + kk] : 1.0f;
        LAS float* d = scr + kk * 33 + 4 * n4;
        d[0] = v[i].x * sc; d[1] = v[i].y * sc; d[2] = v[i].z * sc; d[3] = v[i].w * sc;
    }
    LDS_WAIT(); asm volatile("" ::: "memory");
    const int c = lane & 7;
#pragma unroll
    for (int j = 0; j < 4; ++j) { const int n = (lane >> 3) + 8 * j; const LAS float* s = scr + (8 * c) * 33 + n;
        v4u o; o.x = pk2(s[0 * 33], s[1 * 33]); o.y = pk2(s[2 * 33], s[3 * 33]); o.z = pk2(s[4 * 33], s[5 * 33]); o.w = pk2(s[6 * 33], s[7 * 33]);
        *(GAS v4u*)(WT + (size_t)(pos0 + n) * K + kdst + k0 + 8 * c) = o; }
    LDS_WAIT(); asm volatile("" ::: "memory");
}
__device__ __forceinline__ int w1_src(int pos0) {
    const int pn = pos0 >> 8, p = pos0 & 255;
    if (pn < 9) { const int seg = pn / 3, g = pn - 3 * seg; return seg * 768 + g * 256 + 64 * ((p >> 5) & 3) + 32 * (p >> 7); }
    if (pn < 17) { return ((p < 128) ? 2304 : 3328) + 128 * (pn - 9) + (p & 127); }
    return pos0;
}
__device__ __forceinline__ int wgu_src(int pos0) { const int pn = pos0 >> 8, p = pos0 & 255; return ((p < 128) ? 0 : DFF) + 128 * pn + (p & 127); }

__device__ __forceinline__ void tr_load(const float* W, int ldw, int k0, int src0, int lane, f32x4 (&v)[8]) {
    const int kr = lane >> 3, n4 = lane & 7;
#pragma unroll
    for (int i = 0; i < 8; ++i) v[i] = __builtin_nontemporal_load((const GAS f32x4*)(W + (size_t)(k0 + kr + 8 * i) * ldw + src0 + 4 * n4));
}
__device__ __forceinline__ void tr_store(const f32x4 (&v)[8], int K, bf16* WT, int k0, int pos0, const float* ksc, LAS float* scr, int lane, int kdst) {
    const int kr = lane >> 3, n4 = lane & 7;
#pragma unroll
    for (int i = 0; i < 8; ++i) {
        const int kk = kr + 8 * i;
        const float sc = ksc ? ksc[k0 + kk] : 1.0f;
        LAS float* d = scr + kk * 33 + 4 * n4;
        d[0] = v[i].x * sc; d[1] = v[i].y * sc; d[2] = v[i].z * sc; d[3] = v[i].w * sc;
    }
    LDS_WAIT(); asm volatile("" ::: "memory");
    const int c = lane & 7;
#pragma unroll
    for (int j = 0; j < 4; ++j) { const int n = (lane >> 3) + 8 * j; const LAS float* s = scr + (8 * c) * 33 + n;
        v4u o; o.x = pk2(s[0 * 33], s[1 * 33]); o.y = pk2(s[2 * 33], s[3 * 33]); o.z = pk2(s[4 * 33], s[5 * 33]); o.w = pk2(s[6 * 33], s[7 * 33]);
        *(GAS v4u*)(WT + (size_t)(pos0 + n) * K + kdst + k0 + 8 * c) = o; }
    LDS_WAIT(); asm volatile("" ::: "memory");
}
constexpr int LW_ATT = 4 * 32, LW_CO = 16 * 32, LW_OUT = 16 * 32, LW_GU = 16 * (NGU / 32), LW_D = (DFF / 64) * 32, LW_ITEMS = LW_ATT + LW_CO + LW_OUT + LW_GU + LW_D;
__device__ __forceinline__ void lw_load(const Params& p, int it, int lane, f32x4 (&v)[8]) {
    int r = it;
    if (r >= LW_ITEMS) return;
    if (r < LW_ATT) { tr_load(p.in[10], DM, 64 * (r / 32), 32 * (r % 32), lane, v); return; } r -= LW_ATT;
    if (r < LW_CO) { tr_load(p.in[15], DM, 64 * (r / 32), 32 * (r % 32), lane, v); return; } r -= LW_CO;
    if (r < LW_OUT) { tr_load(p.in[16], DM, 64 * (r / 32), 32 * (r % 32), lane, v); return; } r -= LW_OUT;
    if (r < LW_GU) { tr_load(p.in[18], NGU, 64 * (r / (NGU / 32)), wgu_src(32 * (r % (NGU / 32))), lane, v); return; } r -= LW_GU;
    tr_load(p.in[19], DM, 64 * (r / 32), 32 * (r % 32), lane, v);
}
__device__ __forceinline__ void lw_store(const Params& p, int it, int lane, const f32x4 (&v)[8], LAS float* scr) {
    unsigned char* ws = p.ws;
    int r = it;
    if (r >= LW_ITEMS) return;
    if (r < LW_ATT) { tr_store(v, KC, (bf16*)(ws + WS_WCAT), 64 * (r / 32), 32 * (r % 32), nullptr, scr, lane, 0); return; } r -= LW_ATT;
    if (r < LW_CO) { tr_store(v, KC, (bf16*)(ws + WS_WCAT), 64 * (r / 32), 32 * (r % 32), nullptr, scr, lane, DAO); return; } r -= LW_CO;
    if (r < LW_OUT) { tr_store(v, DM, (bf16*)(ws + WS_WOUT), 64 * (r / 32), 32 * (r % 32), nullptr, scr, lane, 0); return; } r -= LW_OUT;
    if (r < LW_GU) { tr_store(v, DM, (bf16*)(ws + WS_WGU), 64 * (r / (NGU / 32)), 32 * (r % (NGU / 32)), p.in[17], scr, lane, 0); return; } r -= LW_GU;
    tr_store(v, DFF, (bf16*)(ws + WS_WD), 64 * (r / 32), 32 * (r % 32), nullptr, scr, lane, 0);
}
__device__ __forceinline__ void late_weights(const Params& p, LAS unsigned char* lds, int idx, int nwk, int wave, int lane) {
    LAS float* scr = (LAS float*)(lds + wave * 16384);
    const int stride = nwk * NWAVES;
    for (int it = idx * NWAVES + wave; it < LW_ITEMS; it += 4 * stride) {
        f32x4 v[4][8];
#pragma unroll
        for (int q = 0; q < 4; ++q) lw_load(p, it + q * stride, lane, v[q]);
#pragma unroll
        for (int q = 0; q < 4; ++q) lw_store(p, it + q * stride, lane, v[q], scr);
    }
}
__device__ __forceinline__ void copy_rows(const float* src, float* dst, int rows, int per, int rw, int gt, int NGT) {
    const int n4b = rows * rw, tot = SB * n4b;
    for (int i0 = gt; i0 < tot; i0 += 8 * NGT) {
        f32x4 v[8];
#pragma unroll
        for (int j = 0; j < 8; ++j) { const int i = i0 + j * NGT; if (i < tot) { const int b = i / n4b, r = i - b * n4b; v[j] = __builtin_nontemporal_load((const GAS f32x4*)src + (size_t)b * per * rw + 4 * rw + r); } }
#pragma unroll
        for (int j = 0; j < 8; ++j) { const int i = i0 + j * NGT; if (i < tot) { const int b = i / n4b, r = i - b * n4b; __builtin_nontemporal_store(v[j], (GAS f32x4*)dst + (size_t)b * per * rw + r); } }
    }
}
__device__ __forceinline__ void p0_prologue(const Params& p, LAS unsigned char* lds, int vcu, int G, int wave, int lane) {
    unsigned char* ws = p.ws;
    LAS float* scr = (LAS float*)(lds + wave * 16384);
    const int gw = vcu * NWAVES + wave, NGW = G * NWAVES;
    constexpr int I_W1 = 16 * (NIN / 32);
    for (int r = gw; r < I_W1; r += NGW) { const int nb = r % (NIN / 32), kb = r / (NIN / 32); tr_item(p.in[7], NIN, DM, (bf16*)(ws + WS_W1), 64 * kb, 32 * nb, w1_src(32 * nb), nullptr, scr, lane); }
    bf16* XN = (bf16*)(ws + WS_A);
    const float* nw = p.in[6];
    f32x4 wv[4];
#pragma unroll
    for (int j = 0; j < 4; ++j) wv[j] = *((const f32x4*)nw + lane + 64 * j);
    for (int m0 = gw; m0 < MR; m0 += 2 * NGW) {
        f32x4 v[2][4];
#pragma unroll
        for (int q = 0; q < 2; ++q) {
            const int m = m0 + q * NGW;
            if (m < MV) {
                const float* xrow = (m < MP) ? p.in[0] + (size_t)m * DM : p.in[1] + (size_t)(m - MP) * DM;
                const GAS f32x4* xr = (const GAS f32x4*)xrow + lane;
#pragma unroll
                for (int j = 0; j < 4; ++j) v[q][j] = __builtin_nontemporal_load(xr + 64 * j);
            } else {
#pragma unroll
                for (int j = 0; j < 4; ++j) v[q][j] = (f32x4){0.f, 0.f, 0.f, 0.f};
            }
        }
#pragma unroll
        for (int q = 0; q < 2; ++q) {
            const int m = m0 + q * NGW;
            if (m < MR) {
                float s = 0.f;
#pragma unroll
                for (int j = 0; j < 4; ++j) s += (v[q][j].x * v[q][j].x + v[q][j].y * v[q][j].y) + (v[q][j].z * v[q][j].z + v[q][j].w * v[q][j].w);
                const float rstd = __builtin_amdgcn_rsqf(wave_sum(s) * (1.f / DM) + RMS_EPS);
                GAS unsigned long long* o8 = (GAS unsigned long long*)(XN + (size_t)m * DM) + lane;
#pragma unroll
                for (int j = 0; j < 4; ++j) { const f32x4 y = v[q][j] * rstd * wv[j]; o8[64 * j] = (unsigned long long)pk2(y.x, y.y) | ((unsigned long long)pk2(y.z, y.w) << 32); }
            }
        }
    }
}

#define CW_XT        0
#define CW_QC(q)     (1024 + 16 * (q))
#define CW_BS(k, x)  (2048 + 256 * (k) + 16 * (x))
#define CW_BT(k)     (3200 + 16 * (k))
struct QuadOrder {
    int pm0, j, nN, nu;
    __device__ __forceinline__ void init(int vcu, int nN_) { pm0 = 2 * (vcu >> 2); j = vcu & 3; nN = nN_; nu = nN_ / 2; }
    __device__ __forceinline__ bool next(int i, pg8::Unit& u) const { if (i >= nu) return false; const int idx = 4 * i + j, hi = (idx >= nN) ? 1 : 0; u.pm = pm0 + hi; u.pn = idx - hi * nN; return true; }
    __device__ __forceinline__ void a_ready(const pg8::Unit&) const {}
    __device__ __forceinline__ void done(const pg8::Unit&) const {}
};
__device__ __forceinline__ void stage_done(const XcdBarrier& b, unsigned* ctlw, volatile LAS unsigned* misc, int quad, int k) {
    asm volatile("s_waitcnt vmcnt(0)" ::: "memory");
    __syncthreads();
    if (threadIdx.x == 0) {
        __builtin_amdgcn_s_waitcnt(0);
        if (misc[10] == 0u) { __builtin_amdgcn_fence(__ATOMIC_RELEASE, "agent"); asm volatile("s_waitcnt vmcnt(0)" ::: "memory"); }
        (void)xb_add(&ctlw[CW_QC(quad)], 1u);
        const unsigned nloc = b.st[0];
        const unsigned old = xb_add(&ctlw[CW_BS(k, b.x)], 1u);
        if (old + 1u == nloc) { __builtin_amdgcn_fence(__ATOMIC_RELEASE, "agent"); asm volatile("s_waitcnt vmcnt(0)" ::: "memory"); (void)xb_add(&ctlw[CW_BT(k)], 1u); }
    }
}
__device__ __forceinline__ void quad_wait(const XcdBarrier& b, unsigned* ctlw, int quad, unsigned target, bool next_too) {
    if (threadIdx.x == 0) {
        XB_SPIN(xb_ld(&ctlw[CW_QC(quad)]) < target, b.bar);
        if (next_too) XB_SPIN(xb_ld(&ctlw[CW_QC(quad + 1)]) < 4u, b.bar);
        __builtin_amdgcn_fence(__ATOMIC_ACQUIRE, "agent");
        asm volatile("s_waitcnt vmcnt(0)" ::: "memory");
    }
    __syncthreads();
}
__device__ __forceinline__ void split_wait(const XcdBarrier& b, unsigned* ctlw, int k) {
    if (threadIdx.x == 0) {
        const unsigned nx = b.st[1];
        XB_SPIN(xb_ld(&ctlw[CW_BT(k)]) < nx, b.bar);
        __builtin_amdgcn_fence(__ATOMIC_ACQUIRE, "agent");
        asm volatile("s_waitcnt vmcnt(0)" ::: "memory");
    }
    __syncthreads();
}

__global__ void __launch_bounds__(NWAVES * 64, 2) fwd_kernel(Params p) {
    extern __shared__ __attribute__((aligned(16))) unsigned char lds_raw[];
    LAS unsigned char* lds = (LAS unsigned char*)lds_raw;
    volatile LAS unsigned* MISC = (volatile LAS unsigned*)(lds + MISC_OFF);
    const int tid = threadIdx.x, lane = tid & 63, wave = __builtin_amdgcn_readfirstlane(tid >> 6);
    const int G = gridDim.x; const int bx = blockIdx.x; const int vcu = (G % 8 == 0) ? (bx % 8) * (G / 8) + bx / 8 : bx;
    unsigned char* ws = p.ws;
    gu32* ctl = (gu32*)(ws + WS_CTL);
    for (int u = tid; u < (LDS_BYTES - LDSCTL_OFF) / 4; u += NWAVES * 64) ((LAS unsigned*)(lds + LDSCTL_OFF))[u] = 0u;
    __syncthreads();
    XcdBarrier bar = xcd_barrier_post((unsigned*)(ctl + CW_BAR), MISC + 8);
    if (tid == 0) __hip_atomic_store((unsigned*)ctl + CW_XT + vcu, bar.x + 1u, __ATOMIC_RELAXED, __HIP_MEMORY_SCOPE_AGENT);
    const int lo = p.ph_lo, hi = p.ph_hi;
#define IN(k) (lo <= (k) && (k) < hi)
#define BOTH(k) (IN(k) && IN((k) + 1))

#if PH_MASK & 1
    if (IN(0)) { p0_prologue(p, lds, vcu, G, wave, lane); if (BOTH(0)) xcd_barrier(bar); }
#endif

#if PH_MASK & (1 << 1)
    if (IN(1)) {
        pg8::Gemm g{(const bf16*)(ws + WS_A), (const bf16*)(ws + WS_W1), MR, NIN, DM}; pg8::StaticOrder S; S.init(MR, NIN, G, bx);
        EpiP1 E{(bf16*)(ws + WS_Q), (bf16*)(ws + WS_K), (bf16*)(ws + WS_V), (bf16*)(ws + WS_B), (bf16*)(ws + WS_GA), (bf16*)(ws + WS_GB), (float*)(ws + WS_SQ), p.out, p.in[8], p.in[9], CopyCtx{p.in[2], p.in[3], p.in[4], p.in[5], p.out}};
        {
            const int nwg = (MR / 256) * (NIN / 256), nfull = nwg % G;
            if (nfull == 0) late_weights(p, lds, bx, G, wave, lane);
            else if (bx >= nfull) late_weights(p, lds, bx - nfull, G - nfull, wave, lane);
        }
        __syncthreads();
        pg8::gemm_phase<EpiP1, pg8::StaticOrder, true, true>(lds, g, S, E);
        if (BOTH(1)) xcd_barrier(bar);
    }
#endif

#if PH_MASK & (1 << 2)
    if (IN(2)) {
        attn_phase_mfma(p, lds, vcu, tid, wave, lane);
        if (wave < 6) attn_sample_unit(p, (LAS float*)(lds + 8192 + wave * 1024), wave * 256 + vcu, lane);
        __syncthreads();
        if (BOTH(2)) xcd_barrier(bar);
    }
#endif
    {
        unsigned* ctlw = (unsigned*)ctl;
        const int quad = vcu >> 2;
        if (tid == 0) {
            const unsigned x0 = xb_ld(&ctlw[CW_XT + 4 * quad]), x1 = xb_ld(&ctlw[CW_XT + 4 * quad + 1]), x2 = xb_ld(&ctlw[CW_XT + 4 * quad + 2]), x3 = xb_ld(&ctlw[CW_XT + 4 * quad + 3]);
            MISC[10] = (x0 != 0u && x0 == x1 && x1 == x2 && x2 == x3) ? 1u : 0u;
        }
        if (vcu & 1) { conv_phase(p, lds, vcu, tid, wave, lane); merge_phase(p, vcu, tid); }
        else { merge_phase(p, vcu, tid); conv_phase(p, lds, vcu, tid, wave, lane); }
        stage_done(bar, ctlw, MISC, quad, 0);
        if (IN(4)) {
            quad_wait(bar, ctlw, quad, 4u, quad + 1 < 64);
            int k_cat = KC; asm volatile("" : "+s"(k_cat));
            pg8::Gemm g{(const bf16*)(ws + WS_A), (const bf16*)(ws + WS_WCAT), MP, DM, k_cat}; QuadOrder S; S.init(vcu, DM / 256);
            EpiGateF E{(const unsigned char*)(ws + WS_GA), (const unsigned char*)(ws + WS_GB), (bf16*)(ws + WS_B)};
            pg8::gemm_phase<EpiGateF, QuadOrder, true, true>(lds, g, S, E);
            split_wait(bar, ctlw, 0);
            thin_stage<0>(p, lds, vcu, tid, wave, lane);
            thin_stage<1>(p, lds, vcu, tid, wave, lane);
            stage_done(bar, ctlw, MISC, quad, 1);
        }
        if (IN(6)) {
            quad_wait(bar, ctlw, quad, 8u, false);
            pg8::Gemm g{(const bf16*)(ws + WS_B), (const bf16*)(ws + WS_WOUT), MP, DM, DM}; QuadOrder S; S.init(vcu, DM / 256);
            EpiX1 E{p.in[0], p.in[1], p.out, (bf16*)(ws + WS_X1B), (float*)(ws + WS_SS)};
            pg8::gemm_phase<EpiX1, QuadOrder, true, true>(lds, g, S, E);
            split_wait(bar, ctlw, 1);
            thin_stage<2>(p, lds, vcu, tid, wave, lane);
            stage_done(bar, ctlw, MISC, quad, 2);
        }
        if (IN(7)) {
            quad_wait(bar, ctlw, quad, 12u, false);
            pg8::Gemm g{(const bf16*)(ws + WS_X1B), (const bf16*)(ws + WS_WGU), MP, NGU, DM}; QuadOrder S; S.init(vcu, NGU / 256);
            EpiAct E{(const float*)(ws + WS_SS), (bf16*)(ws + WS_ACT), CopyCtx{p.in[2], p.in[3], p.in[4], p.in[5], p.out}};
            pg8::gemm_phase<EpiAct, QuadOrder, true, true>(lds, g, S, E);
            split_wait(bar, ctlw, 2);
            thin_stage<3>(p, lds, vcu, tid, wave, lane);
            stage_done(bar, ctlw, MISC, quad, 3);
        }
        if (IN(8)) {
            quad_wait(bar, ctlw, quad, 16u, false);
            pg8::Gemm g{(const bf16*)(ws + WS_ACT), (const bf16*)(ws + WS_WD), MP, DM, DFF}; QuadOrder S; S.init(vcu, DM / 256);
            EpiOut E{p.out, (const bf16*)(ws + WS_X1B)};
            pg8::gemm_phase<EpiOut, QuadOrder, true, true>(lds, g, S, E);
            split_wait(bar, ctlw, 3);
            thin_stage<4>(p, lds, vcu, tid, wave, lane);
        }
    }
#undef IN
#undef BOTH
}

extern "C" void kernel_launch(void* const* d_in, const int* in_sizes, int n_in, void* d_out, int out_size, void* d_ws, size_t ws_size, hipStream_t stream) {
    static int grid = 0;
    if (grid == 0) {
        if (n_in != 20 || (size_t)out_size != O_TOTAL || ws_size < WS_END) { fprintf(stderr, "kernel_launch: unexpected sizes n_in %d out %d ws %zu\n", n_in, out_size, ws_size); grid = -1; return; }
        int dev = 0, cus = 0, per_cu = 0;
        if (hipGetDevice(&dev) != hipSuccess || hipDeviceGetAttribute(&cus, hipDeviceAttributeMultiprocessorCount, dev) != hipSuccess) { grid = -1; return; }
        if (hipFuncSetAttribute((const void*)fwd_kernel, hipFuncAttributeMaxDynamicSharedMemorySize, LDS_BYTES) != hipSuccess) { fprintf(stderr, "kernel_launch: hipFuncSetAttribute failed\n"); grid = -1; return; }
        if (hipOccupancyMaxActiveBlocksPerMultiprocessor(&per_cu, (const void*)fwd_kernel, NWAVES * 64, LDS_BYTES) != hipSuccess || per_cu < 1)
            fprintf(stderr, "kernel_launch: occupancy query reports %d\n", per_cu);
        (void)hipGetLastError();
        if (cus < 256) { fprintf(stderr, "kernel_launch: needs 256 CUs (one resident workgroup each), device has %d\n", cus); grid = -1; return; }
        grid = 256;
    }
    if (grid < 0) return;
    if (hipMemsetAsync((char*)d_ws + WS_CTL, 0, CTL_ZERO_BYTES, stream) != hipSuccess) return;
    Params a{};
    for (int i = 0; i < 20; ++i) a.in[i] = (const float*)d_in[i];
    a.out = (float*)d_out; a.ws = (unsigned char*)d_ws; a.ph_lo = 0; a.ph_hi = 16;
    hipLaunchKernelGGL(fwd_kernel, dim3(grid), dim3(NWAVES * 64), LDS_BYTES, stream, a);
}
```

```cpp
#include <hip/hip_runtime.h>
#include <cstdio>
#include <cstdint>
namespace pg8 {
#define PG8_LAS __attribute__((address_space(3)))
typedef unsigned short bf16_t;
typedef short bf16x8 __attribute__((ext_vector_type(8)));
typedef float f32x4 __attribute__((ext_vector_type(4)));
typedef unsigned u32x4 __attribute__((ext_vector_type(4)));
constexpr int BM = 256, BK = 64, HALF = 128, HTB = HALF * BK * 2  , STAGE_BYTES = 8 * HTB, NXCD = 8, WGM = 8;

__host__ __device__ __forceinline__ int lds_byte(int r, int c) { const int st = (r >> 4) * 2 + (c >> 5), rr = r & 15, cc = c & 31, ob = rr * 64 + cc * 2; return st * 1024 + (ob ^ (((ob >> 9) & 1) << 5)); }
__host__ __device__ __forceinline__ void stage_rc(int b, int& R, int& C) { const int st = b / 1024, sb = b % 1024, swz = sb ^ (((sb >> 9) & 1) << 5); R = (st >> 1) * 16 + swz / 64; C = (st & 1) * 32 + (swz % 64) / 2; }
__host__ __device__ __forceinline__ int perm32(int rho) { const int n = rho >> 4, i = rho & 15; return 8 * (i >> 2) + 4 * n + (i & 3); }

struct Unit { int pm, pn; };
struct Gemm { const bf16_t* A; const bf16_t* Bt; int M, N, K; };

struct StaticOrder {
    int nM, nN, nwg, G, c;
    __host__ __device__ void init(int M, int N, int G_, int c_) { nM = M / BM; nN = N / BM; nwg = nM * nN; G = G_; c = c_; }
    __host__ __device__ bool next(int i, Unit& u) const {
        const long L = (long)i * G + c; if (L >= nwg) return false;
        int wgid = (int)L; { const int q = nwg / NXCD, r = nwg % NXCD, xcd = wgid % NXCD, off = wgid / NXCD; wgid = (xcd < r ? xcd * (q + 1) : r * (q + 1) + (xcd - r) * q) + off; }
        const int nig = WGM * nN, gid = wgid / nig, fm = gid * WGM, gsz = (nM - fm) < WGM ? (nM - fm) : WGM;
        u.pm = fm + ((wgid % nig) % gsz); u.pn = (wgid % nig) / gsz; return true;
    }
    __device__ __forceinline__ void a_ready(const Unit&) const {}
    __device__ __forceinline__ void done(const Unit&) const {}
};
typedef float f32x2_cv __attribute__((ext_vector_type(2))); typedef __bf16 bf16x2_cv __attribute__((ext_vector_type(2)));
__device__ __forceinline__ unsigned cvt_pk_bf16(float lo, float hi) { f32x2_cv v = {lo, hi}; bf16x2_cv b = __builtin_convertvector(v, bf16x2_cv); return __builtin_bit_cast(unsigned, b); }
typedef float f32x2 __attribute__((ext_vector_type(2)));
template <class Epi, class Sched, bool ALIGN_EPI = false, bool SP2 = false>
__device__ __forceinline__ void gemm_phase(PG8_LAS unsigned char* lds, const Gemm g, const Sched& S, const Epi& E) {
    const int tid = threadIdx.x, wid = __builtin_amdgcn_readfirstlane(tid >> 6), lane = tid & 63, wr = wid >> 2, wc = wid & 3, fr = lane & 15, fq = lane >> 4;
    const int K = g.K, nt = K / BK;
    unsigned voffA[2], voffB[2];
#pragma unroll
    for (int i = 0; i < 2; ++i) { int R, C; stage_rc(tid * 16 + i * 8192, R, C); const int Rb = Epi::PERM ? ((R & ~31) + perm32(R & 31)) : R;
        voffA[i] = (unsigned)(R * K + C) * 2u; voffB[i] = (unsigned)(Rb * K + C) * 2u; }
    const size_t kstep = (size_t)(BK * 2);
    const size_t hstep = (size_t)HALF * K * 2;
    const size_t tstep = 2 * hstep;
    const unsigned ldsw = (unsigned)wid * 1024u;
    const int aoff = lds_byte(wr * 64 + fr, fq * 8), boff = lds_byte(wc * 32 + fr, fq * 8);
#define PG8_SA(b, h) (((b) * 2 + (h)) * HTB)
#define PG8_SB(b, h) ((4 + (b) * 2 + (h)) * HTB)
#define PG8_STAGE(bufoff, gbase, voff) do { _Pragma("unroll") for (int _i = 0; _i < 2; ++_i) \
        __builtin_amdgcn_global_load_lds((const unsigned*)((const char*)(gbase) + (voff)[_i]), (PG8_LAS unsigned*)(lds + (bufoff) + ldsw + _i * 8192), 16, 0, 0); } while (0)
#define PG8_LDA(dst, b, h) do { _Pragma("unroll") for (int m = 0; m < 4; ++m) _Pragma("unroll") for (int k = 0; k < 2; ++k) dst[m][k] = *(const PG8_LAS bf16x8*)(lds + PG8_SA(b, h) + aoff + m * 2048 + k * 1024); } while (0)
#define PG8_LDB(dst, b, h) do { _Pragma("unroll") for (int n = 0; n < 2; ++n) _Pragma("unroll") for (int k = 0; k < 2; ++k) dst[n][k] = *(const PG8_LAS bf16x8*)(lds + PG8_SB(b, h) + boff + n * 2048 + k * 1024); } while (0)
#define PG8_MMA(ai, bj, At, Bt) do { __builtin_amdgcn_s_setprio(1); _Pragma("unroll") for (int m = 0; m < 4; ++m) _Pragma("unroll") for (int n = 0; n < 2; ++n) _Pragma("unroll") for (int k = 0; k < 2; ++k) \
        acc[ai][bj][m][n] = __builtin_amdgcn_mfma_f32_16x16x32_bf16(Bt[n][k], At[m][k], acc[ai][bj][m][n], 0, 0, 0); __builtin_amdgcn_s_setprio(0); } while (0)
#define PG8_WAIT_V(n) asm volatile("s_waitcnt vmcnt(" #n ")" ::: "memory")
#define PG8_WAIT_L(n) asm volatile("s_waitcnt lgkmcnt(" #n ")" ::: "memory")
#define PG8_BAR __builtin_amdgcn_s_barrier()
#define PG8_SCHED __builtin_amdgcn_sched_barrier(0)
    Unit cur, nxt; int ui = 0;
    if (!S.next(0, cur)) return;
    f32x4 acc[2][2][4][2];
#pragma unroll
    for (int a = 0; a < 2; ++a)
#pragma unroll
        for (int b = 0; b < 2; ++b)
#pragma unroll
            for (int m = 0; m < 4; ++m)
#pragma unroll
                for (int n = 0; n < 2; ++n) acc[a][b][m][n] = (f32x4){0.f, 0.f, 0.f, 0.f};
    bf16x8 At[4][2], B0[2][2], B1[2][2];
    const char* cA = (const char*)g.A + (size_t)cur.pm * tstep; const char* cB = (const char*)g.Bt + (size_t)cur.pn * tstep;
    S.a_ready(cur);
    if constexpr (SP2) {
        PG8_STAGE(PG8_SB(0, 0), cB, voffB); PG8_STAGE(PG8_SB(0, 1), cB + hstep, voffB); PG8_STAGE(PG8_SA(0, 0), cA, voffA); PG8_STAGE(PG8_SA(0, 1), cA + hstep, voffA);
        if (wr == 1) PG8_BAR;
        PG8_WAIT_V(2); PG8_BAR;
        PG8_STAGE(PG8_SB(1, 0), cB + kstep, voffB); PG8_STAGE(PG8_SA(1, 0), cA + kstep, voffA); PG8_STAGE(PG8_SB(1, 1), cB + hstep + kstep, voffB);
        PG8_WAIT_V(6); PG8_BAR;
    } else {
        PG8_STAGE(PG8_SB(0, 0), cB, voffB); PG8_STAGE(PG8_SA(0, 0), cA, voffA); PG8_STAGE(PG8_SB(0, 1), cB + hstep, voffB); PG8_STAGE(PG8_SA(0, 1), cA + hstep, voffA);
        if (wr == 1) PG8_BAR;
        PG8_WAIT_V(4); PG8_BAR;
        PG8_STAGE(PG8_SB(1, 0), cB + kstep, voffB); PG8_STAGE(PG8_SA(1, 0), cA + kstep, voffA); PG8_STAGE(PG8_SB(1, 1), cB + hstep + kstep, voffB);
        PG8_WAIT_V(6); PG8_BAR;
    }
    for (;;) {
        const bool has_next = S.next(ui + 1, nxt);
        const char* nA = has_next ? (const char*)g.A + (size_t)nxt.pm * tstep : cA; const char* nB = has_next ? (const char*)g.Bt + (size_t)nxt.pn * tstep : cB;
        if constexpr (Epi::HAS_MID) {
            int tmid = Epi::MID_T; asm volatile("" : "+s"(tmid));
#pragma unroll 1
            for (int t = 0; t < tmid; t += 2) {
            { const bool last = false;
            asm volatile("" : "+s"(cA), "+s"(cB));
            const char* a1 = cA + (size_t)(t + 1) * kstep;
            const char* a2 = last ? nA : cA + (size_t)(t + 2) * kstep; const char* b2 = last ? nB : cB + (size_t)(t + 2) * kstep;
            const char* a3 = a2 + kstep; const char* b3 = b2 + kstep;
            if (last && has_next) S.a_ready(nxt);
            PG8_LDB(B0, 0, 0); PG8_LDB(B1, 0, 1); PG8_SCHED; PG8_LDA(At, 0, 0); PG8_STAGE(PG8_SA(1, 1), a1 + hstep, voffA);
            PG8_WAIT_V(8); PG8_WAIT_L(0); PG8_BAR; PG8_MMA(0, 0, At, B0); PG8_MMA(0, 1, At, B1); PG8_BAR; PG8_SCHED;
            PG8_LDA(At, 0, 1); PG8_STAGE(PG8_SB(0, 0), b2, voffB); PG8_STAGE(PG8_SB(0, 1), b2 + hstep, voffB); PG8_STAGE(PG8_SA(0, 0), a2, voffA);
            PG8_WAIT_V(8); PG8_WAIT_L(0); PG8_BAR; PG8_MMA(1, 0, At, B0); PG8_MMA(1, 1, At, B1); PG8_BAR; PG8_SCHED;
            PG8_LDB(B0, 1, 0); PG8_LDB(B1, 1, 1); PG8_SCHED; PG8_LDA(At, 1, 0); PG8_STAGE(PG8_SA(0, 1), a2 + hstep, voffA);
            PG8_WAIT_V(8); PG8_WAIT_L(0); PG8_BAR; PG8_MMA(0, 0, At, B0); PG8_MMA(0, 1, At, B1); PG8_BAR; PG8_SCHED;
            PG8_LDA(At, 1, 1); PG8_STAGE(PG8_SB(1, 0), b3, voffB); PG8_STAGE(PG8_SB(1, 1), b3 + hstep, voffB); PG8_STAGE(PG8_SA(1, 0), a3, voffA);
            PG8_WAIT_V(8); PG8_WAIT_L(0); PG8_BAR; PG8_MMA(1, 0, At, B0); PG8_MMA(1, 1, At, B1); PG8_BAR; PG8_SCHED;
            }
            }
            E.mid(acc, cur, wr, wc, fr, fq);
#pragma unroll 1
            for (int t = tmid; t < nt; t += 2) {
            { const bool last = (t == nt - 2);
            asm volatile("" : "+s"(cA), "+s"(cB));
            const char* a1 = cA + (size_t)(t + 1) * kstep;
            const char* a2 = last ? nA : cA + (size_t)(t + 2) * kstep; const char* b2 = last ? nB : cB + (size_t)(t + 2) * kstep;
            const char* a3 = a2 + kstep; const char* b3 = b2 + kstep;
            if (last && has_next) S.a_ready(nxt);
            PG8_LDB(B0, 0, 0); PG8_LDB(B1, 0, 1); PG8_SCHED; PG8_LDA(At, 0, 0); PG8_STAGE(PG8_SA(1, 1), a1 + hstep, voffA);
            PG8_WAIT_V(8); PG8_WAIT_L(0); PG8_BAR; PG8_MMA(0, 0, At, B0); PG8_MMA(0, 1, At, B1); PG8_BAR; PG8_SCHED;
            PG8_LDA(At, 0, 1); PG8_STAGE(PG8_SB(0, 0), b2, voffB); PG8_STAGE(PG8_SB(0, 1), b2 + hstep, voffB); PG8_STAGE(PG8_SA(0, 0), a2, voffA);
            PG8_WAIT_V(8); PG8_WAIT_L(0); PG8_BAR; PG8_MMA(1, 0, At, B0); PG8_MMA(1, 1, At, B1); PG8_BAR; PG8_SCHED;
            PG8_LDB(B0, 1, 0); PG8_LDB(B1, 1, 1); PG8_SCHED; PG8_LDA(At, 1, 0); PG8_STAGE(PG8_SA(0, 1), a2 + hstep, voffA);
            PG8_WAIT_V(8); PG8_WAIT_L(0); PG8_BAR; PG8_MMA(0, 0, At, B0); PG8_MMA(0, 1, At, B1); PG8_BAR; PG8_SCHED;
            PG8_LDA(At, 1, 1); PG8_STAGE(PG8_SB(1, 0), b3, voffB); PG8_STAGE(PG8_SB(1, 1), b3 + hstep, voffB); PG8_STAGE(PG8_SA(1, 0), a3, voffA);
            PG8_WAIT_V(8); PG8_WAIT_L(0); PG8_BAR; PG8_MMA(1, 0, At, B0); PG8_MMA(1, 1, At, B1); PG8_BAR; PG8_SCHED;
            }
            }
        } else
        for (int t = 0; t < nt; t += 2) {
            const bool last = (t == nt - 2);
            const char* a1 = cA + (size_t)(t + 1) * kstep;
            const char* a2 = last ? nA : cA + (size_t)(t + 2) * kstep; const char* b2 = last ? nB : cB + (size_t)(t + 2) * kstep;
            const char* a3 = a2 + kstep; const char* b3 = b2 + kstep;
            if (last && has_next) S.a_ready(nxt);
            if constexpr (SP2) {
            PG8_LDB(B0, 0, 0); PG8_LDB(B1, 0, 1); PG8_SCHED; PG8_LDA(At, 0, 0); PG8_STAGE(PG8_SA(1, 1), a1 + hstep, voffA);
            PG8_WAIT_V(8); PG8_WAIT_L(0); PG8_BAR; PG8_MMA(0, 0, At, B0); PG8_MMA(0, 1, At, B1); PG8_BAR; PG8_SCHED;
            PG8_LDA(At, 0, 1); PG8_STAGE(PG8_SB(0, 0), b2, voffB); PG8_STAGE(PG8_SB(0, 1), b2 + hstep, voffB); PG8_STAGE(PG8_SA(0, 0), a2, voffA);
            PG8_WAIT_V(8); PG8_WAIT_L(0); PG8_BAR; PG8_MMA(1, 0, At, B0); PG8_MMA(1, 1, At, B1); PG8_BAR; PG8_SCHED;
            PG8_LDB(B0, 1, 0); PG8_LDB(B1, 1, 1); PG8_SCHED; PG8_LDA(At, 1, 0); PG8_STAGE(PG8_SA(0, 1), a2 + hstep, voffA);
            PG8_WAIT_V(8); PG8_WAIT_L(0); PG8_BAR; PG8_MMA(0, 0, At, B0); PG8_MMA(0, 1, At, B1); PG8_BAR; PG8_SCHED;
            PG8_LDA(At, 1, 1); PG8_STAGE(PG8_SB(1, 0), b3, voffB); PG8_STAGE(PG8_SB(1, 1), b3 + hstep, voffB); PG8_STAGE(PG8_SA(1, 0), a3, voffA);
            PG8_WAIT_V(8); PG8_WAIT_L(0); PG8_BAR; PG8_MMA(1, 0, At, B0); PG8_MMA(1, 1, At, B1); PG8_BAR; PG8_SCHED;
            } else {
            PG8_LDB(B0, 0, 0); PG8_SCHED; PG8_LDA(At, 0, 0); PG8_STAGE(PG8_SA(1, 1), a1 + hstep, voffA);
            PG8_WAIT_L(8); PG8_BAR; PG8_WAIT_L(0); PG8_MMA(0, 0, At, B0); PG8_BAR; PG8_SCHED;
            PG8_LDB(B1, 0, 1); PG8_STAGE(PG8_SB(0, 0), b2, voffB);
            PG8_BAR; PG8_WAIT_L(0); PG8_MMA(0, 1, At, B1); PG8_BAR;
            PG8_LDA(At, 0, 1); PG8_STAGE(PG8_SA(0, 0), a2, voffA);
            PG8_BAR; PG8_WAIT_L(0); PG8_MMA(1, 0, At, B0); PG8_BAR; PG8_SCHED;
            PG8_STAGE(PG8_SB(0, 1), b2 + hstep, voffB);
            PG8_WAIT_V(6); PG8_BAR; PG8_MMA(1, 1, At, B1); PG8_BAR;
            PG8_LDB(B0, 1, 0); PG8_SCHED; PG8_LDA(At, 1, 0); PG8_STAGE(PG8_SA(0, 1), a2 + hstep, voffA);
            PG8_WAIT_L(8); PG8_BAR; PG8_WAIT_L(0); PG8_MMA(0, 0, At, B0); PG8_BAR; PG8_SCHED;
            PG8_LDB(B1, 1, 1); PG8_STAGE(PG8_SB(1, 0), b3, voffB);
            PG8_BAR; PG8_WAIT_L(0); PG8_MMA(0, 1, At, B1); PG8_BAR;
            PG8_LDA(At, 1, 1); PG8_STAGE(PG8_SA(1, 0), a3, voffA);
            PG8_BAR; PG8_WAIT_L(0); PG8_MMA(1, 0, At, B0); PG8_BAR; PG8_SCHED;
            PG8_STAGE(PG8_SB(1, 1), b3 + hstep, voffB);
            PG8_WAIT_V(6); PG8_BAR; PG8_MMA(1, 1, At, B1); PG8_BAR;
            }
        }
        if constexpr (ALIGN_EPI) { if (wr == 0) PG8_BAR; }
        if constexpr (!Epi::AFTER_DRAIN) { E(acc, cur, wr, wc, fr, fq); S.done(cur); }
        if (!has_next) break;
#pragma unroll
        for (int a = 0; a < 2; ++a)
#pragma unroll
            for (int b = 0; b < 2; ++b)
#pragma unroll
                for (int m = 0; m < 4; ++m)
#pragma unroll
                    for (int n = 0; n < 2; ++n) acc[a][b][m][n] = (f32x4){0.f, 0.f, 0.f, 0.f};
        cur = nxt; cA = nA; cB = nB; ++ui;
        if constexpr (ALIGN_EPI) { if (wr == 1) PG8_BAR; }
    }
    PG8_WAIT_V(0);
    if constexpr (!ALIGN_EPI) { if (wr == 0) PG8_BAR; }
    PG8_BAR;
    if constexpr (Epi::AFTER_DRAIN) { E.fused(acc, cur, wr, wc, fr, fq, lds, wid, lane); S.done(cur); }
#undef PG8_SA
#undef PG8_SB
#undef PG8_STAGE
#undef PG8_LDA
#undef PG8_LDB
#undef PG8_MMA
#undef PG8_WAIT_V
#undef PG8_WAIT_L
#undef PG8_BAR
#undef PG8_SCHED
}
}
#define GAS __attribute__((address_space(1)))
#define LAS __attribute__((address_space(3)))
typedef unsigned short bf16;
typedef unsigned v4u __attribute__((ext_vector_type(4)));
typedef float f32x4 __attribute__((ext_vector_type(4)));
typedef short bf16x8 __attribute__((ext_vector_type(8)));
typedef GAS unsigned gu32;
typedef GAS unsigned long long gu64;
#define RLX_AGENT __ATOMIC_RELAXED, __HIP_MEMORY_SCOPE_AGENT
#define LDS_WAIT() asm volatile("s_waitcnt lgkmcnt(0)" ::: "memory")
#define VM_WAIT() asm volatile("s_waitcnt vmcnt(0)" ::: "memory")
__device__ __forceinline__ unsigned long long rt() { return __builtin_amdgcn_s_memrealtime(); }
__device__ __forceinline__ unsigned f2bf(float f) { unsigned u = __builtin_bit_cast(unsigned, f); return (u + 0x7fffu + ((u >> 16) & 1u)) >> 16; }
__device__ __forceinline__ unsigned pk2(float lo, float hi) { return f2bf(lo) | (f2bf(hi) << 16); }

#define XB_TMO      128
#define XB_XCNT(j)  (256  + 64 * (j))
#define XB_XSUB(j)  (1280 + 64 * (j))
#define XB_XGEN(j)  (2304 + 64 * (j))
#define XB_TOP      3328
#define XB_TOPGEN   3392
#define XCD_BAR_WORDS 3456
#define XB_SPIN_CAP (1u << 18)

__device__ __forceinline__ unsigned xb_ld(unsigned* p)              { return __hip_atomic_load(p, __ATOMIC_RELAXED, __HIP_MEMORY_SCOPE_AGENT); }
__device__ __forceinline__ unsigned xb_add(unsigned* p, unsigned v) { return __hip_atomic_fetch_add(p, v, __ATOMIC_RELAXED, __HIP_MEMORY_SCOPE_AGENT); }
__device__ __forceinline__ unsigned xb_xcc_id() { return (unsigned)__builtin_amdgcn_s_getreg((3 << 11) | 20) & 0xFu; }
#define XB_SPIN(cond, bar) do { unsigned _sp = 0; while (cond) { __builtin_amdgcn_s_sleep(1); \
    if ((++_sp & 255u) == 0u) { if (xb_ld(&(bar)[XB_TMO])) break; if (_sp > XB_SPIN_CAP) { atomicAdd(&(bar)[XB_TMO], 1u); break; } } } } while (0)

struct XcdBarrier {
    unsigned* bar; unsigned x;
    volatile LAS unsigned* st;
};

__device__ __forceinline__ XcdBarrier xcd_barrier_post(unsigned* bar, volatile LAS unsigned* st) {
    XcdBarrier b; b.bar = bar; b.x = xb_xcc_id(); b.st = st;
    if (threadIdx.x == 0) (void)xb_add(&bar[XB_XCNT(b.x)], 1u);
    return b;
}
__device__ __forceinline__ void xcd_barrier_complete(unsigned* bar, unsigned x, unsigned& nloc, unsigned& nx) {
    const unsigned G = gridDim.x * gridDim.y * gridDim.z;
    unsigned sum, cnt, mine, sp = 0u;
    for (;;) {
        sum = 0u; cnt = 0u; mine = 0u;
#pragma unroll
        for (unsigned j = 0; j < 16; ++j) { const unsigned c = xb_ld(&bar[XB_XCNT(j)]); sum += c; cnt += (c > 0u) ? 1u : 0u; mine = (j == x) ? c : mine; }
        if (sum == G) break;
        __builtin_amdgcn_s_sleep(1);
        if ((++sp & 255u) == 0u) { if (xb_ld(&bar[XB_TMO])) break; if (sp > XB_SPIN_CAP) { atomicAdd(&bar[XB_TMO], 1u); break; } }
    }
    nloc = mine > 0u ? mine : 1u; nx = cnt > 0u ? cnt : 1u;
}

__device__ __forceinline__ void xcd_barrier(const XcdBarrier& b) {
    asm volatile("s_waitcnt vmcnt(0)" ::: "memory");
    __syncthreads();
    if (threadIdx.x == 0) {
        unsigned* bar = b.bar;
        __builtin_amdgcn_s_waitcnt(0);
        unsigned nloc = b.st[0], nx = b.st[1];
        if (nloc == 0u) { xcd_barrier_complete(bar, b.x, nloc, nx); b.st[0] = nloc; b.st[1] = nx; }
        const unsigned old = xb_add(&bar[XB_XSUB(b.x)], 1u);
        const unsigned gen = old / nloc;
        if (old + 1u == (gen + 1u) * nloc) {
            __builtin_amdgcn_fence(__ATOMIC_RELEASE, "agent");
            asm volatile("s_waitcnt vmcnt(0)" ::: "memory");
            const unsigned og = xb_add(&bar[XB_TOP], 1u);
            const unsigned tg = og / nx;
            if (og + 1u == (tg + 1u) * nx) xb_add(&bar[XB_TOPGEN], 1u);
            else XB_SPIN(xb_ld(&bar[XB_TOPGEN]) == tg, bar);
            __builtin_amdgcn_fence(__ATOMIC_ACQUIRE, "agent");
            xb_add(&bar[XB_XGEN(b.x)], 1u);
            asm volatile("s_waitcnt vmcnt(0)" ::: "memory");
        } else {
            XB_SPIN(xb_ld(&bar[XB_XGEN(b.x)]) == gen, bar);
            __builtin_amdgcn_fence(__ATOMIC_ACQUIRE, "agent");
            asm volatile("s_waitcnt vmcnt(0)" ::: "memory");
        }
    }
    __syncthreads();
}

#ifndef PH_MASK
#define PH_MASK 0x1ff
#endif
constexpr int DM = 1024, NB = 8, SEQ = 4096, MP = NB * SEQ;
constexpr int SB = 32, SS_ = 4, MS = SB * SS_, MV = MP + MS;
constexpr int MR = 129 * 256;
constexpr int NIN = 6400, DFF = 2816, NGU = 2 * DFF, DAO = 256;
constexpr float RMS_EPS = 1e-6f, LN_EPS = 1e-5f;
constexpr int NWAVES = 8;

constexpr size_t O_Y = 0;
constexpr size_t O_KVP0 = 33685504, O_KVS0 = 34209792, O_KVP1 = 36306944, O_KVS1 = 38404096, O_KVP2 = 46792704, O_KVS2 = 55181312;
constexpr size_t O_CONVP = 88735744, O_CONVS = 88981504, O_TOTAL = 89964544;

constexpr size_t MiB = 1u << 20;
constexpr size_t WS_CTL = 0, CTL_ZERO_BYTES = 32768;
constexpr size_t WS_W1 = 1 * MiB;
constexpr size_t WS_WCAT = 14 * MiB;
constexpr size_t WS_WOUT = 17 * MiB;
constexpr size_t WS_WGU = 19 * MiB;
constexpr size_t WS_WD = 30 * MiB;
constexpr int KC = 1280;
constexpr size_t WS_A = 36 * MiB;
constexpr size_t WS_B = 117 * MiB;
constexpr size_t WS_GA = 182 * MiB, WS_GB = WS_GA + 1024;
constexpr int GP = 2048;
constexpr size_t WS_X1B = WS_GA;
constexpr size_t WS_Q = 248 * MiB, WS_K = 296 * MiB, WS_V = 344 * MiB;
constexpr size_t WS_OG = 392 * MiB;
constexpr size_t WS_LSE = 441 * MiB;
constexpr size_t WS_SS = 443 * MiB;
constexpr size_t WS_SQ = 446 * MiB;
constexpr size_t WS_SSS = 447 * MiB;
constexpr size_t WS_ACT = 248 * MiB;
constexpr size_t WS_END = 448 * MiB;
constexpr int CW_BAR = 4096;

constexpr int RING_BYTES = 131072, LDSCTL_OFF = RING_BYTES, MISC_OFF = LDSCTL_OFF + 320, LDS_BYTES = 147456;

typedef unsigned u32x4 __attribute__((ext_vector_type(4)));
typedef unsigned u32x2 __attribute__((ext_vector_type(2)));

struct Params {
    const float* in[20];
    float* out;
    unsigned char* ws;
    int ph_lo, ph_hi;
};

__device__ __forceinline__ float sigmoidf_(float x) { return __builtin_amdgcn_rcpf(1.0f + __expf(-x)); }
__device__ __forceinline__ float wave_sum(float v) {
#pragma unroll
    for (int o = 1; o < 64; o <<= 1) v += __shfl_xor(v, o);
    return v;
}


__device__ __forceinline__ u32x2 qgate8(const f32x4 a, const f32x4 b) {
    unsigned w0 = 0u, w1 = 0u;
    w0 = __builtin_amdgcn_cvt_pk_u8_f32(__builtin_rintf(a[0] * 255.f), 0, w0); w0 = __builtin_amdgcn_cvt_pk_u8_f32(__builtin_rintf(a[1] * 255.f), 1, w0);
    w0 = __builtin_amdgcn_cvt_pk_u8_f32(__builtin_rintf(a[2] * 255.f), 2, w0); w0 = __builtin_amdgcn_cvt_pk_u8_f32(__builtin_rintf(a[3] * 255.f), 3, w0);
    w1 = __builtin_amdgcn_cvt_pk_u8_f32(__builtin_rintf(b[0] * 255.f), 0, w1); w1 = __builtin_amdgcn_cvt_pk_u8_f32(__builtin_rintf(b[1] * 255.f), 1, w1);
    w1 = __builtin_amdgcn_cvt_pk_u8_f32(__builtin_rintf(b[2] * 255.f), 2, w1); w1 = __builtin_amdgcn_cvt_pk_u8_f32(__builtin_rintf(b[3] * 255.f), 3, w1);
    return (u32x2){w0, w1};
}
__device__ __forceinline__ void dqgate8(const u32x2 w, f32x4& a, f32x4& b) {
    constexpr float S = 1.0f / 255.0f;
    a = (f32x4){(float)(w.x & 0xffu) * S, (float)((w.x >> 8) & 0xffu) * S, (float)((w.x >> 16) & 0xffu) * S, (float)(w.x >> 24) * S};
    b = (f32x4){(float)(w.y & 0xffu) * S, (float)((w.y >> 8) & 0xffu) * S, (float)((w.y >> 16) & 0xffu) * S, (float)(w.y >> 24) * S};
}

constexpr int CP_CHUNKS = 5456;
struct CopyCtx { const float* s0; const float* s1; const float* s2; const float* s3; float* out; };
__device__ __forceinline__ void cp_addr(const CopyCtx& c, int chunk, int tid, int j, const GAS f32x4*& src, GAS f32x4*& dst) {
    int base, rows, per, rw; const float* sp; size_t oo;
    if (chunk < 248) { base = 0; rows = 124; per = 128; rw = 128; sp = c.s0; oo = O_KVS0; }
    else if (chunk < 1264) { base = 248; rows = 508; per = 512; rw = 128; sp = c.s1; oo = O_KVS1; }
    else if (chunk < 5352) { base = 1264; rows = 2044; per = 2048; rw = 128; sp = c.s2; oo = O_KVS2; }
    else { base = 5352; rows = 26; per = 30; rw = 256; sp = c.s3; oo = O_CONVS; }
    const int i0 = (chunk - base) * 2048, n4b = rows * rw, b0 = i0 / n4b, r0 = i0 - b0 * n4b;
    int r = r0 + j * 512 + tid, b = b0;
    if (r >= n4b) { r -= n4b; b += 1; }
    const unsigned idx = (unsigned)(b * per * rw + r);
    src = (const GAS f32x4*)sp + idx + 4 * rw;
    dst = (GAS f32x4*)(c.out + oo) + idx;
}
__device__ __forceinline__ void cp_load(const CopyCtx& c, int chunk, int tid, f32x4 (&v)[4]) {
    if (chunk < CP_CHUNKS) {
#pragma unroll
        for (int j = 0; j < 4; ++j) { const GAS f32x4* src; GAS f32x4* dst; cp_addr(c, chunk, tid, j, src, dst); v[j] = __builtin_nontemporal_load(src); }
    }
    __builtin_amdgcn_sched_barrier(0);
}
__device__ __forceinline__ void cp_store(const CopyCtx& c, int chunk, int tid, const f32x4 (&v)[4]) {
    __builtin_amdgcn_sched_barrier(0);
    if (chunk < CP_CHUNKS) {
#pragma unroll
        for (int j = 0; j < 4; ++j) { const GAS f32x4* src; GAS f32x4* dst; cp_addr(c, chunk, tid, j, src, dst); __builtin_nontemporal_store(v[j], dst); }
    }
}

struct EpiP1 {
    static constexpr bool PERM = true, AFTER_DRAIN = false, HAS_MID = false;
    bf16 *Q, *K, *V, *U, *GA, *GB; float* SQ; float* out; const float *qw, *kw; CopyCtx cc;
    __device__ __forceinline__ void operator()(const pg8::f32x4 (&acc)[2][2][4][2], const pg8::Unit& u, int wr, int wc, int fr, int fq) const {
        const int pn = u.pn, row0 = u.pm * 256 + wr * 64 + fr;
        const int cp_chunk = u.pm * 25 + pn, cp_tid = (wr * 4 + wc) * 64 + fq * 16 + fr; f32x4 cpv[4]; cp_load(cc, cp_chunk, cp_tid, cpv);
        if (pn < 9) {
            const int seg = pn / 3, g = pn - 3 * seg, sh = 2 * g, win = 128 << sh, head = wc;
            f32x4 w[2][2];
            const float* nw = (seg == 0) ? qw : kw;
#pragma unroll
            for (int bj = 0; bj < 2; ++bj)
#pragma unroll
                for (int n = 0; n < 2; ++n) w[bj][n] = (seg < 2) ? *(const f32x4*)(nw + 32 * bj + 8 * fq + 4 * n) : (f32x4){1.f, 1.f, 1.f, 1.f};
            const float post = (seg == 0) ? 0.125f * 1.4426950408889634f : 1.0f;
            bf16* dstb = Q + (size_t)seg * ((WS_K - WS_Q) / 2);
            const size_t okp = (g == 0) ? O_KVP0 : (g == 1) ? O_KVP1 : O_KVP2;
            const size_t oks = (g == 0) ? O_KVS0 : (g == 1) ? O_KVS1 : O_KVS2;
#pragma unroll
            for (int ai = 0; ai < 2; ++ai)
#pragma unroll
                for (int m = 0; m < 4; ++m) {
                    const int row = row0 + ai * 128 + m * 16;
                    if (ai == 1 && m == 0) cp_store(cc, cp_chunk, cp_tid, cpv);
                    f32x4 v[2][2];
#pragma unroll
                    for (int bj = 0; bj < 2; ++bj)
#pragma unroll
                        for (int n = 0; n < 2; ++n) v[bj][n] = acc[ai][bj][m][n];
                    if (seg < 2) {
                        float ss = 0.f;
#pragma unroll
                        for (int bj = 0; bj < 2; ++bj)
#pragma unroll
                            for (int n = 0; n < 2; ++n) { const f32x4 x = v[bj][n]; ss += (x[0] * x[0] + x[1] * x[1]) + (x[2] * x[2] + x[3] * x[3]); }
                        ss += __shfl_xor(ss, 16); ss += __shfl_xor(ss, 32);
                        const float rs = __builtin_amdgcn_rsqf(ss * (1.0f / 64.0f) + RMS_EPS) * post;
#pragma unroll
                        for (int bj = 0; bj < 2; ++bj)
#pragma unroll
                            for (int n = 0; n < 2; ++n) v[bj][n] = v[bj][n] * rs * w[bj][n];
                    }
                    if (row < MP) {
                        const int b = row >> 12, t = row & 4095;
                        const int pos = ((t & ((1 << sh) - 1)) << (12 - sh)) + (t >> sh);
                        bf16* d = dstb + ((size_t)((b * 3 + g) * 4 + head) * 4096 + pos) * 64 + 8 * fq;
#pragma unroll
                        for (int bj = 0; bj < 2; ++bj) {
                            u32x4 pk; pk.x = pg8::cvt_pk_bf16(v[bj][0][0], v[bj][0][1]); pk.y = pg8::cvt_pk_bf16(v[bj][0][2], v[bj][0][3]);
                            pk.z = pg8::cvt_pk_bf16(v[bj][1][0], v[bj][1][1]); pk.w = pg8::cvt_pk_bf16(v[bj][1][2], v[bj][1][3]);
                            *(u32x4*)(d + 32 * bj) = pk;
                        }
                        if (seg >= 1 && t >= 4096 - win) {
                            float* o = out + okp + ((size_t)(b * win + (t - (4096 - win))) * 2 + (seg - 1)) * 256 + head * 64 + 8 * fq;
#pragma unroll
                            for (int bj = 0; bj < 2; ++bj)
#pragma unroll
                                for (int n = 0; n < 2; ++n) __builtin_nontemporal_store(v[bj][n], (f32x4*)(o + 32 * bj + 4 * n));
                        }
                    } else if (row < MV) {
                        const int si = row - MP, sb = si >> 2, s = si & 3;
                        float* o = (seg == 0) ? SQ + ((size_t)si * 12 + g * 4 + head) * 64 + 8 * fq
                                              : out + oks + ((size_t)(sb * win + win - 4 + s) * 2 + (seg - 1)) * 256 + head * 64 + 8 * fq;
#pragma unroll
                        for (int bj = 0; bj < 2; ++bj)
#pragma unroll
                            for (int n = 0; n < 2; ++n) *(f32x4*)(o + 32 * bj + 4 * n) = v[bj][n];
                    }
                }
        } else if (pn < 17) {
            const int ch0 = 128 * (pn - 9) + 32 * wc + 8 * fq;
#pragma unroll
            for (int ai = 0; ai < 2; ++ai)
#pragma unroll
                for (int m = 0; m < 4; ++m) {
                    const int row = row0 + ai * 128 + m * 16;
                    if (ai == 1 && m == 0) cp_store(cc, cp_chunk, cp_tid, cpv);
                    f32x4 uu[2];
#pragma unroll
                    for (int n = 0; n < 2; ++n) {
                        const f32x4 a = acc[ai][0][m][n], b = acc[ai][1][m][n];
#pragma unroll
                        for (int i = 0; i < 4; ++i) uu[n][i] = a[i] * sigmoidf_(b[i]);
                    }
                    u32x4 pk; pk.x = pg8::cvt_pk_bf16(uu[0][0], uu[0][1]); pk.y = pg8::cvt_pk_bf16(uu[0][2], uu[0][3]);
                    pk.z = pg8::cvt_pk_bf16(uu[1][0], uu[1][1]); pk.w = pg8::cvt_pk_bf16(uu[1][2], uu[1][3]);
                    *(u32x4*)(U + (size_t)row * DM + ch0) = pk;
                    float* o = nullptr;
                    if (row < MP) { const int b = row >> 12, t = row & 4095; if (t >= 4066) o = out + O_CONVP + ((size_t)(b * 30 + t - 4066)) * DM + ch0; }
                    else if (row < MV) { const int si = row - MP; o = out + O_CONVS + ((size_t)((si >> 2) * 30 + 26 + (si & 3))) * DM + ch0; }
                    if (o) { *(f32x4*)o = uu[0]; *(f32x4*)(o + 4) = uu[1]; }
                }
        } else {
            const int q = pn - 17; unsigned char* G = (unsigned char*)((q >> 2) ? GB : GA);
            const int col0 = 256 * (q & 3) + 32 * wc + 8 * fq;
#pragma unroll
            for (int ai = 0; ai < 2; ++ai)
#pragma unroll
                for (int m = 0; m < 4; ++m) {
                    const int row = row0 + ai * 128 + m * 16;
                    if (ai == 1 && m == 0) cp_store(cc, cp_chunk, cp_tid, cpv);
#pragma unroll
                    for (int bj = 0; bj < 2; ++bj) {
                        f32x4 a = acc[ai][bj][m][0], b = acc[ai][bj][m][1];
#pragma unroll
                        for (int i = 0; i < 4; ++i) { a[i] = sigmoidf_(a[i]); b[i] = sigmoidf_(b[i]); }
                        __builtin_nontemporal_store(qgate8(a, b), (u32x2*)(G + (size_t)row * GP + col0 + 128 * bj));
                    }
                }
        }
    }
};

__device__ __forceinline__ float bf_lo(unsigned w) { return __builtin_bit_cast(float, w << 16); }
__device__ __forceinline__ float bf_hi(unsigned w) { return __builtin_bit_cast(float, w & 0xffff0000u); }
__device__ __forceinline__ void unpack8(const u32x4 w, f32x4& a, f32x4& b) {
    a = (f32x4){bf_lo(w.x), bf_hi(w.x), bf_lo(w.y), bf_hi(w.y)}; b = (f32x4){bf_lo(w.z), bf_hi(w.z), bf_lo(w.w), bf_hi(w.w)};
}
__device__ __forceinline__ u32x4 pack8(const f32x4 a, const f32x4 b) {
    u32x4 pk; pk.x = pg8::cvt_pk_bf16(a[0], a[1]); pk.y = pg8::cvt_pk_bf16(a[2], a[3]); pk.z = pg8::cvt_pk_bf16(b[0], b[1]); pk.w = pg8::cvt_pk_bf16(b[2], b[3]); return pk;
}

__device__ __forceinline__ u32x2 ld8nt(const void* pz) { return __builtin_nontemporal_load((const u32x2*)pz); }
struct EpiGateF {
    static constexpr bool PERM = true, AFTER_DRAIN = false, HAS_MID = true; static constexpr int MID_T = DAO / 64;
    const unsigned char* GA; const unsigned char* GB; bf16* H;
    __device__ __forceinline__ void mid(pg8::f32x4 (&acc)[2][2][4][2], const pg8::Unit& u, int wr, int wc, int fr, int fq) const {
        const int row0 = u.pm * 256 + wr * 64 + fr, col0 = u.pn * 256 + 32 * wc + 8 * fq;
#pragma unroll
        for (int ai = 0; ai < 2; ++ai)
#pragma unroll
            for (int m = 0; m < 4; ++m) {
                const unsigned off = (unsigned)(row0 + ai * 128 + m * 16) * GP + col0;
#pragma unroll
                for (int bj = 0; bj < 2; ++bj) {
                    f32x4 a0, a1, b0, b1; dqgate8(ld8nt(GA + off + 128 * bj), a0, a1); dqgate8(*(const u32x2*)(GB + off + 128 * bj), b0, b1);
#pragma unroll
                    for (int i = 0; i < 4; ++i) {
                        acc[ai][bj][m][0][i] *= a0[i] * __builtin_amdgcn_rcpf(fmaxf(b0[i], 8.6736174e-19f));
                        acc[ai][bj][m][1][i] *= a1[i] * __builtin_amdgcn_rcpf(fmaxf(b1[i], 8.6736174e-19f));
                    }
                }
                if (m & 1) asm volatile("" ::: "memory");
            }
    }
    __device__ __forceinline__ void operator()(const pg8::f32x4 (&acc)[2][2][4][2], const pg8::Unit& u, int wr, int wc, int fr, int fq) const {
        int row0 = u.pm * 256 + wr * 64 + fr, col0 = u.pn * 256 + 32 * wc + 8 * fq;
        asm volatile("" : "+v"(row0), "+v"(col0));
#pragma unroll
        for (int ai = 0; ai < 2; ++ai)
#pragma unroll
            for (int m = 0; m < 4; ++m) {
                const unsigned off = (unsigned)(row0 + ai * 128 + m * 16) * DM + col0, goff = (unsigned)(row0 + ai * 128 + m * 16) * GP + col0;
#pragma unroll
                for (int bj = 0; bj < 2; ++bj) {
                    f32x4 b0, b1; dqgate8(ld8nt(GB + goff + 128 * bj), b0, b1);
#pragma unroll
                    for (int i = 0; i < 4; ++i) { b0[i] = fmaxf(b0[i], 8.6736174e-19f); b1[i] = fmaxf(b1[i], 8.6736174e-19f); }
                    *(u32x4*)(H + off + 128 * bj) = pack8(acc[ai][bj][m][0] * b0, acc[ai][bj][m][1] * b1);
                }
                if (m & 1) asm volatile("" ::: "memory");
            }
    }
};
struct EpiX1 {
    static constexpr bool PERM = true, AFTER_DRAIN = false, HAS_MID = false;
    const float *xp, *xs; float* out; bf16* X1B; float* SS;
    __device__ __forceinline__ void operator()(const pg8::f32x4 (&acc)[2][2][4][2], const pg8::Unit& u, int wr, int wc, int fr, int fq) const {
        const int row0 = u.pm * 256 + wr * 64 + fr, col0 = u.pn * 256 + 32 * wc + 8 * fq;
#pragma unroll
        for (int ai = 0; ai < 2; ++ai) {
            f32x4 xv[4][2][2];
#pragma unroll
            for (int m = 0; m < 4; ++m) {
                const float* xr = xp + (size_t)(row0 + ai * 128 + m * 16) * DM + col0;
#pragma unroll
                for (int bj = 0; bj < 2; ++bj)
#pragma unroll
                    for (int n = 0; n < 2; ++n) xv[m][bj][n] = __builtin_nontemporal_load((const f32x4*)(xr + 128 * bj + 4 * n));
            }
#pragma unroll
            for (int m = 0; m < 4; ++m) {
                const int row = row0 + ai * 128 + m * 16;
                float ss = 0.f;
#pragma unroll
                for (int bj = 0; bj < 2; ++bj) {
                    f32x4 v[2];
#pragma unroll
                    for (int n = 0; n < 2; ++n) {
                        v[n] = xv[m][bj][n] + acc[ai][bj][m][n];
                        ss += (v[n][0] * v[n][0] + v[n][1] * v[n][1]) + (v[n][2] * v[n][2] + v[n][3] * v[n][3]);
                    }
                    *(u32x4*)(X1B + (size_t)row * DM + col0 + 128 * bj) = pack8(v[0], v[1]);
                }
                ss += __shfl_xor(ss, 16); ss += __shfl_xor(ss, 32);
                if (fq == 0) SS[(size_t)row * 16 + u.pn * 4 + wc] = ss;
            }
            asm volatile("" ::: "memory");
        }
    }
};
struct EpiAct {
    static constexpr bool PERM = true, AFTER_DRAIN = false, HAS_MID = false;
    const float* SS; bf16* ACT; CopyCtx cc;
    __device__ __forceinline__ void operator()(const pg8::f32x4 (&acc)[2][2][4][2], const pg8::Unit& u, int wr, int wc, int fr, int fq) const {
        const int row0 = u.pm * 256 + wr * 64 + fr, ch0 = u.pn * 128 + 32 * wc + 8 * fq;
        const int cp_q = u.pm * 22 + u.pn, cp_c0 = (cp_q * (CP_CHUNKS - 3225)) / 2816, cp_c1 = ((cp_q + 1) * (CP_CHUNKS - 3225)) / 2816;
        const int cp_chunk = (cp_c1 != cp_c0) ? 3225 + cp_c0 : CP_CHUNKS, cp_tid = (wr * 4 + wc) * 64 + fq * 16 + fr; f32x4 cpv[4]; cp_load(cc, cp_chunk, cp_tid, cpv);
#pragma unroll
        for (int ai = 0; ai < 2; ++ai)
#pragma unroll
            for (int m = 0; m < 4; ++m) {
                const int row = row0 + ai * 128 + m * 16;
                    if (ai == 1 && m == 0) cp_store(cc, cp_chunk, cp_tid, cpv);
                const f32x4 sv = *((const f32x4*)(SS + (size_t)row * 16) + fq);
                float tot = (sv[0] + sv[1]) + (sv[2] + sv[3]);
                tot += __shfl_xor(tot, 16); tot += __shfl_xor(tot, 32);
                const float rstd = __builtin_amdgcn_rsqf(tot * (1.0f / DM) + RMS_EPS);
                f32x4 a[2];
#pragma unroll
                for (int n = 0; n < 2; ++n)
#pragma unroll
                    for (int i = 0; i < 4; ++i) { const float g = acc[ai][0][m][n][i] * rstd, up = acc[ai][1][m][n][i] * rstd; a[n][i] = g * sigmoidf_(g) * up; }
                *(u32x4*)(ACT + (size_t)row * DFF + ch0) = pack8(a[0], a[1]);
            }
    }
};
struct EpiOut {
    static constexpr bool PERM = true, AFTER_DRAIN = false, HAS_MID = false;
    float* out; const bf16* X1B;
    __device__ __forceinline__ void operator()(const pg8::f32x4 (&acc)[2][2][4][2], const pg8::Unit& u, int wr, int wc, int fr, int fq) const {
        const int row0 = u.pm * 256 + wr * 64 + fr, col0 = u.pn * 256 + 32 * wc + 8 * fq;
#pragma unroll
        for (int ai = 0; ai < 2; ++ai)
#pragma unroll
            for (int m = 0; m < 4; ++m) {
                const int row = row0 + ai * 128 + m * 16;
                float* o = out + (size_t)row * DM + col0;
#pragma unroll
                for (int bj = 0; bj < 2; ++bj) {
                    f32x4 xa, xb; unpack8(__builtin_nontemporal_load((const u32x4*)(X1B + (size_t)row * DM + col0 + 128 * bj)), xa, xb);
                    __builtin_nontemporal_store(xa + acc[ai][bj][m][0], (f32x4*)(o + 128 * bj)); __builtin_nontemporal_store(xb + acc[ai][bj][m][1], (f32x4*)(o + 128 * bj + 4));
                }
            }
    }
};

__device__ __forceinline__ void attn_sample_unit(const Params& p, LAS float* sS, int it, int lane) {
    unsigned char* ws = p.ws;
    const int h = it & 3, g = (it >> 2) % 3, si = it / 12, b = si >> 2, s = si & 3, sh = 2 * g, win = 128 << sh;
    const float* cache = p.in[2 + g];
    const float* newr = p.out + ((g == 0) ? O_KVS0 : (g == 1) ? O_KVS1 : O_KVS2);
    const f32x4* qp = (const f32x4*)((const float*)(ws + WS_SQ) + ((size_t)si * 12 + g * 4 + h) * 64);
    const float* kr[2];
#pragma unroll
    for (int c = 0; c < 2; ++c) {
        const int idx = win + s - ((lane + 64 * c) << sh);
        kr[c] = (idx < win) ? cache + (size_t)(b * win + idx) * 512 + h * 64 : newr + (size_t)(b * win + idx - 4) * 512 + h * 64;
    }
    f32x4 kv[2][16];
#pragma unroll
    for (int c = 0; c < 2; ++c)
#pragma unroll
        for (int c16 = 0; c16 < 16; ++c16) kv[c][c16] = *((const f32x4*)kr[c] + c16);
    const f32x4 k128 = *((const f32x4*)(cache + (size_t)(b * win + s) * 512 + h * 64) + (lane & 15));
    float d[2];
#pragma unroll
    for (int c = 0; c < 2; ++c) {
        float a0 = 0.f, a1 = 0.f;
#pragma unroll
        for (int c16 = 0; c16 < 16; c16 += 2) {
            const f32x4 pa = kv[c][c16] * qp[c16], pb = kv[c][c16 + 1] * qp[c16 + 1];
            a0 += (pa[0] + pa[1]) + (pa[2] + pa[3]); a1 += (pb[0] + pb[1]) + (pb[2] + pb[3]);
        }
        d[c] = a0 + a1;
    }
    float d2;
    { const f32x4 pa = k128 * qp[lane & 15]; d2 = (pa[0] + pa[1]) + (pa[2] + pa[3]); d2 += __shfl_xor(d2, 1); d2 += __shfl_xor(d2, 2); d2 += __shfl_xor(d2, 4); d2 += __shfl_xor(d2, 8); }
    float mx = fmaxf(fmaxf(d[0], d[1]), d2);
#pragma unroll
    for (int o = 1; o < 64; o <<= 1) mx = fmaxf(mx, __shfl_xor(mx, o));
    const float p0 = __builtin_amdgcn_exp2f(d[0] - mx), p1 = __builtin_amdgcn_exp2f(d[1] - mx), p2 = __builtin_amdgcn_exp2f(d2 - mx);
    sS[lane] = p0; sS[lane + 64] = p1; if (lane == 0) sS[128] = p2;
    const float p2b = __builtin_bit_cast(float, __builtin_amdgcn_readfirstlane(__builtin_bit_cast(int, p2)));
    const float l = wave_sum(p0 + p1) + p2b;
    LDS_WAIT();
    const int kg = lane >> 4, dc = lane & 15;
    const size_t voff = (size_t)h * 64 + 4 * dc + 256;
    f32x4 vv[33];
#pragma unroll
    for (int i = 0; i < 33; ++i) {
        const int jj = kg + 4 * i, jc = (jj <= 128) ? jj : 128;
        const int idx = win + s - (jc << sh);
        const float* vr = (idx < win) ? cache + (size_t)(b * win + idx) * 512 + voff : newr + (size_t)(b * win + idx - 4) * 512 + voff;
        vv[i] = *(const f32x4*)vr;
    }
    f32x4 o = {0.f, 0.f, 0.f, 0.f};
#pragma unroll
    for (int i = 0; i < 33; ++i) { const int jj = kg + 4 * i; const float pj = (jj <= 128) ? sS[(jj <= 128) ? jj : 128] : 0.f; o = o + vv[i] * pj; }
#pragma unroll
    for (int e = 0; e < 4; ++e) { o[e] += __shfl_xor(o[e], 16); o[e] += __shfl_xor(o[e], 32); }
    const float inv = 1.0f / l;
    if (lane < 16) {
        u32x2 w; w.x = pg8::cvt_pk_bf16(o[0] * inv, o[1] * inv); w.y = pg8::cvt_pk_bf16(o[2] * inv, o[3] * inv);
        *(u32x2*)((bf16*)(ws + WS_OG) + ((size_t)g * MR + MP + si) * DAO + h * 64 + 4 * dc) = w;
    }
    if (lane == 0) ((float*)(ws + WS_LSE))[((size_t)g * MR + MP + si) * 4 + h] = mx + __builtin_amdgcn_logf(l);
    LDS_WAIT();
}

typedef short s16x8 __attribute__((ext_vector_type(8)));
typedef short s16x4 __attribute__((ext_vector_type(4)));
typedef float f32x16 __attribute__((ext_vector_type(16)));
constexpr int AT_ROWB = 144, AT_VROWB = 192, AT_V0 = 384 * AT_ROWB, AT_UNITS = NB * 12 * 16, AT_PER_WG = 6;
__device__ __forceinline__ s16x4 vtr(const LAS unsigned char* p) { return __builtin_bit_cast(s16x4, __builtin_amdgcn_ds_read_tr16_b64_v4i16((LAS s16x4*)p)); }
__device__ __forceinline__ float shfl32(float v) { return __shfl_xor(v, 32); }

struct AttnPf { u32x4 k[6], v[6], q[4]; };
__device__ __forceinline__ void attn_prefetch(AttnPf& pf, const bf16* Q, const bf16* K, const bf16* V, int u, int tid, int wave, int lane) {
    const int bgh = u >> 4, c = u & 15, g = (bgh >> 2) % 3, sh = 2 * g, pos0 = 256 * c;
    const bool has_prev = (pos0 & ((4096 >> sh) - 1)) != 0;
    const size_t hb = (size_t)bgh * 4096 * 64;
#pragma unroll
    for (int i = 0; i < 6; ++i) {
        const int rel = (tid >> 3) + 64 * i - 128;
        if (has_prev || i >= 2) {
            const size_t off = hb + (size_t)(pos0 + rel) * 64 + (tid & 7) * 8;
            pf.k[i] = *(const u32x4*)(K + off); pf.v[i] = *(const u32x4*)(V + off);
        }
    }
    const bf16* qp = Q + hb + (size_t)(pos0 + 32 * wave + (lane & 31)) * 64 + (lane >> 5) * 8;
#pragma unroll
    for (int ks = 0; ks < 4; ++ks) pf.q[ks] = *(const u32x4*)(qp + ks * 16);
}
__device__ __forceinline__ void attn_stage(const AttnPf& pf, LAS unsigned char* lds, int u, int tid) {
    const int bgh = u >> 4, c = u & 15, g = (bgh >> 2) % 3, sh = 2 * g, pos0 = 256 * c;
    const bool has_prev = (pos0 & ((4096 >> sh) - 1)) != 0;
#pragma unroll
    for (int i = 0; i < 6; ++i) {
        const int kr = (tid >> 3) + 64 * i;
        const bool ld = has_prev || i >= 2;
        *(LAS u32x4*)(lds + kr * AT_ROWB + (tid & 7) * 16) = ld ? pf.k[i] : (u32x4){0u, 0u, 0u, 0u};
        *(LAS u32x4*)(lds + AT_V0 + kr * AT_VROWB + (tid & 7) * 16) = ld ? pf.v[i] : (u32x4){0u, 0u, 0u, 0u};
    }
}
__device__ __forceinline__ void attn_compute(const AttnPf& pf, LAS unsigned char* lds, bf16* OG, float* LSE, int u, int wave, int lane) {
    const int bgh = u >> 4, c = u & 15, b = bgh / 12, g = (bgh >> 2) % 3, hh = bgh & 3, sh = 2 * g, pos0 = 256 * c;
    const bool has_prev = (pos0 & ((4096 >> sh) - 1)) != 0;
    const int r32 = lane & 31, h = lane >> 5;
    const int jmin = has_prev ? 0 : ((wave < 4) ? 4 - wave : 0);
    f32x16 S[5];
    const LAS unsigned char* kbase = lds + (32 * wave + r32) * AT_ROWB + h * 16;
    s16x8 kf[2][4];
#pragma unroll
    for (int ks = 0; ks < 4; ++ks) kf[0][ks] = *(const LAS s16x8*)(kbase + ks * 32);
#pragma unroll
    for (int j = 0; j < 5; ++j) {
        if (j < 4) {
#pragma unroll
            for (int ks = 0; ks < 4; ++ks) kf[(j + 1) & 1][ks] = *(const LAS s16x8*)(kbase + (j + 1) * 32 * AT_ROWB + ks * 32);
        }
        f32x16 a = {0.f, 0.f, 0.f, 0.f, 0.f, 0.f, 0.f, 0.f, 0.f, 0.f, 0.f, 0.f, 0.f, 0.f, 0.f, 0.f};
#pragma unroll
        for (int ks = 0; ks < 4; ++ks) a = __builtin_amdgcn_mfma_f32_32x32x16_bf16(kf[j & 1][ks], __builtin_bit_cast(s16x8, pf.q[ks]), a, 0, 0, 0);
        S[j] = a;
    }
    float m = -1e30f;
#pragma unroll
    for (int j = 0; j < 5; ++j) {
        const bool tile_ok = j >= jmin;
#pragma unroll
        for (int r = 0; r < 16; ++r) {
            const int cr = (r & 3) + 8 * (r >> 2) + 4 * h;
            const bool valid = tile_ok && ((j == 0) ? (cr >= r32) : (j == 4) ? (cr <= r32) : true);
            const float v = valid ? S[j][r] : -1e30f;
            S[j][r] = v; m = fmaxf(m, v);
        }
    }
    m = fmaxf(m, shfl32(m));
    float l = 0.f;
#pragma unroll
    for (int j = 0; j < 5; ++j) {
#pragma unroll
        for (int r = 0; r < 16; ++r) { const float pe = __builtin_amdgcn_exp2f(S[j][r] - m); S[j][r] = pe; l += pe; }
    }
    l += shfl32(l);
    f32x16 o0 = {0.f, 0.f, 0.f, 0.f, 0.f, 0.f, 0.f, 0.f, 0.f, 0.f, 0.f, 0.f, 0.f, 0.f, 0.f, 0.f}, o1 = o0;
    const int a4 = lane & 15, G4 = lane >> 4;
    const LAS unsigned char* vbase = lds + AT_V0 + (32 * wave + 4 * (G4 >> 1) + (a4 >> 2)) * AT_VROWB + (16 * (G4 & 1) + 4 * (a4 & 3)) * 2;
#pragma unroll
    for (int j = 0; j < 5; ++j) {
        {
#pragma unroll
            for (int s2 = 0; s2 < 2; ++s2) {
                u32x4 pw;
                pw.x = pg8::cvt_pk_bf16(S[j][8 * s2 + 0], S[j][8 * s2 + 1]); pw.y = pg8::cvt_pk_bf16(S[j][8 * s2 + 2], S[j][8 * s2 + 3]);
                pw.z = pg8::cvt_pk_bf16(S[j][8 * s2 + 4], S[j][8 * s2 + 5]); pw.w = pg8::cvt_pk_bf16(S[j][8 * s2 + 6], S[j][8 * s2 + 7]);
                const s16x8 pfrag = __builtin_bit_cast(s16x8, pw);
                const LAS unsigned char* vp = vbase + (32 * j + 16 * s2) * AT_VROWB;
                const s16x4 a0 = vtr(vp), a1 = vtr(vp + 8 * AT_VROWB), b0 = vtr(vp + 64), b1 = vtr(vp + 8 * AT_VROWB + 64);
                const s16x8 va = {a0[0], a0[1], a0[2], a0[3], a1[0], a1[1], a1[2], a1[3]};
                const s16x8 vb = {b0[0], b0[1], b0[2], b0[3], b1[0], b1[1], b1[2], b1[3]};
                o0 = __builtin_amdgcn_mfma_f32_32x32x16_bf16(va, pfrag, o0, 0, 0, 0);
                o1 = __builtin_amdgcn_mfma_f32_32x32x16_bf16(vb, pfrag, o1, 0, 0, 0);
            }
        }
    }
    const int pos = pos0 + 32 * wave + r32;
    const int t = ((pos & ((4096 >> sh) - 1)) << sh) + (pos >> (12 - sh));
    const size_t row = (size_t)b * 4096 + t;
    const float inv = 1.0f / l;
    bf16* op = OG + ((size_t)g * MR + row) * DAO + hh * 64 + 4 * h;
#pragma unroll
    for (int i = 0; i < 4; ++i) {
        u32x2 w0, w1;
        w0.x = pg8::cvt_pk_bf16(o0[4 * i] * inv, o0[4 * i + 1] * inv); w0.y = pg8::cvt_pk_bf16(o0[4 * i + 2] * inv, o0[4 * i + 3] * inv);
        w1.x = pg8::cvt_pk_bf16(o1[4 * i] * inv, o1[4 * i + 1] * inv); w1.y = pg8::cvt_pk_bf16(o1[4 * i + 2] * inv, o1[4 * i + 3] * inv);
        *(u32x2*)(op + 8 * i) = w0; *(u32x2*)(op + 32 + 8 * i) = w1;
    }
    if (h == 0) LSE[((size_t)g * MR + row) * 4 + hh] = m + __builtin_amdgcn_logf(l);
}
__device__ __forceinline__ void attn_phase_mfma(const Params& p, LAS unsigned char* lds, int vcu, int tid, int wave, int lane) {
    unsigned char* ws = p.ws;
    const bf16* Q = (const bf16*)(ws + WS_Q); const bf16* K = (const bf16*)(ws + WS_K); const bf16* V = (const bf16*)(ws + WS_V);
    bf16* OG = (bf16*)(ws + WS_OG); float* LSE = (float*)(ws + WS_LSE);
    AttnPf pf;
    const int u0 = vcu * AT_PER_WG;
    attn_prefetch(pf, Q, K, V, u0, tid, wave, lane);
#pragma unroll 1
    for (int i = 0; i < AT_PER_WG; ++i) {
        const int u = u0 + i;
        attn_stage(pf, lds, u, tid);
        AttnPf cur;
#pragma unroll
        for (int ks = 0; ks < 4; ++ks) cur.q[ks] = pf.q[ks];
        __syncthreads();
        if (i + 1 < AT_PER_WG) attn_prefetch(pf, Q, K, V, u + 1, tid, wave, lane);
        attn_compute(cur, lds, OG, LSE, u, wave, lane);
        __syncthreads();
    }
}
__device__ __forceinline__ void merge4(const bf16* OG, const float* LSE, bf16* OATT, int row0, int rstep, int ch, int n) {
    float l[4][3]; u32x4 og[4][3];
    const int hh = ch >> 3;
#pragma unroll
    for (int q = 0; q < 4; ++q) {
        if (q < n) {
            const int row = row0 + q * rstep;
#pragma unroll
            for (int g = 0; g < 3; ++g) { l[q][g] = LSE[((size_t)g * MR + row) * 4 + hh]; og[q][g] = __builtin_nontemporal_load((const u32x4*)(OG + ((size_t)g * MR + row) * DAO + ch * 8)); }
        }
    }
#pragma unroll
    for (int q = 0; q < 4; ++q) {
        if (q < n) {
            const int row = row0 + q * rstep;
            const float mx = fmaxf(l[q][0], fmaxf(l[q][1], l[q][2]));
            float e0 = __builtin_amdgcn_exp2f(l[q][0] - mx), e1 = __builtin_amdgcn_exp2f(l[q][1] - mx), e2 = __builtin_amdgcn_exp2f(l[q][2] - mx);
            const float inv = 1.0f / (e0 + e1 + e2); e0 *= inv; e1 *= inv; e2 *= inv;
            f32x4 a0, b0, a1, b1, a2, b2;
            unpack8(og[q][0], a0, b0); unpack8(og[q][1], a1, b1); unpack8(og[q][2], a2, b2);
            *(u32x4*)(OATT + (size_t)row * KC + ch * 8) = pack8(a0 * e0 + a1 * e1 + a2 * e2, b0 * e0 + b1 * e1 + b2 * e2);
        }
    }
}
__device__ __forceinline__ void merge_phase(const Params& p, int vcu, int tid) {
    unsigned char* ws = p.ws;
    const bf16* OG = (const bf16*)(ws + WS_OG); const float* LSE = (const float*)(ws + WS_LSE); bf16* OATT = (bf16*)(ws + WS_A);
    const int r0 = 128 * vcu + (tid >> 5), ch = tid & 31;
    merge4(OG, LSE, OATT, r0, 16, ch, 4);
    merge4(OG, LSE, OATT, r0 + 64, 16, ch, 4);
}

typedef float f32x2 __attribute__((ext_vector_type(2)));
constexpr int CV_T = 32, CV_UNITS = MP / CV_T, CV_PER_WG = CV_UNITS / 256;
template <int E> __device__ __forceinline__ void conv_loads(unsigned (&uw)[62], const bf16* up, bool has_left) {
    if constexpr (E < 62) {
        uw[E] = 0u;
        if (E >= 30 || has_left) uw[E] = *(const unsigned*)(up + (size_t)E * DM);
        conv_loads<E + 1>(uw, up, has_left);
    }
}
template <int E> __device__ __forceinline__ void conv_steps(f32x2 (&acc)[32], const f32x2 (&w)[31], const unsigned (&uw)[62]) {
    if constexpr (E < 62) {
        const f32x2 uv = {bf_lo(uw[E]), bf_hi(uw[E])};
        constexpr int TLO = (E - 30 > 0) ? E - 30 : 0, THI = (E < 31) ? E : 31;
#pragma unroll
        for (int t = TLO; t <= THI; ++t) acc[t] = acc[t] + w[E - t] * uv;
        conv_steps<E + 1>(acc, w, uw);
    }
}
__device__ __forceinline__ void conv_unit(const Params& p, LAS unsigned char* lds, const bf16* U, bf16* CACT, int unit, int tid, int wave, int lane,
                                          const f32x2 (&w)[31], f32x2 cb, f32x2 lw, f32x2 lb) {
    const int row0 = unit * CV_T, t0 = row0 & 4095, ch = 2 * tid;
    f32x2 acc[CV_T];
#pragma unroll
    for (int t = 0; t < CV_T; ++t) acc[t] = cb;
    const bf16* up = U + (size_t)(row0 - 30) * DM + ch;
    unsigned uw[62];
    conv_loads<0>(uw, up, t0 != 0);
    conv_steps<0>(acc, w, uw);
    float v[64];
#pragma unroll
    for (int t = 0; t < CV_T; ++t) { v[t] = acc[t].x + acc[t].y; v[32 + t] = acc[t].x * acc[t].x + acc[t].y * acc[t].y; }
#define CV_BFLY(n) { const bool up_half = (lane & (n)) != 0; _Pragma("unroll") for (int i = 0; i < (n); ++i) { \
        const float keep = up_half ? v[i + (n)] : v[i], send = up_half ? v[i] : v[i + (n)]; v[i] = keep + __shfl_xor(send, (n)); } }
    CV_BFLY(32) CV_BFLY(16) CV_BFLY(8) CV_BFLY(4) CV_BFLY(2) CV_BFLY(1)
#undef CV_BFLY
    LAS float* red = (LAS float*)lds;
    red[wave * 64 + lane] = v[0];
    __syncthreads();
    float tot = 0.f;
#pragma unroll
    for (int w8 = 0; w8 < 8; ++w8) tot += red[w8 * 64 + lane];
    __syncthreads();
    const float sq = __shfl(tot, (lane & 31) + 32);
    const float mean = tot * (1.0f / DM);
    const float var = sq * (1.0f / DM) - mean * mean;
    const float rstd = __builtin_amdgcn_rsqf(fmaxf(var, 0.f) + LN_EPS);
#pragma unroll
    for (int t = 0; t < CV_T; ++t) {
        const float mt = __builtin_bit_cast(float, __builtin_amdgcn_readlane(__builtin_bit_cast(int, mean), t));
        const float rt = __builtin_bit_cast(float, __builtin_amdgcn_readlane(__builtin_bit_cast(int, rstd), t));
        float y0 = (acc[t].x - mt) * rt * lw.x + lb.x, y1 = (acc[t].y - mt) * rt * lw.y + lb.y;
        y0 = y0 * sigmoidf_(y0); y1 = y1 * sigmoidf_(y1);
        *(unsigned*)(CACT + (size_t)(row0 + t) * KC + ch) = pg8::cvt_pk_bf16(y0, y1);
    }
}
__device__ __forceinline__ void conv_phase(const Params& p, LAS unsigned char* lds, int vcu, int tid, int wave, int lane) {
    unsigned char* ws = p.ws;
    const bf16* U = (const bf16*)(ws + WS_B); bf16* CACT = (bf16*)(ws + WS_A) + DAO;
    const int ch = 2 * tid;
    f32x2 w[31];
#pragma unroll
    for (int i = 0; i < 31; ++i) w[i] = *(const f32x2*)(p.in[11] + (size_t)i * DM + ch);
    const f32x2 cb = *(const f32x2*)(p.in[12] + ch), lw = *(const f32x2*)(p.in[13] + ch), lb = *(const f32x2*)(p.in[14] + ch);
#pragma unroll 1
    for (int i = 0; i < CV_PER_WG; ++i) conv_unit(p, lds, U, CACT, vcu * CV_PER_WG + i, tid, wave, lane, w, cb, lw, lb);
    if (vcu < SB) {
        const int b = vcu;
        f32x2 u[34];
#pragma unroll
        for (int e = 0; e < 30; ++e) u[e] = *(const f32x2*)(p.in[5] + ((size_t)b * 30 + e) * DM + ch);
#pragma unroll
        for (int e = 30; e < 34; ++e) { const unsigned wv = *(const unsigned*)(U + (size_t)(MP + 4 * b + e - 30) * DM + ch); u[e] = (f32x2){bf_lo(wv), bf_hi(wv)}; }
        f32x2 acc[4]; float v[8];
#pragma unroll
        for (int s4 = 0; s4 < 4; ++s4) {
            acc[s4] = cb;
#pragma unroll
            for (int i = 0; i < 31; ++i) acc[s4] = acc[s4] + w[i] * u[s4 + i];
            v[s4] = acc[s4].x + acc[s4].y; v[4 + s4] = acc[s4].x * acc[s4].x + acc[s4].y * acc[s4].y;
        }
#pragma unroll
        for (int o = 1; o < 64; o <<= 1)
#pragma unroll
            for (int j = 0; j < 8; ++j) v[j] += __shfl_xor(v[j], o);
        LAS float* red = (LAS float*)lds;
        __syncthreads();
        if (lane < 8) {
            float mine = v[0];
#pragma unroll
            for (int j = 1; j < 8; ++j) mine = (lane == j) ? v[j] : mine;
            red[wave * 8 + lane] = mine;
        }
        __syncthreads();
#pragma unroll
        for (int s4 = 0; s4 < 4; ++s4) {
            float sm = 0.f, sq = 0.f;
#pragma unroll
            for (int w8 = 0; w8 < 8; ++w8) { sm += red[w8 * 8 + s4]; sq += red[w8 * 8 + 4 + s4]; }
            const float mean = sm * (1.0f / DM), var = sq * (1.0f / DM) - mean * mean, rstd = __builtin_amdgcn_rsqf(fmaxf(var, 0.f) + LN_EPS);
            float y0 = (acc[s4].x - mean) * rstd * lw.x + lb.x, y1 = (acc[s4].y - mean) * rstd * lw.y + lb.y;
            y0 = y0 * sigmoidf_(y0); y1 = y1 * sigmoidf_(y1);
            *(unsigned*)(CACT + (size_t)(MP + 4 * b + s4) * KC + ch) = pg8::cvt_pk_bf16(y0, y1);
        }
        __syncthreads();
    }
}

typedef float f32x4v __attribute__((ext_vector_type(4)));
template <int NRB, int NCB, int K>
__device__ __forceinline__ void thin_partial(LAS float* P, const bf16* A, int lda, const bf16* B0, const bf16* B1, int ldb, int wave, int lane) {
    constexpr int KW = K / 8, STEPS = KW / 32, ROWS = 16 * NRB, COLS = 16 * NCB;
    const int r16 = lane & 15, k8 = lane >> 4;
    f32x4v acc[NRB][NCB];
#pragma unroll
    for (int rb = 0; rb < NRB; ++rb)
#pragma unroll
        for (int cb = 0; cb < NCB; ++cb) acc[rb][cb] = (f32x4v){0.f, 0.f, 0.f, 0.f};
    const bf16* ap = A + (size_t)r16 * lda + wave * KW + 8 * k8;
    const bf16* bp0 = B0 + (size_t)r16 * ldb + wave * KW + 8 * k8;
    const bf16* bp1 = B1 + (size_t)r16 * ldb + wave * KW + 8 * k8;
#pragma unroll
    for (int st = 0; st < STEPS; ++st) {
        bf16x8 b[NCB];
        b[0] = *(const bf16x8*)(bp0 + 32 * st);
        if (NCB > 1) b[NCB - 1] = *(const bf16x8*)(bp1 + 32 * st);
#pragma unroll
        for (int rb = 0; rb < NRB; ++rb) {
            const bf16x8 a = *(const bf16x8*)(ap + (size_t)(16 * rb) * lda + 32 * st);
#pragma unroll
            for (int cb = 0; cb < NCB; ++cb) acc[rb][cb] = __builtin_amdgcn_mfma_f32_16x16x32_bf16(a, b[cb], acc[rb][cb], 0, 0, 0);
        }
    }
#pragma unroll
    for (int rb = 0; rb < NRB; ++rb)
#pragma unroll
        for (int cb = 0; cb < NCB; ++cb)
#pragma unroll
            for (int r = 0; r < 4; ++r) P[(wave * ROWS + 16 * rb + 4 * k8 + r) * COLS + 16 * cb + r16] = acc[rb][cb][r];
}
template <int ROWS, int COLS> __device__ __forceinline__ float thin_sum(const LAS float* P, int r, int c) {
    float v = 0.f;
#pragma unroll
    for (int w = 0; w < 8; ++w) v += P[(w * ROWS + r) * COLS + c];
    return v;
}
template <int STAGE> __device__ __forceinline__ void thin_stage(const Params& p, LAS unsigned char* lds, int vcu, int tid, int wave, int lane) {
    unsigned char* ws = p.ws;
    LAS float* P = (LAS float*)lds;
    if constexpr (STAGE == 0 || STAGE == 1 || STAGE == 2 || STAGE == 4) {
        constexpr int K = (STAGE == 0) ? DAO : (STAGE == 4) ? DFF : DM;
        constexpr int LDA = (STAGE <= 1) ? KC : K, LDB = (STAGE <= 1) ? KC : K;
        const bf16* A = (STAGE == 0) ? (const bf16*)(ws + WS_A) : (STAGE == 1) ? (const bf16*)(ws + WS_A) + DAO : (STAGE == 2) ? (const bf16*)(ws + WS_B) : (const bf16*)(ws + WS_ACT);
        const bf16* B = (STAGE == 0) ? (const bf16*)(ws + WS_WCAT) : (STAGE == 1) ? (const bf16*)(ws + WS_WCAT) + DAO : (STAGE == 2) ? (const bf16*)(ws + WS_WOUT) : (const bf16*)(ws + WS_WD);
        const int ct = vcu & 63, rb = vcu >> 6, row0 = MP + 32 * rb, col0 = 16 * ct;
        if constexpr (STAGE == 0) {
            merge4((const bf16*)(ws + WS_OG), (const float*)(ws + WS_LSE), (bf16*)(ws + WS_A), row0 + (tid >> 5), 16, tid & 31, 2);
            asm volatile("s_waitcnt vmcnt(0)" ::: "memory");
            __syncthreads();
            __builtin_amdgcn_fence(__ATOMIC_ACQUIRE, "agent");
        }
        thin_partial<2, 1, K>(P, A + (size_t)row0 * LDA, LDA, B + (size_t)col0 * LDB, B + (size_t)col0 * LDB, LDB, wave, lane);
        __syncthreads();
        const int r = tid >> 4, c = tid & 15, row = row0 + r, col = col0 + c;
        const float acc = thin_sum<32, 16>(P, r, c);
        if constexpr (STAGE == 0) {
            const bf16* GA = (const bf16*)(ws + WS_GA); bf16* HA = (bf16*)(ws + WS_B);
            HA[(size_t)row * DM + col] = (bf16)f2bf(acc * ((float)((const unsigned char*)GA)[(size_t)row * GP + col] * (1.0f / 255.0f)));
        } else if constexpr (STAGE == 1) {
            const bf16* GB = (const bf16*)(ws + WS_GB); bf16* H = (bf16*)(ws + WS_B);
            H[(size_t)row * DM + col] = (bf16)f2bf(acc * ((float)((const unsigned char*)GB)[(size_t)row * GP + col] * (1.0f / 255.0f)) + bf_lo((unsigned)H[(size_t)row * DM + col]));
        } else if constexpr (STAGE == 2) {
            const float x1 = p.in[1][(size_t)(row - MP) * DM + col] + acc;
            p.out[(size_t)row * DM + col] = x1;
            ((bf16*)(ws + WS_X1B))[(size_t)row * DM + col] = (bf16)f2bf(x1);
            float ss = x1 * x1;
            ss += __shfl_xor(ss, 1); ss += __shfl_xor(ss, 2); ss += __shfl_xor(ss, 4); ss += __shfl_xor(ss, 8);
            if (c == 0) ((float*)(ws + WS_SSS))[(size_t)(row - MP) * 64 + ct] = ss;
        } else {
            p.out[(size_t)row * DM + col] += acc;
        }
        __syncthreads();
    } else {
        const bf16* A = (const bf16*)(ws + WS_X1B); const bf16* B = (const bf16*)(ws + WS_WGU); bf16* ACT = (bf16*)(ws + WS_ACT);
        const float* SSS = (const float*)(ws + WS_SSS);
        for (int u = vcu; u < 352; u += 256) {
            const int ct = u % 176, rb = u / 176, row0 = MP + 64 * rb, ch0 = 16 * ct;
            const int bpos = (ch0 >> 7) * 256 + (ch0 & 127);
            thin_partial<4, 2, DM>(P, A + (size_t)row0 * DM, DM, B + (size_t)bpos * DM, B + (size_t)(bpos + 128) * DM, DM, wave, lane);
            __syncthreads();
#pragma unroll
            for (int i = 0; i < 2; ++i) {
                const int e = tid + 512 * i, r = e >> 4, c = e & 15, row = row0 + r;
                const f32x4 sv = *(const f32x4*)(SSS + (size_t)(row - MP) * 64 + 4 * c);
                float tot = (sv[0] + sv[1]) + (sv[2] + sv[3]);
                tot += __shfl_xor(tot, 1); tot += __shfl_xor(tot, 2); tot += __shfl_xor(tot, 4); tot += __shfl_xor(tot, 8);
                const float rstd = __builtin_amdgcn_rsqf(tot * (1.0f / DM) + RMS_EPS);
                const float g = thin_sum<64, 32>(P, r, c) * rstd, up = thin_sum<64, 32>(P, r, 16 + c) * rstd;
                ACT[(size_t)row * DFF + ch0 + c] = (bf16)f2bf(g * sigmoidf_(g) * up);
            }
            __syncthreads();
        }
    }
}

__device__ __forceinline__ void tr_item(const float* W, int ldw, int K, bf16* WT, int k0, int pos0, int src0, const float* ksc, LAS float* scr, int lane, int kdst = 0) {
    const int kr = lane >> 3, n4 = lane & 7;
    f32x4 v[8];
#pragma unroll
    for (int i = 0; i < 8; ++i) v[i] = __builtin_nontemporal_load((const GAS f32x4*)(W + (size_t)(k0 + kr + 8 * i) * ldw + src0 + 4 * n4));
#pragma unroll
    for (int i = 0; i < 8; ++i) {
        const int kk = kr + 8 * i;
        const float sc = ksc ? ksc[k0 + kk] : 1.0f;
        LAS float* d = scr + kk * 33 + 4 * n4;
        d[0] = v[i].x * sc; d[1] = v[i].y * sc; d[2] = v[i].z * sc; d[3] = v[i].w * sc;
    }
    LDS_WAIT(); asm volatile("" ::: "memory");
    const int c = lane & 7;
#pragma unroll
    for (int j = 0; j < 4; ++j) { const int n = (lane >> 3) + 8 * j; const LAS float* s = scr + (8 * c) * 33 + n;
        v4u o; o.x = pk2(s[0 * 33], s[1 * 33]); o.y = pk2(s[2 * 33], s[3 * 33]); o.z = pk2(s[4 * 33], s[5 * 33]); o.w = pk2(s[6 * 33], s[7 * 33]);
        *(GAS v4u*)(WT + (size_t)(pos0 + n) * K + kdst + k0 + 8 * c) = o; }
    LDS_WAIT(); asm volatile("" ::: "memory");
}
__device__ __forceinline__ int w1_src(int pos0) {
    const int pn = pos0 >> 8, p = pos0 & 255;
    if (pn < 9) { const int seg = pn / 3, g = pn - 3 * seg; return seg * 768 + g * 256 + 64 * ((p >> 5) & 3) + 32 * (p >> 7); }
    if (pn < 17) { return ((p < 128) ? 2304 : 3328) + 128 * (pn - 9) + (p & 127); }
    return pos0;
}
__device__ __forceinline__ int wgu_src(int pos0) { const int pn = pos0 >> 8, p = pos0 & 255; return ((p < 128) ? 0 : DFF) + 128 * pn + (p & 127); }

__device__ __forceinline__ void tr_load(const float* W, int ldw, int k0, int src0, int lane, f32x4 (&v)[8]) {
    const int kr = lane >> 3, n4 = lane & 7;
#pragma unroll
    for (int i = 0; i < 8; ++i) v[i] = __builtin_nontemporal_load((const GAS f32x4*)(W + (size_t)(k0 + kr + 8 * i) * ldw + src0 + 4 * n4));
}
__device__ __forceinline__ void tr_store(const f32x4 (&v)[8], int K, bf16* WT, int k0, int pos0, const float* ksc, LAS float* scr, int lane, int kdst) {
    const int kr = lane >> 3, n4 = lane & 7;
#pragma unroll
    for (int i = 0; i < 8; ++i) {
        const int kk = kr + 8 * i;
        const float sc = ksc ? ksc[k0 + kk] : 1.0f;
        LAS float* d = scr + kk * 33 + 4 * n4;
        d[0] = v[i].x * sc; d[1] = v[i].y * sc; d[2] = v[i].z * sc; d[3] = v[i].w * sc;
    }
    LDS_WAIT(); asm volatile("" ::: "memory");
    const int c = lane & 7;
#pragma unroll
    for (int j = 0; j < 4; ++j) { const int n = (lane >> 3) + 8 * j; const LAS float* s = scr + (8 * c) * 33 + n;
        v4u o; o.x = pk2(s[0 * 33], s[1 * 33]); o.y = pk2(s[2 * 33], s[3 * 33]); o.z = pk2(s[4 * 33], s[5 * 33]); o.w = pk2(s[6 * 33], s[7 * 33]);
        *(GAS v4u*)(WT + (size_t)(pos0 + n) * K + kdst + k0 + 8 * c) = o; }
    LDS_WAIT(); asm volatile("" ::: "memory");
}
constexpr int LW_ATT = 4 * 32, LW_CO = 16 * 32, LW_OUT = 16 * 32, LW_GU = 16 * (NGU / 32), LW_D = (DFF / 64) * 32, LW_ITEMS = LW_ATT + LW_CO + LW_OUT + LW_GU + LW_D;
__device__ __forceinline__ void lw_load(const Params& p, int it, int lane, f32x4 (&v)[8]) {
    int r = it;
    if (r >= LW_ITEMS) return;
    if (r < LW_ATT) { tr_load(p.in[10], DM, 64 * (r / 32), 32 * (r % 32), lane, v); return; } r -= LW_ATT;
    if (r < LW_CO) { tr_load(p.in[15], DM, 64 * (r / 32), 32 * (r % 32), lane, v); return; } r -= LW_CO;
    if (r < LW_OUT) { tr_load(p.in[16], DM, 64 * (r / 32), 32 * (r % 32), lane, v); return; } r -= LW_OUT;
    if (r < LW_GU) { tr_load(p.in[18], NGU, 64 * (r / (NGU / 32)), wgu_src(32 * (r % (NGU / 32))), lane, v); return; } r -= LW_GU;
    tr_load(p.in[19], DM, 64 * (r / 32), 32 * (r % 32), lane, v);
}
__device__ __forceinline__ void lw_store(const Params& p, int it, int lane, const f32x4 (&v)[8], LAS float* scr) {
    unsigned char* ws = p.ws;
    int r = it;
    if (r >= LW_ITEMS) return;
    if (r < LW_ATT) { tr_store(v, KC, (bf16*)(ws + WS_WCAT), 64 * (r / 32), 32 * (r % 32), nullptr, scr, lane, 0); return; } r -= LW_ATT;
    if (r < LW_CO) { tr_store(v, KC, (bf16*)(ws + WS_WCAT), 64 * (r / 32), 32 * (r % 32), nullptr, scr, lane, DAO); return; } r -= LW_CO;
    if (r < LW_OUT) { tr_store(v, DM, (bf16*)(ws + WS_WOUT), 64 * (r / 32), 32 * (r % 32), nullptr, scr, lane, 0); return; } r -= LW_OUT;
    if (r < LW_GU) { tr_store(v, DM, (bf16*)(ws + WS_WGU), 64 * (r / (NGU / 32)), 32 * (r % (NGU / 32)), p.in[17], scr, lane, 0); return; } r -= LW_GU;
    tr_store(v, DFF, (bf16*)(ws + WS_WD), 64 * (r / 32), 32 * (r % 32), nullptr, scr, lane, 0);
}
__device__ __forceinline__ void late_weights(const Params& p, LAS unsigned char* lds, int idx, int nwk, int wave, int lane) {
    LAS float* scr = (LAS float*)(lds + wave * 16384);
    const int stride = nwk * NWAVES;
    for (int it = idx * NWAVES + wave; it < LW_ITEMS; it += 4 * stride) {
        f32x4 v[4][8];
#pragma unroll
        for (int q = 0; q < 4; ++q) lw_load(p, it + q * stride, lane, v[q]);
#pragma unroll
        for (int q = 0; q < 4; ++q) lw_store(p, it + q * stride, lane, v[q], scr);
    }
}
__device__ __forceinline__ void copy_rows(const float* src, float* dst, int rows, int per, int rw, int gt, int NGT) {
    const int n4b = rows * rw, tot = SB * n4b;
    for (int i0 = gt; i0 < tot; i0 += 8 * NGT) {
        f32x4 v[8];
#pragma unroll
        for (int j = 0; j < 8; ++j) { const int i = i0 + j * NGT; if (i < tot) { const int b = i / n4b, r = i - b * n4b; v[j] = __builtin_nontemporal_load((const GAS f32x4*)src + (size_t)b * per * rw + 4 * rw + r); } }
#pragma unroll
        for (int j = 0; j < 8; ++j) { const int i = i0 + j * NGT; if (i < tot) { const int b = i / n4b, r = i - b * n4b; __builtin_nontemporal_store(v[j], (GAS f32x4*)dst + (size_t)b * per * rw + r); } }
    }
}
__device__ __forceinline__ void p0_prologue(const Params& p, LAS unsigned char* lds, int vcu, int G, int wave, int lane) {
    unsigned char* ws = p.ws;
    LAS float* scr = (LAS float*)(lds + wave * 16384);
    const int gw = vcu * NWAVES + wave, NGW = G * NWAVES;
    constexpr int I_W1 = 16 * (NIN / 32);
    for (int r = gw; r < I_W1; r += NGW) { const int nb = r % (NIN / 32), kb = r / (NIN / 32); tr_item(p.in[7], NIN, DM, (bf16*)(ws + WS_W1), 64 * kb, 32 * nb, w1_src(32 * nb), nullptr, scr, lane); }
    bf16* XN = (bf16*)(ws + WS_A);
    const float* nw = p.in[6];
    f32x4 wv[4];
#pragma unroll
    for (int j = 0; j < 4; ++j) wv[j] = *((const f32x4*)nw + lane + 64 * j);
    for (int m0 = gw; m0 < MR; m0 += 2 * NGW) {
        f32x4 v[2][4];
#pragma unroll
        for (int q = 0; q < 2; ++q) {
            const int m = m0 + q * NGW;
            if (m < MV) {
                const float* xrow = (m < MP) ? p.in[0] + (size_t)m * DM : p.in[1] + (size_t)(m - MP) * DM;
                const GAS f32x4* xr = (const GAS f32x4*)xrow + lane;
#pragma unroll
                for (int j = 0; j < 4; ++j) v[q][j] = __builtin_nontemporal_load(xr + 64 * j);
            } else {
#pragma unroll
                for (int j = 0; j < 4; ++j) v[q][j] = (f32x4){0.f, 0.f, 0.f, 0.f};
            }
        }
#pragma unroll
        for (int q = 0; q < 2; ++q) {
            const int m = m0 + q * NGW;
            if (m < MR) {
                float s = 0.f;
#pragma unroll
                for (int j = 0; j < 4; ++j) s += (v[q][j].x * v[q][j].x + v[q][j].y * v[q][j].y) + (v[q][j].z * v[q][j].z + v[q][j].w * v[q][j].w);
                const float rstd = __builtin_amdgcn_rsqf(wave_sum(s) * (1.f / DM) + RMS_EPS);
                GAS unsigned long long* o8 = (GAS unsigned long long*)(XN + (size_t)m * DM) + lane;
#pragma unroll
                for (int j = 0; j < 4; ++j) { const f32x4 y = v[q][j] * rstd * wv[j]; o8[64 * j] = (unsigned long long)pk2(y.x, y.y) | ((unsigned long long)pk2(y.z, y.w) << 32); }
            }
        }
    }
}

#define CW_XT        0
#define CW_QC(q)     (1024 + 16 * (q))
#define CW_BS(k, x)  (2048 + 128 * (k) + 8 * (x))
#define CW_BT(k)     (3200 + 16 * (k))
#define CW_GC(g)     (3400 + 16 * (g))
#define SB_P1 4
#define SB_P2 5
struct QuadOrder {
    int pm0, j, nN, nu;
    __device__ __forceinline__ void init(int vcu, int nN_) { pm0 = 2 * (vcu >> 2); j = vcu & 3; nN = nN_; nu = nN_ / 2; }
    __device__ __forceinline__ bool next(int i, pg8::Unit& u) const { if (i >= nu) return false; const int idx = 4 * i + j, hi = (idx >= nN) ? 1 : 0; u.pm = pm0 + hi; u.pn = idx - hi * nN; return true; }
    __device__ __forceinline__ void a_ready(const pg8::Unit&) const {}
    __device__ __forceinline__ void done(const pg8::Unit&) const {}
};
struct BatchOrder {
    int b, j, ns;
    __device__ __forceinline__ void init(int vcu) { b = vcu >> 5; j = vcu & 31; ns = (b == 0) ? 4 : 3; }
    __device__ __forceinline__ bool next(int i, pg8::Unit& u) const {
        const int idx = 32 * i + j;
        if (idx < 400) { const int sg = idx / 200, w = idx - 200 * sg; u.pm = 16 * b + 8 * sg + (w & 7); u.pn = w >> 3; return true; }
        if (idx < 400 + ns) { u.pm = 128; u.pn = b + 8 * (idx - 400); return true; }
        return false;
    }
    __device__ __forceinline__ int worker() const { return (j >= 16 + ns) ? ((b == 0) ? 0 : 12 + 13 * (b - 1)) + (j - 16 - ns) : -1; }
    __device__ __forceinline__ void a_ready(const pg8::Unit&) const {}
    __device__ __forceinline__ void done(const pg8::Unit&) const {}
};
__device__ __forceinline__ void split_arrive_t0(const XcdBarrier& b, unsigned* ctlw, int k) {
    const unsigned nloc = b.st[0];
    const unsigned old = xb_add(&ctlw[CW_BS(k, b.x)], 1u);
    if (old + 1u == nloc) { __builtin_amdgcn_fence(__ATOMIC_RELEASE, "agent"); asm volatile("s_waitcnt vmcnt(0)" ::: "memory"); (void)xb_add(&ctlw[CW_BT(k)], 1u); }
}
__device__ __forceinline__ void group_barrier(const XcdBarrier& b, unsigned* ctlw, volatile LAS unsigned* misc, int grp, unsigned target, int k) {
    asm volatile("s_waitcnt vmcnt(0)" ::: "memory");
    __syncthreads();
    if (threadIdx.x == 0) {
        __builtin_amdgcn_s_waitcnt(0);
        if (misc[11] == 0u) { __builtin_amdgcn_fence(__ATOMIC_RELEASE, "agent"); asm volatile("s_waitcnt vmcnt(0)" ::: "memory"); }
        (void)xb_add(&ctlw[CW_GC(grp)], 1u);
        split_arrive_t0(b, ctlw, k);
        XB_SPIN(xb_ld(&ctlw[CW_GC(grp)]) < target, b.bar);
        __builtin_amdgcn_fence(__ATOMIC_ACQUIRE, "agent");
        asm volatile("s_waitcnt vmcnt(0)" ::: "memory");
    }
    __syncthreads();
}
__device__ __forceinline__ void stage_done(const XcdBarrier& b, unsigned* ctlw, volatile LAS unsigned* misc, int quad, int k) {
    asm volatile("s_waitcnt vmcnt(0)" ::: "memory");
    __syncthreads();
    if (threadIdx.x == 0) {
        __builtin_amdgcn_s_waitcnt(0);
        if (misc[10] == 0u) { __builtin_amdgcn_fence(__ATOMIC_RELEASE, "agent"); asm volatile("s_waitcnt vmcnt(0)" ::: "memory"); }
        (void)xb_add(&ctlw[CW_QC(quad)], 1u);
        split_arrive_t0(b, ctlw, k);
    }
}
__device__ __forceinline__ void quad_wait(const XcdBarrier& b, unsigned* ctlw, int quad, unsigned target, bool next_too) {
    if (threadIdx.x == 0) {
        XB_SPIN(xb_ld(&ctlw[CW_QC(quad)]) < target, b.bar);
        if (next_too) XB_SPIN(xb_ld(&ctlw[CW_QC(quad + 1)]) < 4u, b.bar);
        __builtin_amdgcn_fence(__ATOMIC_ACQUIRE, "agent");
        asm volatile("s_waitcnt vmcnt(0)" ::: "memory");
    }
    __syncthreads();
}
__device__ __forceinline__ void split_wait(const XcdBarrier& b, unsigned* ctlw, int k) {
    if (threadIdx.x == 0) {
        const unsigned nx = b.st[1];
        XB_SPIN(xb_ld(&ctlw[CW_BT(k)]) < nx, b.bar);
        __builtin_amdgcn_fence(__ATOMIC_ACQUIRE, "agent");
        asm volatile("s_waitcnt vmcnt(0)" ::: "memory");
    }
    __syncthreads();
}

__global__ void __launch_bounds__(NWAVES * 64, 2) fwd_kernel(Params p) {
    extern __shared__ __attribute__((aligned(16))) unsigned char lds_raw[];
    LAS unsigned char* lds = (LAS unsigned char*)lds_raw;
    volatile LAS unsigned* MISC = (volatile LAS unsigned*)(lds + MISC_OFF);
    const int tid = threadIdx.x, lane = tid & 63, wave = __builtin_amdgcn_readfirstlane(tid >> 6);
    const int G = gridDim.x; const int bx = blockIdx.x; const int vcu = (G % 8 == 0) ? (bx % 8) * (G / 8) + bx / 8 : bx;
    unsigned char* ws = p.ws;
    gu32* ctl = (gu32*)(ws + WS_CTL);
    for (int u = tid; u < (LDS_BYTES - LDSCTL_OFF) / 4; u += NWAVES * 64) ((LAS unsigned*)(lds + LDSCTL_OFF))[u] = 0u;
    __syncthreads();
    XcdBarrier bar = xcd_barrier_post((unsigned*)(ctl + CW_BAR), MISC + 8);
    if (tid == 0) __hip_atomic_store((unsigned*)ctl + CW_XT + vcu, bar.x + 1u, __ATOMIC_RELAXED, __HIP_MEMORY_SCOPE_AGENT);
    const int lo = p.ph_lo, hi = p.ph_hi;
    unsigned* ctlw = (unsigned*)ctl;
    const int grp = vcu >> 5, quad = vcu >> 2;
#define IN(k) (lo <= (k) && (k) < hi)
#define BOTH(k) (IN(k) && IN((k) + 1))

#if PH_MASK & 1
    if (IN(0)) { p0_prologue(p, lds, vcu, G, wave, lane); if (BOTH(0)) xcd_barrier(bar); }
#endif

#if PH_MASK & (1 << 1)
    if (IN(1)) {
        pg8::Gemm g{(const bf16*)(ws + WS_A), (const bf16*)(ws + WS_W1), MR, NIN, DM}; BatchOrder S; S.init(vcu);
        if (tid < 64) {
            const unsigned xi = xb_ld(&ctlw[CW_XT + 32 * grp + (tid & 31)]), x0 = xb_ld(&ctlw[CW_XT + 32 * grp]);
            const unsigned long long m = __ballot(xi == x0 && x0 != 0u);
            if (tid == 0) MISC[11] = (m == ~0ull) ? 1u : 0u;
        }
        EpiP1 E{(bf16*)(ws + WS_Q), (bf16*)(ws + WS_K), (bf16*)(ws + WS_V), (bf16*)(ws + WS_B), (bf16*)(ws + WS_GA), (bf16*)(ws + WS_GB), (float*)(ws + WS_SQ), p.out, p.in[8], p.in[9], CopyCtx{p.in[2], p.in[3], p.in[4], p.in[5], p.out}};
        {
            const int wk = S.worker();
            if (wk >= 0) late_weights(p, lds, wk, 103, wave, lane);
        }
        __syncthreads();
        pg8::gemm_phase<EpiP1, BatchOrder, true, true>(lds, g, S, E);
        group_barrier(bar, ctlw, MISC, grp, 32u, SB_P1);
    }
#endif

#if PH_MASK & (1 << 2)
    if (IN(2)) {
        attn_phase_mfma(p, lds, vcu, tid, wave, lane);
        split_wait(bar, ctlw, SB_P1);
        if (wave < 6) attn_sample_unit(p, (LAS float*)(lds + 8192 + wave * 1024), wave * 256 + vcu, lane);
        group_barrier(bar, ctlw, MISC, grp, 64u, SB_P2);
    }
#endif
    {
        if (tid == 0) {
            const unsigned x0 = xb_ld(&ctlw[CW_XT + 4 * quad]), x1 = xb_ld(&ctlw[CW_XT + 4 * quad + 1]), x2 = xb_ld(&ctlw[CW_XT + 4 * quad + 2]), x3 = xb_ld(&ctlw[CW_XT + 4 * quad + 3]);
            MISC[10] = (x0 != 0u && x0 == x1 && x1 == x2 && x2 == x3) ? 1u : 0u;
        }
        if (vcu & 1) { conv_phase(p, lds, vcu, tid, wave, lane); merge_phase(p, vcu, tid); }
        else { merge_phase(p, vcu, tid); conv_phase(p, lds, vcu, tid, wave, lane); }
        stage_done(bar, ctlw, MISC, quad, 0);
        if (IN(4)) {
            quad_wait(bar, ctlw, quad, 4u, ((quad + 1) & 7) != 0);
            int k_cat = KC; asm volatile("" : "+s"(k_cat));
            pg8::Gemm g{(const bf16*)(ws + WS_A), (const bf16*)(ws + WS_WCAT), MP, DM, k_cat}; QuadOrder S; S.init(vcu, DM / 256);
            EpiGateF E{(const unsigned char*)(ws + WS_GA), (const unsigned char*)(ws + WS_GB), (bf16*)(ws + WS_B)};
            pg8::gemm_phase<EpiGateF, QuadOrder, true, true>(lds, g, S, E);
            split_wait(bar, ctlw, 0);
            split_wait(bar, ctlw, SB_P2);
            thin_stage<0>(p, lds, vcu, tid, wave, lane);
            thin_stage<1>(p, lds, vcu, tid, wave, lane);
            stage_done(bar, ctlw, MISC, quad, 1);
        }
        if (IN(6)) {
            quad_wait(bar, ctlw, quad, 8u, false);
            pg8::Gemm g{(const bf16*)(ws + WS_B), (const bf16*)(ws + WS_WOUT), MP, DM, DM}; QuadOrder S; S.init(vcu, DM / 256);
            EpiX1 E{p.in[0], p.in[1], p.out, (bf16*)(ws + WS_X1B), (float*)(ws + WS_SS)};
            pg8::gemm_phase<EpiX1, QuadOrder, true, true>(lds, g, S, E);
            split_wait(bar, ctlw, 1);
            thin_stage<2>(p, lds, vcu, tid, wave, lane);
            stage_done(bar, ctlw, MISC, quad, 2);
        }
        if (IN(7)) {
            quad_wait(bar, ctlw, quad, 12u, false);
            pg8::Gemm g{(const bf16*)(ws + WS_X1B), (const bf16*)(ws + WS_WGU), MP, NGU, DM}; QuadOrder S; S.init(vcu, NGU / 256);
            EpiAct E{(const float*)(ws + WS_SS), (bf16*)(ws + WS_ACT), CopyCtx{p.in[2], p.in[3], p.in[4], p.in[5], p.out}};
            pg8::gemm_phase<EpiAct, QuadOrder, true, true>(lds, g, S, E);
            split_wait(bar, ctlw, 2);
            thin_stage<3>(p, lds, vcu, tid, wave, lane);
            stage_done(bar, ctlw, MISC, quad, 3);
        }
        if (IN(8)) {
            quad_wait(bar, ctlw, quad, 16u, false);
            pg8::Gemm g{(const bf16*)(ws + WS_ACT), (const bf16*)(ws + WS_WD), MP, DM, DFF}; QuadOrder S; S.init(vcu, DM / 256);
            EpiOut E{p.out, (const bf16*)(ws + WS_X1B)};
            pg8::gemm_phase<EpiOut, QuadOrder, true, true>(lds, g, S, E);
            split_wait(bar, ctlw, 3);
            thin_stage<4>(p, lds, vcu, tid, wave, lane);
        }
    }
#undef IN
#undef BOTH
}

extern "C" void kernel_launch(void* const* d_in, const int* in_sizes, int n_in, void* d_out, int out_size, void* d_ws, size_t ws_size, hipStream_t stream) {
    static int grid = 0;
    if (grid == 0) {
        if (n_in != 20 || (size_t)out_size != O_TOTAL || ws_size < WS_END) { fprintf(stderr, "kernel_launch: unexpected sizes n_in %d out %d ws %zu\n", n_in, out_size, ws_size); grid = -1; return; }
        int dev = 0, cus = 0, per_cu = 0;
        if (hipGetDevice(&dev) != hipSuccess || hipDeviceGetAttribute(&cus, hipDeviceAttributeMultiprocessorCount, dev) != hipSuccess) { grid = -1; return; }
        if (hipFuncSetAttribute((const void*)fwd_kernel, hipFuncAttributeMaxDynamicSharedMemorySize, LDS_BYTES) != hipSuccess) { fprintf(stderr, "kernel_launch: hipFuncSetAttribute failed\n"); grid = -1; return; }
        if (hipOccupancyMaxActiveBlocksPerMultiprocessor(&per_cu, (const void*)fwd_kernel, NWAVES * 64, LDS_BYTES) != hipSuccess || per_cu < 1)
            fprintf(stderr, "kernel_launch: occupancy query reports %d\n", per_cu);
        (void)hipGetLastError();
        if (cus < 256) { fprintf(stderr, "kernel_launch: needs 256 CUs (one resident workgroup each), device has %d\n", cus); grid = -1; return; }
        grid = 256;
    }
    if (grid < 0) return;
    if (hipMemsetAsync((char*)d_ws + WS_CTL, 0, CTL_ZERO_BYTES, stream) != hipSuccess) return;
    Params a{};
    for (int i = 0; i < 20; ++i) a.in[i] = (const float*)d_in[i];
    a.out = (float*)d_out; a.ws = (unsigned char*)d_ws; a.ph_lo = 0; a.ph_hi = 16;
    hipLaunchKernelGGL(fwd_kernel, dim3(grid), dim3(NWAVES * 64), LDS_BYTES, stream, a);
}
```

```cpp
#include <hip/hip_runtime.h>
#include <cstdio>
#include <cstdint>
namespace pg8 {
#define PG8_LAS __attribute__((address_space(3)))
typedef unsigned short bf16_t;
typedef short bf16x8 __attribute__((ext_vector_type(8)));
typedef float f32x4 __attribute__((ext_vector_type(4)));
typedef unsigned u32x4 __attribute__((ext_vector_type(4)));
constexpr int BM = 256, BK = 64, HALF = 128, HTB = HALF * BK * 2  , STAGE_BYTES = 8 * HTB, NXCD = 8, WGM = 8;

__host__ __device__ __forceinline__ int lds_byte(int r, int c) { const int st = (r >> 4) * 2 + (c >> 5), rr = r & 15, cc = c & 31, ob = rr * 64 + cc * 2; return st * 1024 + (ob ^ (((ob >> 9) & 1) << 5)); }
__host__ __device__ __forceinline__ void stage_rc(int b, int& R, int& C) { const int st = b / 1024, sb = b % 1024, swz = sb ^ (((sb >> 9) & 1) << 5); R = (st >> 1) * 16 + swz / 64; C = (st & 1) * 32 + (swz % 64) / 2; }
__host__ __device__ __forceinline__ int perm32(int rho) { const int n = rho >> 4, i = rho & 15; return 8 * (i >> 2) + 4 * n + (i & 3); }

struct Unit { int pm, pn; };
struct Gemm { const bf16_t* A; const bf16_t* Bt; int M, N, K; };

struct StaticOrder {
    int nM, nN, nwg, G, c;
    __host__ __device__ void init(int M, int N, int G_, int c_) { nM = M / BM; nN = N / BM; nwg = nM * nN; G = G_; c = c_; }
    __host__ __device__ bool next(int i, Unit& u) const {
        const long L = (long)i * G + c; if (L >= nwg) return false;
        int wgid = (int)L; { const int q = nwg / NXCD, r = nwg % NXCD, xcd = wgid % NXCD, off = wgid / NXCD; wgid = (xcd < r ? xcd * (q + 1) : r * (q + 1) + (xcd - r) * q) + off; }
        const int nig = WGM * nN, gid = wgid / nig, fm = gid * WGM, gsz = (nM - fm) < WGM ? (nM - fm) : WGM;
        u.pm = fm + ((wgid % nig) % gsz); u.pn = (wgid % nig) / gsz; return true;
    }
    __device__ __forceinline__ void a_ready(const Unit&) const {}
    __device__ __forceinline__ void done(const Unit&) const {}
};
typedef float f32x2_cv __attribute__((ext_vector_type(2))); typedef __bf16 bf16x2_cv __attribute__((ext_vector_type(2)));
__device__ __forceinline__ unsigned cvt_pk_bf16(float lo, float hi) { f32x2_cv v = {lo, hi}; bf16x2_cv b = __builtin_convertvector(v, bf16x2_cv); return __builtin_bit_cast(unsigned, b); }
typedef float f32x2 __attribute__((ext_vector_type(2)));
template <class Epi, class Sched, bool ALIGN_EPI = false, bool SP2 = false>
__device__ __forceinline__ void gemm_phase(PG8_LAS unsigned char* lds, const Gemm g, const Sched& S, const Epi& E) {
    const int tid = threadIdx.x, wid = __builtin_amdgcn_readfirstlane(tid >> 6), lane = tid & 63, wr = wid >> 2, wc = wid & 3, fr = lane & 15, fq = lane >> 4;
    const int K = g.K, nt = K / BK;
    unsigned voffA[2], voffB[2];
#pragma unroll
    for (int i = 0; i < 2; ++i) { int R, C; stage_rc(tid * 16 + i * 8192, R, C); const int Rb = Epi::PERM ? ((R & ~31) + perm32(R & 31)) : R;
        voffA[i] = (unsigned)(R * K + C) * 2u; voffB[i] = (unsigned)(Rb * K + C) * 2u; }
    const size_t kstep = (size_t)(BK * 2);
    const size_t hstep = (size_t)HALF * K * 2;
    const size_t tstep = 2 * hstep;
    const unsigned ldsw = (unsigned)wid * 1024u;
    const int aoff = lds_byte(wr * 64 + fr, fq * 8), boff = lds_byte(wc * 32 + fr, fq * 8);
#define PG8_SA(b, h) (((b) * 2 + (h)) * HTB)
#define PG8_SB(b, h) ((4 + (b) * 2 + (h)) * HTB)
#define PG8_STAGE(bufoff, gbase, voff) do { _Pragma("unroll") for (int _i = 0; _i < 2; ++_i) \
        __builtin_amdgcn_global_load_lds((const unsigned*)((const char*)(gbase) + (voff)[_i]), (PG8_LAS unsigned*)(lds + (bufoff) + ldsw + _i * 8192), 16, 0, 0); } while (0)
#define PG8_LDA(dst, b, h) do { _Pragma("unroll") for (int m = 0; m < 4; ++m) _Pragma("unroll") for (int k = 0; k < 2; ++k) dst[m][k] = *(const PG8_LAS bf16x8*)(lds + PG8_SA(b, h) + aoff + m * 2048 + k * 1024); } while (0)
#define PG8_LDB(dst, b, h) do { _Pragma("unroll") for (int n = 0; n < 2; ++n) _Pragma("unroll") for (int k = 0; k < 2; ++k) dst[n][k] = *(const PG8_LAS bf16x8*)(lds + PG8_SB(b, h) + boff + n * 2048 + k * 1024); } while (0)
#define PG8_MMA(ai, bj, At, Bt) do { __builtin_amdgcn_s_setprio(1); _Pragma("unroll") for (int m = 0; m < 4; ++m) _Pragma("unroll") for (int n = 0; n < 2; ++n) _Pragma("unroll") for (int k = 0; k < 2; ++k) \
        acc[ai][bj][m][n] = __builtin_amdgcn_mfma_f32_16x16x32_bf16(Bt[n][k], At[m][k], acc[ai][bj][m][n], 0, 0, 0); __builtin_amdgcn_s_setprio(0); } while (0)
#define PG8_WAIT_V(n) asm volatile("s_waitcnt vmcnt(" #n ")" ::: "memory")
#define PG8_WAIT_L(n) asm volatile("s_waitcnt lgkmcnt(" #n ")" ::: "memory")
#define PG8_BAR __builtin_amdgcn_s_barrier()
#define PG8_SCHED __builtin_amdgcn_sched_barrier(0)
    Unit cur, nxt; int ui = 0;
    if (!S.next(0, cur)) return;
    f32x4 acc[2][2][4][2];
#pragma unroll
    for (int a = 0; a < 2; ++a)
#pragma unroll
        for (int b = 0; b < 2; ++b)
#pragma unroll
            for (int m = 0; m < 4; ++m)
#pragma unroll
                for (int n = 0; n < 2; ++n) acc[a][b][m][n] = (f32x4){0.f, 0.f, 0.f, 0.f};
    bf16x8 At[4][2], B0[2][2], B1[2][2];
    const char* cA = (const char*)g.A + (size_t)cur.pm * tstep; const char* cB = (const char*)g.Bt + (size_t)cur.pn * tstep;
    S.a_ready(cur);
    if constexpr (SP2) {
        PG8_STAGE(PG8_SB(0, 0), cB, voffB); PG8_STAGE(PG8_SB(0, 1), cB + hstep, voffB); PG8_STAGE(PG8_SA(0, 0), cA, voffA); PG8_STAGE(PG8_SA(0, 1), cA + hstep, voffA);
        if (wr == 1) PG8_BAR;
        PG8_WAIT_V(2); PG8_BAR;
        PG8_STAGE(PG8_SB(1, 0), cB + kstep, voffB); PG8_STAGE(PG8_SA(1, 0), cA + kstep, voffA); PG8_STAGE(PG8_SB(1, 1), cB + hstep + kstep, voffB);
        PG8_WAIT_V(6); PG8_BAR;
    } else {
        PG8_STAGE(PG8_SB(0, 0), cB, voffB); PG8_STAGE(PG8_SA(0, 0), cA, voffA); PG8_STAGE(PG8_SB(0, 1), cB + hstep, voffB); PG8_STAGE(PG8_SA(0, 1), cA + hstep, voffA);
        if (wr == 1) PG8_BAR;
        PG8_WAIT_V(4); PG8_BAR;
        PG8_STAGE(PG8_SB(1, 0), cB + kstep, voffB); PG8_STAGE(PG8_SA(1, 0), cA + kstep, voffA); PG8_STAGE(PG8_SB(1, 1), cB + hstep + kstep, voffB);
        PG8_WAIT_V(6); PG8_BAR;
    }
    for (;;) {
        const bool has_next = S.next(ui + 1, nxt);
        const char* nA = has_next ? (const char*)g.A + (size_t)nxt.pm * tstep : cA; const char* nB = has_next ? (const char*)g.Bt + (size_t)nxt.pn * tstep : cB;
        if constexpr (Epi::HAS_MID) {
            int tmid = Epi::MID_T; asm volatile("" : "+s"(tmid));
#pragma unroll 1
            for (int t = 0; t < tmid; t += 2) {
            { const bool last = false;
            asm volatile("" : "+s"(cA), "+s"(cB));
            const char* a1 = cA + (size_t)(t + 1) * kstep;
            const char* a2 = last ? nA : cA + (size_t)(t + 2) * kstep; const char* b2 = last ? nB : cB + (size_t)(t + 2) * kstep;
            const char* a3 = a2 + kstep; const char* b3 = b2 + kstep;
            if (last && has_next) S.a_ready(nxt);
            PG8_LDB(B0, 0, 0); PG8_LDB(B1, 0, 1); PG8_SCHED; PG8_LDA(At, 0, 0); PG8_STAGE(PG8_SA(1, 1), a1 + hstep, voffA);
            PG8_WAIT_V(8); PG8_WAIT_L(0); PG8_BAR; PG8_MMA(0, 0, At, B0); PG8_MMA(0, 1, At, B1); PG8_BAR; PG8_SCHED;
            PG8_LDA(At, 0, 1); PG8_STAGE(PG8_SB(0, 0), b2, voffB); PG8_STAGE(PG8_SB(0, 1), b2 + hstep, voffB); PG8_STAGE(PG8_SA(0, 0), a2, voffA);
            PG8_WAIT_V(8); PG8_WAIT_L(0); PG8_BAR; PG8_MMA(1, 0, At, B0); PG8_MMA(1, 1, At, B1); PG8_BAR; PG8_SCHED;
            PG8_LDB(B0, 1, 0); PG8_LDB(B1, 1, 1); PG8_SCHED; PG8_LDA(At, 1, 0); PG8_STAGE(PG8_SA(0, 1), a2 + hstep, voffA);
            PG8_WAIT_V(8); PG8_WAIT_L(0); PG8_BAR; PG8_MMA(0, 0, At, B0); PG8_MMA(0, 1, At, B1); PG8_BAR; PG8_SCHED;
            PG8_LDA(At, 1, 1); PG8_STAGE(PG8_SB(1, 0), b3, voffB); PG8_STAGE(PG8_SB(1, 1), b3 + hstep, voffB); PG8_STAGE(PG8_SA(1, 0), a3, voffA);
            PG8_WAIT_V(8); PG8_WAIT_L(0); PG8_BAR; PG8_MMA(1, 0, At, B0); PG8_MMA(1, 1, At, B1); PG8_BAR; PG8_SCHED;
            }
            }
            E.mid(acc, cur, wr, wc, fr, fq);
#pragma unroll 1
            for (int t = tmid; t < nt; t += 2) {
            { const bool last = (t == nt - 2);
            asm volatile("" : "+s"(cA), "+s"(cB));
            const char* a1 = cA + (size_t)(t + 1) * kstep;
            const char* a2 = last ? nA : cA + (size_t)(t + 2) * kstep; const char* b2 = last ? nB : cB + (size_t)(t + 2) * kstep;
            const char* a3 = a2 + kstep; const char* b3 = b2 + kstep;
            if (last && has_next) S.a_ready(nxt);
            PG8_LDB(B0, 0, 0); PG8_LDB(B1, 0, 1); PG8_SCHED; PG8_LDA(At, 0, 0); PG8_STAGE(PG8_SA(1, 1), a1 + hstep, voffA);
            PG8_WAIT_V(8); PG8_WAIT_L(0); PG8_BAR; PG8_MMA(0, 0, At, B0); PG8_MMA(0, 1, At, B1); PG8_BAR; PG8_SCHED;
            PG8_LDA(At, 0, 1); PG8_STAGE(PG8_SB(0, 0), b2, voffB); PG8_STAGE(PG8_SB(0, 1), b2 + hstep, voffB); PG8_STAGE(PG8_SA(0, 0), a2, voffA);
            PG8_WAIT_V(8); PG8_WAIT_L(0); PG8_BAR; PG8_MMA(1, 0, At, B0); PG8_MMA(1, 1, At, B1); PG8_BAR; PG8_SCHED;
            PG8_LDB(B0, 1, 0); PG8_LDB(B1, 1, 1); PG8_SCHED; PG8_LDA(At, 1, 0); PG8_STAGE(PG8_SA(0, 1), a2 + hstep, voffA);
            PG8_WAIT_V(8); PG8_WAIT_L(0); PG8_BAR; PG8_MMA(0, 0, At, B0); PG8_MMA(0, 1, At, B1); PG8_BAR; PG8_SCHED;
            PG8_LDA(At, 1, 1); PG8_STAGE(PG8_SB(1, 0), b3, voffB); PG8_STAGE(PG8_SB(1, 1), b3 + hstep, voffB); PG8_STAGE(PG8_SA(1, 0), a3, voffA);
            PG8_WAIT_V(8); PG8_WAIT_L(0); PG8_BAR; PG8_MMA(1, 0, At, B0); PG8_MMA(1, 1, At, B1); PG8_BAR; PG8_SCHED;
            }
            }
        } else
        for (int t = 0; t < nt; t += 2) {
            const bool last = (t == nt - 2);
            const char* a1 = cA + (size_t)(t + 1) * kstep;
            const char* a2 = last ? nA : cA + (size_t)(t + 2) * kstep; const char* b2 = last ? nB : cB + (size_t)(t + 2) * kstep;
            const char* a3 = a2 + kstep; const char* b3 = b2 + kstep;
            if (last && has_next) S.a_ready(nxt);
            if constexpr (SP2) {
            PG8_LDB(B0, 0, 0); PG8_LDB(B1, 0, 1); PG8_SCHED; PG8_LDA(At, 0, 0); PG8_STAGE(PG8_SA(1, 1), a1 + hstep, voffA);
            PG8_WAIT_V(8); PG8_WAIT_L(0); PG8_BAR; PG8_MMA(0, 0, At, B0); PG8_MMA(0, 1, At, B1); PG8_BAR; PG8_SCHED;
            PG8_LDA(At, 0, 1); PG8_STAGE(PG8_SB(0, 0), b2, voffB); PG8_STAGE(PG8_SB(0, 1), b2 + hstep, voffB); PG8_STAGE(PG8_SA(0, 0), a2, voffA);
            PG8_WAIT_V(8); PG8_WAIT_L(0); PG8_BAR; PG8_MMA(1, 0, At, B0); PG8_MMA(1, 1, At, B1); PG8_BAR; PG8_SCHED;
            PG8_LDB(B0, 1, 0); PG8_LDB(B1, 1, 1); PG8_SCHED; PG8_LDA(At, 1, 0); PG8_STAGE(PG8_SA(0, 1), a2 + hstep, voffA);
            PG8_WAIT_V(8); PG8_WAIT_L(0); PG8_BAR; PG8_MMA(0, 0, At, B0); PG8_MMA(0, 1, At, B1); PG8_BAR; PG8_SCHED;
            PG8_LDA(At, 1, 1); PG8_STAGE(PG8_SB(1, 0), b3, voffB); PG8_STAGE(PG8_SB(1, 1), b3 + hstep, voffB); PG8_STAGE(PG8_SA(1, 0), a3, voffA);
            PG8_WAIT_V(8); PG8_WAIT_L(0); PG8_BAR; PG8_MMA(1, 0, At, B0); PG8_MMA(1, 1, At, B1); PG8_BAR; PG8_SCHED;
            } else {
            PG8_LDB(B0, 0, 0); PG8_SCHED; PG8_LDA(At, 0, 0); PG8_STAGE(PG8_SA(1, 1), a1 + hstep, voffA);
            PG8_WAIT_L(8); PG8_BAR; PG8_WAIT_L(0); PG8_MMA(0, 0, At, B0); PG8_BAR; PG8_SCHED;
            PG8_LDB(B1, 0, 1); PG8_STAGE(PG8_SB(0, 0), b2, voffB);
            PG8_BAR; PG8_WAIT_L(0); PG8_MMA(0, 1, At, B1); PG8_BAR;
            PG8_LDA(At, 0, 1); PG8_STAGE(PG8_SA(0, 0), a2, voffA);
            PG8_BAR; PG8_WAIT_L(0); PG8_MMA(1, 0, At, B0); PG8_BAR; PG8_SCHED;
            PG8_STAGE(PG8_SB(0, 1), b2 + hstep, voffB);
            PG8_WAIT_V(6); PG8_BAR; PG8_MMA(1, 1, At, B1); PG8_BAR;
            PG8_LDB(B0, 1, 0); PG8_SCHED; PG8_LDA(At, 1, 0); PG8_STAGE(PG8_SA(0, 1), a2 + hstep, voffA);
            PG8_WAIT_L(8); PG8_BAR; PG8_WAIT_L(0); PG8_MMA(0, 0, At, B0); PG8_BAR; PG8_SCHED;
            PG8_LDB(B1, 1, 1); PG8_STAGE(PG8_SB(1, 0), b3, voffB);
            PG8_BAR; PG8_WAIT_L(0); PG8_MMA(0, 1, At, B1); PG8_BAR;
            PG8_LDA(At, 1, 1); PG8_STAGE(PG8_SA(1, 0), a3, voffA);
            PG8_BAR; PG8_WAIT_L(0); PG8_MMA(1, 0, At, B0); PG8_BAR; PG8_SCHED;
            PG8_STAGE(PG8_SB(1, 1), b3 + hstep, voffB);
            PG8_WAIT_V(6); PG8_BAR; PG8_MMA(1, 1, At, B1); PG8_BAR;
            }
        }
        if constexpr (ALIGN_EPI) { if (wr == 0) PG8_BAR; }
        if constexpr (!Epi::AFTER_DRAIN) { E(acc, cur, wr, wc, fr, fq); S.done(cur); }
        if (!has_next) break;
#pragma unroll
        for (int a = 0; a < 2; ++a)
#pragma unroll
            for (int b = 0; b < 2; ++b)
#pragma unroll
                for (int m = 0; m < 4; ++m)
#pragma unroll
                    for (int n = 0; n < 2; ++n) acc[a][b][m][n] = (f32x4){0.f, 0.f, 0.f, 0.f};
        cur = nxt; cA = nA; cB = nB; ++ui;
        if constexpr (ALIGN_EPI) { if (wr == 1) PG8_BAR; }
    }
    PG8_WAIT_V(0);
    if constexpr (!ALIGN_EPI) { if (wr == 0) PG8_BAR; }
    PG8_BAR;
    if constexpr (Epi::AFTER_DRAIN) { E.fused(acc, cur, wr, wc, fr, fq, lds, wid, lane); S.done(cur); }
#undef PG8_SA
#undef PG8_SB
#undef PG8_STAGE
#undef PG8_LDA
#undef PG8_LDB
#undef PG8_MMA
#undef PG8_WAIT_V
#undef PG8_WAIT_L
#undef PG8_BAR
#undef PG8_SCHED
}
}
#define GAS __attribute__((address_space(1)))
#define LAS __attribute__((address_space(3)))
typedef unsigned short bf16;
typedef unsigned v4u __attribute__((ext_vector_type(4)));
typedef float f32x4 __attribute__((ext_vector_type(4)));
typedef short bf16x8 __attribute__((ext_vector_type(8)));
typedef GAS unsigned gu32;
typedef GAS unsigned long long gu64;
#define RLX_AGENT __ATOMIC_RELAXED, __HIP_MEMORY_SCOPE_AGENT
#define LDS_WAIT() asm volatile("s_waitcnt lgkmcnt(0)" ::: "memory")
#define VM_WAIT() asm volatile("s_waitcnt vmcnt(0)" ::: "memory")
__device__ __forceinline__ unsigned long long rt() { return __builtin_amdgcn_s_memrealtime(); }
__device__ __forceinline__ unsigned f2bf(float f) { unsigned u = __builtin_bit_cast(unsigned, f); return (u + 0x7fffu + ((u >> 16) & 1u)) >> 16; }
__device__ __forceinline__ unsigned pk2(float lo, float hi) { return f2bf(lo) | (f2bf(hi) << 16); }

#define XB_TMO      128
#define XB_XCNT(j)  (256  + 64 * (j))
#define XB_XSUB(j)  (1280 + 64 * (j))
#define XB_XGEN(j)  (2304 + 64 * (j))
#define XB_TOP      3328
#define XB_TOPGEN   3392
#define XCD_BAR_WORDS 3456
#define XB_SPIN_CAP (1u << 18)

__device__ __forceinline__ unsigned xb_ld(unsigned* p)              { return __hip_atomic_load(p, __ATOMIC_RELAXED, __HIP_MEMORY_SCOPE_AGENT); }
__device__ __forceinline__ unsigned xb_add(unsigned* p, unsigned v) { return __hip_atomic_fetch_add(p, v, __ATOMIC_RELAXED, __HIP_MEMORY_SCOPE_AGENT); }
__device__ __forceinline__ unsigned xb_xcc_id() { return (unsigned)__builtin_amdgcn_s_getreg((3 << 11) | 20) & 0xFu; }
#define XB_SPIN(cond, bar) do { unsigned _sp = 0; while (cond) { __builtin_amdgcn_s_sleep(1); \
    if ((++_sp & 255u) == 0u) { if (xb_ld(&(bar)[XB_TMO])) break; if (_sp > XB_SPIN_CAP) { atomicAdd(&(bar)[XB_TMO], 1u); break; } } } } while (0)

struct XcdBarrier {
    unsigned* bar; unsigned x;
    volatile LAS unsigned* st;
};

__device__ __forceinline__ XcdBarrier xcd_barrier_post(unsigned* bar, volatile LAS unsigned* st) {
    XcdBarrier b; b.bar = bar; b.x = xb_xcc_id(); b.st = st;
    if (threadIdx.x == 0) (void)xb_add(&bar[XB_XCNT(b.x)], 1u);
    return b;
}
__device__ __forceinline__ void xcd_barrier_complete(unsigned* bar, unsigned x, unsigned& nloc, unsigned& nx) {
    const unsigned G = gridDim.x * gridDim.y * gridDim.z;
    unsigned sum, cnt, mine, sp = 0u;
    for (;;) {
        sum = 0u; cnt = 0u; mine = 0u;
#pragma unroll
        for (unsigned j = 0; j < 16; ++j) { const unsigned c = xb_ld(&bar[XB_XCNT(j)]); sum += c; cnt += (c > 0u) ? 1u : 0u; mine = (j == x) ? c : mine; }
        if (sum == G) break;
        __builtin_amdgcn_s_sleep(1);
        if ((++sp & 255u) == 0u) { if (xb_ld(&bar[XB_TMO])) break; if (sp > XB_SPIN_CAP) { atomicAdd(&bar[XB_TMO], 1u); break; } }
    }
    nloc = mine > 0u ? mine : 1u; nx = cnt > 0u ? cnt : 1u;
}

__device__ __forceinline__ void xcd_barrier(const XcdBarrier& b) {
    asm volatile("s_waitcnt vmcnt(0)" ::: "memory");
    __syncthreads();
    if (threadIdx.x == 0) {
        unsigned* bar = b.bar;
        __builtin_amdgcn_s_waitcnt(0);
        unsigned nloc = b.st[0], nx = b.st[1];
        if (nloc == 0u) { xcd_barrier_complete(bar, b.x, nloc, nx); b.st[0] = nloc; b.st[1] = nx; }
        const unsigned old = xb_add(&bar[XB_XSUB(b.x)], 1u);
        const unsigned gen = old / nloc;
        if (old + 1u == (gen + 1u) * nloc) {
            __builtin_amdgcn_fence(__ATOMIC_RELEASE, "agent");
            asm volatile("s_waitcnt vmcnt(0)" ::: "memory");
            const unsigned og = xb_add(&bar[XB_TOP], 1u);
            const unsigned tg = og / nx;
            if (og + 1u == (tg + 1u) * nx) xb_add(&bar[XB_TOPGEN], 1u);
            else XB_SPIN(xb_ld(&bar[XB_TOPGEN]) == tg, bar);
            __builtin_amdgcn_fence(__ATOMIC_ACQUIRE, "agent");
            xb_add(&bar[XB_XGEN(b.x)], 1u);
            asm volatile("s_waitcnt vmcnt(0)" ::: "memory");
        } else {
            XB_SPIN(xb_ld(&bar[XB_XGEN(b.x)]) == gen, bar);
            __builtin_amdgcn_fence(__ATOMIC_ACQUIRE, "agent");
            asm volatile("s_waitcnt vmcnt(0)" ::: "memory");
        }
    }
    __syncthreads();
}

#ifndef PH_MASK
#define PH_MASK 0x1ff
#endif
constexpr int DM = 1024, NB = 8, SEQ = 4096, MP = NB * SEQ;
constexpr int SB = 32, SS_ = 4, MS = SB * SS_, MV = MP + MS;
constexpr int MR = 129 * 256;
constexpr int NIN = 6400, DFF = 2816, NGU = 2 * DFF, DAO = 256;
constexpr float RMS_EPS = 1e-6f, LN_EPS = 1e-5f;
constexpr int NWAVES = 8;

constexpr size_t O_Y = 0;
constexpr size_t O_KVP0 = 33685504, O_KVS0 = 34209792, O_KVP1 = 36306944, O_KVS1 = 38404096, O_KVP2 = 46792704, O_KVS2 = 55181312;
constexpr size_t O_CONVP = 88735744, O_CONVS = 88981504, O_TOTAL = 89964544;

constexpr size_t MiB = 1u << 20;
constexpr size_t WS_CTL = 0, CTL_ZERO_BYTES = 32768;
constexpr size_t WS_W1 = 1 * MiB;
constexpr size_t WS_WCAT = 14 * MiB;
constexpr size_t WS_WOUT = 17 * MiB;
constexpr size_t WS_WGU = 19 * MiB;
constexpr size_t WS_WD = 30 * MiB;
constexpr int KC = 1280;
constexpr size_t WS_A = 36 * MiB;
constexpr size_t WS_B = 117 * MiB;
constexpr size_t WS_GA = 182 * MiB, WS_GB = WS_GA + 1024;
constexpr int GP = 2048;
constexpr size_t WS_X1B = WS_GA;
constexpr size_t WS_Q = 248 * MiB, WS_K = 296 * MiB, WS_V = 344 * MiB;
constexpr size_t WS_OG = 392 * MiB;
constexpr size_t WS_LSE = 441 * MiB;
constexpr size_t WS_SS = 443 * MiB;
constexpr size_t WS_SQ = 446 * MiB;
constexpr size_t WS_SSS = 447 * MiB;
constexpr size_t WS_ACT = 248 * MiB;
constexpr size_t WS_END = 448 * MiB;
constexpr int CW_BAR = 4096;

constexpr int RING_BYTES = 131072, LDSCTL_OFF = RING_BYTES, MISC_OFF = LDSCTL_OFF + 320, LDS_BYTES = 147456;

typedef unsigned u32x4 __attribute__((ext_vector_type(4)));
typedef unsigned u32x2 __attribute__((ext_vector_type(2)));

struct Params {
    const float* in[20];
    float* out;
    unsigned char* ws;
    int ph_lo, ph_hi;
};

__device__ __forceinline__ float sigmoidf_(float x) { return __builtin_amdgcn_rcpf(1.0f + __expf(-x)); }
__device__ __forceinline__ float wave_sum(float v) {
#pragma unroll
    for (int o = 1; o < 64; o <<= 1) v += __shfl_xor(v, o);
    return v;
}


__device__ __forceinline__ u32x2 qgate8(const f32x4 a, const f32x4 b) {
    unsigned w0 = 0u, w1 = 0u;
    w0 = __builtin_amdgcn_cvt_pk_u8_f32(__builtin_rintf(a[0] * 255.f), 0, w0); w0 = __builtin_amdgcn_cvt_pk_u8_f32(__builtin_rintf(a[1] * 255.f), 1, w0);
    w0 = __builtin_amdgcn_cvt_pk_u8_f32(__builtin_rintf(a[2] * 255.f), 2, w0); w0 = __builtin_amdgcn_cvt_pk_u8_f32(__builtin_rintf(a[3] * 255.f), 3, w0);
    w1 = __builtin_amdgcn_cvt_pk_u8_f32(__builtin_rintf(b[0] * 255.f), 0, w1); w1 = __builtin_amdgcn_cvt_pk_u8_f32(__builtin_rintf(b[1] * 255.f), 1, w1);
    w1 = __builtin_amdgcn_cvt_pk_u8_f32(__builtin_rintf(b[2] * 255.f), 2, w1); w1 = __builtin_amdgcn_cvt_pk_u8_f32(__builtin_rintf(b[3] * 255.f), 3, w1);
    return (u32x2){w0, w1};
}
__device__ __forceinline__ void dqgate8(const u32x2 w, f32x4& a, f32x4& b) {
    constexpr float S = 1.0f / 255.0f;
    a = (f32x4){(float)(w.x & 0xffu) * S, (float)((w.x >> 8) & 0xffu) * S, (float)((w.x >> 16) & 0xffu) * S, (float)(w.x >> 24) * S};
    b = (f32x4){(float)(w.y & 0xffu) * S, (float)((w.y >> 8) & 0xffu) * S, (float)((w.y >> 16) & 0xffu) * S, (float)(w.y >> 24) * S};
}

constexpr int CP_CHUNKS = 5456;
struct CopyCtx { const float* s0; const float* s1; const float* s2; const float* s3; float* out; };
__device__ __forceinline__ void cp_addr(const CopyCtx& c, int chunk, int tid, int j, const GAS f32x4*& src, GAS f32x4*& dst) {
    int base, rows, per, rw; const float* sp; size_t oo;
    if (chunk < 248) { base = 0; rows = 124; per = 128; rw = 128; sp = c.s0; oo = O_KVS0; }
    else if (chunk < 1264) { base = 248; rows = 508; per = 512; rw = 128; sp = c.s1; oo = O_KVS1; }
    else if (chunk < 5352) { base = 1264; rows = 2044; per = 2048; rw = 128; sp = c.s2; oo = O_KVS2; }
    else { base = 5352; rows = 26; per = 30; rw = 256; sp = c.s3; oo = O_CONVS; }
    const int i0 = (chunk - base) * 2048, n4b = rows * rw, b0 = i0 / n4b, r0 = i0 - b0 * n4b;
    int r = r0 + j * 512 + tid, b = b0;
    if (r >= n4b) { r -= n4b; b += 1; }
    const unsigned idx = (unsigned)(b * per * rw + r);
    src = (const GAS f32x4*)sp + idx + 4 * rw;
    dst = (GAS f32x4*)(c.out + oo) + idx;
}
__device__ __forceinline__ void cp_load(const CopyCtx& c, int chunk, int tid, f32x4 (&v)[4]) {
    if (chunk < CP_CHUNKS) {
#pragma unroll
        for (int j = 0; j < 4; ++j) { const GAS f32x4* src; GAS f32x4* dst; cp_addr(c, chunk, tid, j, src, dst); v[j] = __builtin_nontemporal_load(src); }
    }
    __builtin_amdgcn_sched_barrier(0);
}
__device__ __forceinline__ void cp_store(const CopyCtx& c, int chunk, int tid, const f32x4 (&v)[4]) {
    __builtin_amdgcn_sched_barrier(0);
    if (chunk < CP_CHUNKS) {
#pragma unroll
        for (int j = 0; j < 4; ++j) { const GAS f32x4* src; GAS f32x4* dst; cp_addr(c, chunk, tid, j, src, dst); __builtin_nontemporal_store(v[j], dst); }
    }
}

struct EpiP1 {
    static constexpr bool PERM = true, AFTER_DRAIN = false, HAS_MID = false;
    bf16 *Q, *K, *V, *U, *GA, *GB; float* SQ; float* out; const float *qw, *kw; CopyCtx cc;
    __device__ __forceinline__ void operator()(const pg8::f32x4 (&acc)[2][2][4][2], const pg8::Unit& u, int wr, int wc, int fr, int fq) const {
        const int pn = u.pn, row0 = u.pm * 256 + wr * 64 + fr;
        const int cp_chunk = u.pm * 25 + pn, cp_tid = (wr * 4 + wc) * 64 + fq * 16 + fr; f32x4 cpv[4]; cp_load(cc, cp_chunk, cp_tid, cpv);
        if (pn < 9) {
            const int seg = pn / 3, g = pn - 3 * seg, sh = 2 * g, win = 128 << sh, head = wc;
            f32x4 w[2][2];
            const float* nw = (seg == 0) ? qw : kw;
#pragma unroll
            for (int bj = 0; bj < 2; ++bj)
#pragma unroll
                for (int n = 0; n < 2; ++n) w[bj][n] = (seg < 2) ? *(const f32x4*)(nw + 32 * bj + 8 * fq + 4 * n) : (f32x4){1.f, 1.f, 1.f, 1.f};
            const float post = (seg == 0) ? 0.125f * 1.4426950408889634f : 1.0f;
            bf16* dstb = Q + (size_t)seg * ((WS_K - WS_Q) / 2);
            const size_t okp = (g == 0) ? O_KVP0 : (g == 1) ? O_KVP1 : O_KVP2;
            const size_t oks = (g == 0) ? O_KVS0 : (g == 1) ? O_KVS1 : O_KVS2;
#pragma unroll
            for (int ai = 0; ai < 2; ++ai)
#pragma unroll
                for (int m = 0; m < 4; ++m) {
                    const int row = row0 + ai * 128 + m * 16;
                    if (ai == 1 && m == 0) cp_store(cc, cp_chunk, cp_tid, cpv);
                    f32x4 v[2][2];
#pragma unroll
                    for (int bj = 0; bj < 2; ++bj)
#pragma unroll
                        for (int n = 0; n < 2; ++n) v[bj][n] = acc[ai][bj][m][n];
                    if (seg < 2) {
                        float ss = 0.f;
#pragma unroll
                        for (int bj = 0; bj < 2; ++bj)
#pragma unroll
                            for (int n = 0; n < 2; ++n) { const f32x4 x = v[bj][n]; ss += (x[0] * x[0] + x[1] * x[1]) + (x[2] * x[2] + x[3] * x[3]); }
                        ss += __shfl_xor(ss, 16); ss += __shfl_xor(ss, 32);
                        const float rs = __builtin_amdgcn_rsqf(ss * (1.0f / 64.0f) + RMS_EPS) * post;
#pragma unroll
                        for (int bj = 0; bj < 2; ++bj)
#pragma unroll
                            for (int n = 0; n < 2; ++n) v[bj][n] = v[bj][n] * rs * w[bj][n];
                    }
                    if (row < MP) {
                        const int b = row >> 12, t = row & 4095;
                        const int pos = ((t & ((1 << sh) - 1)) << (12 - sh)) + (t >> sh);
                        bf16* d = dstb + ((size_t)((b * 3 + g) * 4 + head) * 4096 + pos) * 64 + 8 * fq;
#pragma unroll
                        for (int bj = 0; bj < 2; ++bj) {
                            u32x4 pk; pk.x = pg8::cvt_pk_bf16(v[bj][0][0], v[bj][0][1]); pk.y = pg8::cvt_pk_bf16(v[bj][0][2], v[bj][0][3]);
                            pk.z = pg8::cvt_pk_bf16(v[bj][1][0], v[bj][1][1]); pk.w = pg8::cvt_pk_bf16(v[bj][1][2], v[bj][1][3]);
                            *(u32x4*)(d + 32 * bj) = pk;
                        }
                        if (seg >= 1 && t >= 4096 - win) {
                            float* o = out + okp + ((size_t)(b * win + (t - (4096 - win))) * 2 + (seg - 1)) * 256 + head * 64 + 8 * fq;
#pragma unroll
                            for (int bj = 0; bj < 2; ++bj)
#pragma unroll
                                for (int n = 0; n < 2; ++n) __builtin_nontemporal_store(v[bj][n], (f32x4*)(o + 32 * bj + 4 * n));
                        }
                    } else if (row < MV) {
                        const int si = row - MP, sb = si >> 2, s = si & 3;
                        float* o = (seg == 0) ? SQ + ((size_t)si * 12 + g * 4 + head) * 64 + 8 * fq
                                              : out + oks + ((size_t)(sb * win + win - 4 + s) * 2 + (seg - 1)) * 256 + head * 64 + 8 * fq;
#pragma unroll
                        for (int bj = 0; bj < 2; ++bj)
#pragma unroll
                            for (int n = 0; n < 2; ++n) *(f32x4*)(o + 32 * bj + 4 * n) = v[bj][n];
                    }
                }
        } else if (pn < 17) {
            const int ch0 = 128 * (pn - 9) + 32 * wc + 8 * fq;
#pragma unroll
            for (int ai = 0; ai < 2; ++ai)
#pragma unroll
                for (int m = 0; m < 4; ++m) {
                    const int row = row0 + ai * 128 + m * 16;
                    if (ai == 1 && m == 0) cp_store(cc, cp_chunk, cp_tid, cpv);
                    f32x4 uu[2];
#pragma unroll
                    for (int n = 0; n < 2; ++n) {
                        const f32x4 a = acc[ai][0][m][n], b = acc[ai][1][m][n];
#pragma unroll
                        for (int i = 0; i < 4; ++i) uu[n][i] = a[i] * sigmoidf_(b[i]);
                    }
                    u32x4 pk; pk.x = pg8::cvt_pk_bf16(uu[0][0], uu[0][1]); pk.y = pg8::cvt_pk_bf16(uu[0][2], uu[0][3]);
                    pk.z = pg8::cvt_pk_bf16(uu[1][0], uu[1][1]); pk.w = pg8::cvt_pk_bf16(uu[1][2], uu[1][3]);
                    *(u32x4*)(U + (size_t)row * DM + ch0) = pk;
                    float* o = nullptr;
                    if (row < MP) { const int b = row >> 12, t = row & 4095; if (t >= 4066) o = out + O_CONVP + ((size_t)(b * 30 + t - 4066)) * DM + ch0; }
                    else if (row < MV) { const int si = row - MP; o = out + O_CONVS + ((size_t)((si >> 2) * 30 + 26 + (si & 3))) * DM + ch0; }
                    if (o) { *(f32x4*)o = uu[0]; *(f32x4*)(o + 4) = uu[1]; }
                }
        } else {
            const int q = pn - 17; unsigned char* G = (unsigned char*)((q >> 2) ? GB : GA);
            const int col0 = 256 * (q & 3) + 32 * wc + 8 * fq;
#pragma unroll
            for (int ai = 0; ai < 2; ++ai)
#pragma unroll
                for (int m = 0; m < 4; ++m) {
                    const int row = row0 + ai * 128 + m * 16;
                    if (ai == 1 && m == 0) cp_store(cc, cp_chunk, cp_tid, cpv);
#pragma unroll
                    for (int bj = 0; bj < 2; ++bj) {
                        f32x4 a = acc[ai][bj][m][0], b = acc[ai][bj][m][1];
#pragma unroll
                        for (int i = 0; i < 4; ++i) { a[i] = sigmoidf_(a[i]); b[i] = sigmoidf_(b[i]); }
                        __builtin_nontemporal_store(qgate8(a, b), (u32x2*)(G + (size_t)row * GP + col0 + 128 * bj));
                    }
                }
        }
    }
};

__device__ __forceinline__ float bf_lo(unsigned w) { return __builtin_bit_cast(float, w << 16); }
__device__ __forceinline__ float bf_hi(unsigned w) { return __builtin_bit_cast(float, w & 0xffff0000u); }
__device__ __forceinline__ void unpack8(const u32x4 w, f32x4& a, f32x4& b) {
    a = (f32x4){bf_lo(w.x), bf_hi(w.x), bf_lo(w.y), bf_hi(w.y)}; b = (f32x4){bf_lo(w.z), bf_hi(w.z), bf_lo(w.w), bf_hi(w.w)};
}
__device__ __forceinline__ u32x4 pack8(const f32x4 a, const f32x4 b) {
    u32x4 pk; pk.x = pg8::cvt_pk_bf16(a[0], a[1]); pk.y = pg8::cvt_pk_bf16(a[2], a[3]); pk.z = pg8::cvt_pk_bf16(b[0], b[1]); pk.w = pg8::cvt_pk_bf16(b[2], b[3]); return pk;
}

__device__ __forceinline__ u32x2 ld8nt(const void* pz) { return __builtin_nontemporal_load((const u32x2*)pz); }
struct EpiGateF {
    static constexpr bool PERM = true, AFTER_DRAIN = false, HAS_MID = true; static constexpr int MID_T = DAO / 64;
    const unsigned char* GA; const unsigned char* GB; bf16* H;
    __device__ __forceinline__ void mid(pg8::f32x4 (&acc)[2][2][4][2], const pg8::Unit& u, int wr, int wc, int fr, int fq) const {
        const int row0 = u.pm * 256 + wr * 64 + fr, col0 = u.pn * 256 + 32 * wc + 8 * fq;
#pragma unroll
        for (int ai = 0; ai < 2; ++ai)
#pragma unroll
            for (int m = 0; m < 4; ++m) {
                const unsigned off = (unsigned)(row0 + ai * 128 + m * 16) * GP + col0;
#pragma unroll
                for (int bj = 0; bj < 2; ++bj) {
                    f32x4 a0, a1, b0, b1; dqgate8(ld8nt(GA + off + 128 * bj), a0, a1); dqgate8(*(const u32x2*)(GB + off + 128 * bj), b0, b1);
#pragma unroll
                    for (int i = 0; i < 4; ++i) {
                        acc[ai][bj][m][0][i] *= a0[i] * __builtin_amdgcn_rcpf(fmaxf(b0[i], 8.6736174e-19f));
                        acc[ai][bj][m][1][i] *= a1[i] * __builtin_amdgcn_rcpf(fmaxf(b1[i], 8.6736174e-19f));
                    }
                }
                if (m & 1) asm volatile("" ::: "memory");
            }
    }
    __device__ __forceinline__ void operator()(const pg8::f32x4 (&acc)[2][2][4][2], const pg8::Unit& u, int wr, int wc, int fr, int fq) const {
        int row0 = u.pm * 256 + wr * 64 + fr, col0 = u.pn * 256 + 32 * wc + 8 * fq;
        asm volatile("" : "+v"(row0), "+v"(col0));
#pragma unroll
        for (int ai = 0; ai < 2; ++ai)
#pragma unroll
            for (int m = 0; m < 4; ++m) {
                const unsigned off = (unsigned)(row0 + ai * 128 + m * 16) * DM + col0, goff = (unsigned)(row0 + ai * 128 + m * 16) * GP + col0;
#pragma unroll
                for (int bj = 0; bj < 2; ++bj) {
                    f32x4 b0, b1; dqgate8(ld8nt(GB + goff + 128 * bj), b0, b1);
#pragma unroll
                    for (int i = 0; i < 4; ++i) { b0[i] = fmaxf(b0[i], 8.6736174e-19f); b1[i] = fmaxf(b1[i], 8.6736174e-19f); }
                    *(u32x4*)(H + off + 128 * bj) = pack8(acc[ai][bj][m][0] * b0, acc[ai][bj][m][1] * b1);
                }
                if (m & 1) asm volatile("" ::: "memory");
            }
    }
};
struct EpiX1 {
    static constexpr bool PERM = true, AFTER_DRAIN = false, HAS_MID = false;
    const float *xp, *xs; float* out; bf16* X1B; float* SS;
    __device__ __forceinline__ void operator()(const pg8::f32x4 (&acc)[2][2][4][2], const pg8::Unit& u, int wr, int wc, int fr, int fq) const {
        const int row0 = u.pm * 256 + wr * 64 + fr, col0 = u.pn * 256 + 32 * wc + 8 * fq;
#pragma unroll
        for (int ai = 0; ai < 2; ++ai) {
            f32x4 xv[4][2][2];
#pragma unroll
            for (int m = 0; m < 4; ++m) {
                const float* xr = xp + (size_t)(row0 + ai * 128 + m * 16) * DM + col0;
#pragma unroll
                for (int bj = 0; bj < 2; ++bj)
#pragma unroll
                    for (int n = 0; n < 2; ++n) xv[m][bj][n] = __builtin_nontemporal_load((const f32x4*)(xr + 128 * bj + 4 * n));
            }
#pragma unroll
            for (int m = 0; m < 4; ++m) {
                const int row = row0 + ai * 128 + m * 16;
                float ss = 0.f;
#pragma unroll
                for (int bj = 0; bj < 2; ++bj) {
                    f32x4 v[2];
#pragma unroll
                    for (int n = 0; n < 2; ++n) {
                        v[n] = xv[m][bj][n] + acc[ai][bj][m][n];
                        ss += (v[n][0] * v[n][0] + v[n][1] * v[n][1]) + (v[n][2] * v[n][2] + v[n][3] * v[n][3]);
                    }
                    *(u32x4*)(X1B + (size_t)row * DM + col0 + 128 * bj) = pack8(v[0], v[1]);
                }
                ss += __shfl_xor(ss, 16); ss += __shfl_xor(ss, 32);
                if (fq == 0) SS[(size_t)row * 16 + u.pn * 4 + wc] = ss;
            }
            asm volatile("" ::: "memory");
        }
    }
};
struct EpiAct {
    static constexpr bool PERM = true, AFTER_DRAIN = false, HAS_MID = false;
    const float* SS; bf16* ACT; CopyCtx cc;
    __device__ __forceinline__ void operator()(const pg8::f32x4 (&acc)[2][2][4][2], const pg8::Unit& u, int wr, int wc, int fr, int fq) const {
        const int row0 = u.pm * 256 + wr * 64 + fr, ch0 = u.pn * 128 + 32 * wc + 8 * fq;
        const int cp_q = u.pm * 22 + u.pn, cp_c0 = (cp_q * (CP_CHUNKS - 3225)) / 2816, cp_c1 = ((cp_q + 1) * (CP_CHUNKS - 3225)) / 2816;
        const int cp_chunk = (cp_c1 != cp_c0) ? 3225 + cp_c0 : CP_CHUNKS, cp_tid = (wr * 4 + wc) * 64 + fq * 16 + fr; f32x4 cpv[4]; cp_load(cc, cp_chunk, cp_tid, cpv);
#pragma unroll
        for (int ai = 0; ai < 2; ++ai)
#pragma unroll
            for (int m = 0; m < 4; ++m) {
                const int row = row0 + ai * 128 + m * 16;
                    if (ai == 1 && m == 0) cp_store(cc, cp_chunk, cp_tid, cpv);
                const f32x4 sv = *((const f32x4*)(SS + (size_t)row * 16) + fq);
                float tot = (sv[0] + sv[1]) + (sv[2] + sv[3]);
                tot += __shfl_xor(tot, 16); tot += __shfl_xor(tot, 32);
                const float rstd = __builtin_amdgcn_rsqf(tot * (1.0f / DM) + RMS_EPS);
                f32x4 a[2];
#pragma unroll
                for (int n = 0; n < 2; ++n)
#pragma unroll
                    for (int i = 0; i < 4; ++i) { const float g = acc[ai][0][m][n][i] * rstd, up = acc[ai][1][m][n][i] * rstd; a[n][i] = g * sigmoidf_(g) * up; }
                *(u32x4*)(ACT + (size_t)row * DFF + ch0) = pack8(a[0], a[1]);
            }
    }
};
struct EpiOut {
    static constexpr bool PERM = true, AFTER_DRAIN = false, HAS_MID = false;
    float* out; const bf16* X1B;
    __device__ __forceinline__ void operator()(const pg8::f32x4 (&acc)[2][2][4][2], const pg8::Unit& u, int wr, int wc, int fr, int fq) const {
        const int row0 = u.pm * 256 + wr * 64 + fr, col0 = u.pn * 256 + 32 * wc + 8 * fq;
#pragma unroll
        for (int ai = 0; ai < 2; ++ai)
#pragma unroll
            for (int m = 0; m < 4; ++m) {
                const int row = row0 + ai * 128 + m * 16;
                float* o = out + (size_t)row * DM + col0;
#pragma unroll
                for (int bj = 0; bj < 2; ++bj) {
                    f32x4 xa, xb; unpack8(__builtin_nontemporal_load((const u32x4*)(X1B + (size_t)row * DM + col0 + 128 * bj)), xa, xb);
                    __builtin_nontemporal_store(xa + acc[ai][bj][m][0], (f32x4*)(o + 128 * bj)); __builtin_nontemporal_store(xb + acc[ai][bj][m][1], (f32x4*)(o + 128 * bj + 4));
                }
            }
    }
};

__device__ __forceinline__ void attn_sample_unit(const Params& p, LAS float* sS, int it, int lane) {
    unsigned char* ws = p.ws;
    const int h = it & 3, g = (it >> 2) % 3, si = it / 12, b = si >> 2, s = si & 3, sh = 2 * g, win = 128 << sh;
    const float* cache = p.in[2 + g];
    const float* newr = p.out + ((g == 0) ? O_KVS0 : (g == 1) ? O_KVS1 : O_KVS2);
    const f32x4* qp = (const f32x4*)((const float*)(ws + WS_SQ) + ((size_t)si * 12 + g * 4 + h) * 64);
    const float* kr[2];
#pragma unroll
    for (int c = 0; c < 2; ++c) {
        const int idx = win + s - ((lane + 64 * c) << sh);
        kr[c] = (idx < win) ? cache + (size_t)(b * win + idx) * 512 + h * 64 : newr + (size_t)(b * win + idx - 4) * 512 + h * 64;
    }
    f32x4 kv[2][16];
#pragma unroll
    for (int c = 0; c < 2; ++c)
#pragma unroll
        for (int c16 = 0; c16 < 16; ++c16) kv[c][c16] = *((const f32x4*)kr[c] + c16);
    const f32x4 k128 = *((const f32x4*)(cache + (size_t)(b * win + s) * 512 + h * 64) + (lane & 15));
    float d[2];
#pragma unroll
    for (int c = 0; c < 2; ++c) {
        float a0 = 0.f, a1 = 0.f;
#pragma unroll
        for (int c16 = 0; c16 < 16; c16 += 2) {
            const f32x4 pa = kv[c][c16] * qp[c16], pb = kv[c][c16 + 1] * qp[c16 + 1];
            a0 += (pa[0] + pa[1]) + (pa[2] + pa[3]); a1 += (pb[0] + pb[1]) + (pb[2] + pb[3]);
        }
        d[c] = a0 + a1;
    }
    float d2;
    { const f32x4 pa = k128 * qp[lane & 15]; d2 = (pa[0] + pa[1]) + (pa[2] + pa[3]); d2 += __shfl_xor(d2, 1); d2 += __shfl_xor(d2, 2); d2 += __shfl_xor(d2, 4); d2 += __shfl_xor(d2, 8); }
    float mx = fmaxf(fmaxf(d[0], d[1]), d2);
#pragma unroll
    for (int o = 1; o < 64; o <<= 1) mx = fmaxf(mx, __shfl_xor(mx, o));
    const float p0 = __builtin_amdgcn_exp2f(d[0] - mx), p1 = __builtin_amdgcn_exp2f(d[1] - mx), p2 = __builtin_amdgcn_exp2f(d2 - mx);
    sS[lane] = p0; sS[lane + 64] = p1; if (lane == 0) sS[128] = p2;
    const float p2b = __builtin_bit_cast(float, __builtin_amdgcn_readfirstlane(__builtin_bit_cast(int, p2)));
    const float l = wave_sum(p0 + p1) + p2b;
    LDS_WAIT();
    const int kg = lane >> 4, dc = lane & 15;
    const size_t voff = (size_t)h * 64 + 4 * dc + 256;
    f32x4 vv[33];
#pragma unroll
    for (int i = 0; i < 33; ++i) {
        const int jj = kg + 4 * i, jc = (jj <= 128) ? jj : 128;
        const int idx = win + s - (jc << sh);
        const float* vr = (idx < win) ? cache + (size_t)(b * win + idx) * 512 + voff : newr + (size_t)(b * win + idx - 4) * 512 + voff;
        vv[i] = *(const f32x4*)vr;
    }
    f32x4 o = {0.f, 0.f, 0.f, 0.f};
#pragma unroll
    for (int i = 0; i < 33; ++i) { const int jj = kg + 4 * i; const float pj = (jj <= 128) ? sS[(jj <= 128) ? jj : 128] : 0.f; o = o + vv[i] * pj; }
#pragma unroll
    for (int e = 0; e < 4; ++e) { o[e] += __shfl_xor(o[e], 16); o[e] += __shfl_xor(o[e], 32); }
    const float inv = 1.0f / l;
    if (lane < 16) {
        u32x2 w; w.x = pg8::cvt_pk_bf16(o[0] * inv, o[1] * inv); w.y = pg8::cvt_pk_bf16(o[2] * inv, o[3] * inv);
        *(u32x2*)((bf16*)(ws + WS_OG) + ((size_t)g * MR + MP + si) * DAO + h * 64 + 4 * dc) = w;
    }
    if (lane == 0) ((float*)(ws + WS_LSE))[((size_t)g * MR + MP + si) * 4 + h] = mx + __builtin_amdgcn_logf(l);
    LDS_WAIT();
}

typedef short s16x8 __attribute__((ext_vector_type(8)));
typedef short s16x4 __attribute__((ext_vector_type(4)));
typedef float f32x16 __attribute__((ext_vector_type(16)));
constexpr int AT_ROWB = 144, AT_VROWB = 192, AT_V0 = 384 * AT_ROWB, AT_UNITS = NB * 12 * 16, AT_PER_WG = 6;
__device__ __forceinline__ s16x4 vtr(const LAS unsigned char* p) { return __builtin_bit_cast(s16x4, __builtin_amdgcn_ds_read_tr16_b64_v4i16((LAS s16x4*)p)); }
__device__ __forceinline__ float shfl32(float v) { return __shfl_xor(v, 32); }

struct AttnPf { u32x4 k[6], v[6], q[4]; };
__device__ __forceinline__ void attn_prefetch(AttnPf& pf, const bf16* Q, const bf16* K, const bf16* V, int u, int tid, int wave, int lane) {
    const int bgh = u >> 4, c = u & 15, g = (bgh >> 2) % 3, sh = 2 * g, pos0 = 256 * c;
    const bool has_prev = (pos0 & ((4096 >> sh) - 1)) != 0;
    const size_t hb = (size_t)bgh * 4096 * 64;
#pragma unroll
    for (int i = 0; i < 6; ++i) {
        const int rel = (tid >> 3) + 64 * i - 128;
        if (has_prev || i >= 2) {
            const size_t off = hb + (size_t)(pos0 + rel) * 64 + (tid & 7) * 8;
            pf.k[i] = *(const u32x4*)(K + off); pf.v[i] = *(const u32x4*)(V + off);
        }
    }
    const bf16* qp = Q + hb + (size_t)(pos0 + 32 * wave + (lane & 31)) * 64 + (lane >> 5) * 8;
#pragma unroll
    for (int ks = 0; ks < 4; ++ks) pf.q[ks] = *(const u32x4*)(qp + ks * 16);
}
__device__ __forceinline__ void attn_stage(const AttnPf& pf, LAS unsigned char* lds, int u, int tid) {
    const int bgh = u >> 4, c = u & 15, g = (bgh >> 2) % 3, sh = 2 * g, pos0 = 256 * c;
    const bool has_prev = (pos0 & ((4096 >> sh) - 1)) != 0;
#pragma unroll
    for (int i = 0; i < 6; ++i) {
        const int kr = (tid >> 3) + 64 * i;
        const bool ld = has_prev || i >= 2;
        *(LAS u32x4*)(lds + kr * AT_ROWB + (tid & 7) * 16) = ld ? pf.k[i] : (u32x4){0u, 0u, 0u, 0u};
        *(LAS u32x4*)(lds + AT_V0 + kr * AT_VROWB + (tid & 7) * 16) = ld ? pf.v[i] : (u32x4){0u, 0u, 0u, 0u};
    }
}
__device__ __forceinline__ void attn_compute(const AttnPf& pf, LAS unsigned char* lds, bf16* OG, float* LSE, int u, int wave, int lane) {
    const int bgh = u >> 4, c = u & 15, b = bgh / 12, g = (bgh >> 2) % 3, hh = bgh & 3, sh = 2 * g, pos0 = 256 * c;
    const bool has_prev = (pos0 & ((4096 >> sh) - 1)) != 0;
    const int r32 = lane & 31, h = lane >> 5;
    const int jmin = has_prev ? 0 : ((wave < 4) ? 4 - wave : 0);
    f32x16 S[5];
    const LAS unsigned char* kbase = lds + (32 * wave + r32) * AT_ROWB + h * 16;
    s16x8 kf[2][4];
#pragma unroll
    for (int ks = 0; ks < 4; ++ks) kf[0][ks] = *(const LAS s16x8*)(kbase + ks * 32);
#pragma unroll
    for (int j = 0; j < 5; ++j) {
        if (j < 4) {
#pragma unroll
            for (int ks = 0; ks < 4; ++ks) kf[(j + 1) & 1][ks] = *(const LAS s16x8*)(kbase + (j + 1) * 32 * AT_ROWB + ks * 32);
        }
        f32x16 a = {0.f, 0.f, 0.f, 0.f, 0.f, 0.f, 0.f, 0.f, 0.f, 0.f, 0.f, 0.f, 0.f, 0.f, 0.f, 0.f};
#pragma unroll
        for (int ks = 0; ks < 4; ++ks) a = __builtin_amdgcn_mfma_f32_32x32x16_bf16(kf[j & 1][ks], __builtin_bit_cast(s16x8, pf.q[ks]), a, 0, 0, 0);
        S[j] = a;
    }
    float m = -1e30f;
#pragma unroll
    for (int j = 0; j < 5; ++j) {
        const bool tile_ok = j >= jmin;
#pragma unroll
        for (int r = 0; r < 16; ++r) {
            const int cr = (r & 3) + 8 * (r >> 2) + 4 * h;
            const bool valid = tile_ok && ((j == 0) ? (cr >= r32) : (j == 4) ? (cr <= r32) : true);
            const float v = valid ? S[j][r] : -1e30f;
            S[j][r] = v; m = fmaxf(m, v);
        }
    }
    m = fmaxf(m, shfl32(m));
    float l = 0.f;
#pragma unroll
    for (int j = 0; j < 5; ++j) {
#pragma unroll
        for (int r = 0; r < 16; ++r) { const float pe = __builtin_amdgcn_exp2f(S[j][r] - m); S[j][r] = pe; l += pe; }
    }
    l += shfl32(l);
    f32x16 o0 = {0.f, 0.f, 0.f, 0.f, 0.f, 0.f, 0.f, 0.f, 0.f, 0.f, 0.f, 0.f, 0.f, 0.f, 0.f, 0.f}, o1 = o0;
    const int a4 = lane & 15, G4 = lane >> 4;
    const LAS unsigned char* vbase = lds + AT_V0 + (32 * wave + 4 * (G4 >> 1) + (a4 >> 2)) * AT_VROWB + (16 * (G4 & 1) + 4 * (a4 & 3)) * 2;
#pragma unroll
    for (int j = 0; j < 5; ++j) {
        {
#pragma unroll
            for (int s2 = 0; s2 < 2; ++s2) {
                u32x4 pw;
                pw.x = pg8::cvt_pk_bf16(S[j][8 * s2 + 0], S[j][8 * s2 + 1]); pw.y = pg8::cvt_pk_bf16(S[j][8 * s2 + 2], S[j][8 * s2 + 3]);
                pw.z = pg8::cvt_pk_bf16(S[j][8 * s2 + 4], S[j][8 * s2 + 5]); pw.w = pg8::cvt_pk_bf16(S[j][8 * s2 + 6], S[j][8 * s2 + 7]);
                const s16x8 pfrag = __builtin_bit_cast(s16x8, pw);
                const LAS unsigned char* vp = vbase + (32 * j + 16 * s2) * AT_VROWB;
                const s16x4 a0 = vtr(vp), a1 = vtr(vp + 8 * AT_VROWB), b0 = vtr(vp + 64), b1 = vtr(vp + 8 * AT_VROWB + 64);
                const s16x8 va = {a0[0], a0[1], a0[2], a0[3], a1[0], a1[1], a1[2], a1[3]};
                const s16x8 vb = {b0[0], b0[1], b0[2], b0[3], b1[0], b1[1], b1[2], b1[3]};
                o0 = __builtin_amdgcn_mfma_f32_32x32x16_bf16(va, pfrag, o0, 0, 0, 0);
                o1 = __builtin_amdgcn_mfma_f32_32x32x16_bf16(vb, pfrag, o1, 0, 0, 0);
            }
        }
    }
    const int pos = pos0 + 32 * wave + r32;
    const int t = ((pos & ((4096 >> sh) - 1)) << sh) + (pos >> (12 - sh));
    const size_t row = (size_t)b * 4096 + t;
    const float inv = 1.0f / l;
    bf16* op = OG + ((size_t)g * MR + row) * DAO + hh * 64 + 4 * h;
#pragma unroll
    for (int i = 0; i < 4; ++i) {
        u32x2 w0, w1;
        w0.x = pg8::cvt_pk_bf16(o0[4 * i] * inv, o0[4 * i + 1] * inv); w0.y = pg8::cvt_pk_bf16(o0[4 * i + 2] * inv, o0[4 * i + 3] * inv);
        w1.x = pg8::cvt_pk_bf16(o1[4 * i] * inv, o1[4 * i + 1] * inv); w1.y = pg8::cvt_pk_bf16(o1[4 * i + 2] * inv, o1[4 * i + 3] * inv);
        *(u32x2*)(op + 8 * i) = w0; *(u32x2*)(op + 32 + 8 * i) = w1;
    }
    if (h == 0) LSE[((size_t)g * MR + row) * 4 + hh] = m + __builtin_amdgcn_logf(l);
}
__device__ __forceinline__ void attn_phase_mfma(const Params& p, LAS unsigned char* lds, int vcu, int tid, int wave, int lane) {
    unsigned char* ws = p.ws;
    const bf16* Q = (const bf16*)(ws + WS_Q); const bf16* K = (const bf16*)(ws + WS_K); const bf16* V = (const bf16*)(ws + WS_V);
    bf16* OG = (bf16*)(ws + WS_OG); float* LSE = (float*)(ws + WS_LSE);
    AttnPf pf;
    const int u0 = vcu * AT_PER_WG;
    attn_prefetch(pf, Q, K, V, u0, tid, wave, lane);
#pragma unroll 1
    for (int i = 0; i < AT_PER_WG; ++i) {
        const int u = u0 + i;
        attn_stage(pf, lds, u, tid);
        AttnPf cur;
#pragma unroll
        for (int ks = 0; ks < 4; ++ks) cur.q[ks] = pf.q[ks];
        __syncthreads();
        if (i + 1 < AT_PER_WG) attn_prefetch(pf, Q, K, V, u + 1, tid, wave, lane);
        attn_compute(cur, lds, OG, LSE, u, wave, lane);
        __syncthreads();
    }
}
__device__ __forceinline__ void merge4(const bf16* OG, const float* LSE, bf16* OATT, int row0, int rstep, int ch, int n) {
    float l[4][3]; u32x4 og[4][3];
    const int hh = ch >> 3;
#pragma unroll
    for (int q = 0; q < 4; ++q) {
        if (q < n) {
            const int row = row0 + q * rstep;
#pragma unroll
            for (int g = 0; g < 3; ++g) { l[q][g] = LSE[((size_t)g * MR + row) * 4 + hh]; og[q][g] = __builtin_nontemporal_load((const u32x4*)(OG + ((size_t)g * MR + row) * DAO + ch * 8)); }
        }
    }
#pragma unroll
    for (int q = 0; q < 4; ++q) {
        if (q < n) {
            const int row = row0 + q * rstep;
            const float mx = fmaxf(l[q][0], fmaxf(l[q][1], l[q][2]));
            float e0 = __builtin_amdgcn_exp2f(l[q][0] - mx), e1 = __builtin_amdgcn_exp2f(l[q][1] - mx), e2 = __builtin_amdgcn_exp2f(l[q][2] - mx);
            const float inv = 1.0f / (e0 + e1 + e2); e0 *= inv; e1 *= inv; e2 *= inv;
            f32x4 a0, b0, a1, b1, a2, b2;
            unpack8(og[q][0], a0, b0); unpack8(og[q][1], a1, b1); unpack8(og[q][2], a2, b2);
            *(u32x4*)(OATT + (size_t)row * KC + ch * 8) = pack8(a0 * e0 + a1 * e1 + a2 * e2, b0 * e0 + b1 * e1 + b2 * e2);
        }
    }
}
__device__ __forceinline__ void merge_phase(const Params& p, int vcu, int tid) {
    unsigned char* ws = p.ws;
    const bf16* OG = (const bf16*)(ws + WS_OG); const float* LSE = (const float*)(ws + WS_LSE); bf16* OATT = (bf16*)(ws + WS_A);
    const int r0 = 128 * vcu + (tid >> 5), ch = tid & 31;
    merge4(OG, LSE, OATT, r0, 16, ch, 4);
    merge4(OG, LSE, OATT, r0 + 64, 16, ch, 4);
}

typedef float f32x2 __attribute__((ext_vector_type(2)));
constexpr int CV_T = 32, CV_UNITS = MP / CV_T, CV_PER_WG = CV_UNITS / 256;
template <int E> __device__ __forceinline__ void conv_loads(unsigned (&uw)[62], const bf16* up, bool has_left) {
    if constexpr (E < 62) {
        uw[E] = 0u;
        if (E >= 30 || has_left) uw[E] = *(const unsigned*)(up + (size_t)E * DM);
        conv_loads<E + 1>(uw, up, has_left);
    }
}
template <int E> __device__ __forceinline__ void conv_steps(f32x2 (&acc)[32], const f32x2 (&w)[31], const unsigned (&uw)[62]) {
    if constexpr (E < 62) {
        const f32x2 uv = {bf_lo(uw[E]), bf_hi(uw[E])};
        constexpr int TLO = (E - 30 > 0) ? E - 30 : 0, THI = (E < 31) ? E : 31;
#pragma unroll
        for (int t = TLO; t <= THI; ++t) acc[t] = acc[t] + w[E - t] * uv;
        conv_steps<E + 1>(acc, w, uw);
    }
}
struct MergeLd { float l[2][3]; u32x4 og[2][3]; };
__device__ __forceinline__ void merge_ld(MergeLd& m, const bf16* OG, const float* LSE, int row0, int ch) {
    const int hh = ch >> 3;
#pragma unroll
    for (int q = 0; q < 2; ++q)
#pragma unroll
        for (int g = 0; g < 3; ++g) { const int row = row0 + 16 * q; m.l[q][g] = LSE[((size_t)g * MR + row) * 4 + hh]; m.og[q][g] = __builtin_nontemporal_load((const u32x4*)(OG + ((size_t)g * MR + row) * DAO + ch * 8)); }
}
__device__ __forceinline__ void merge_fin(const MergeLd& m, bf16* OATT, int row0, int ch) {
#pragma unroll
    for (int q = 0; q < 2; ++q) {
        const int row = row0 + 16 * q;
        const float mx = fmaxf(m.l[q][0], fmaxf(m.l[q][1], m.l[q][2]));
        float e0 = __builtin_amdgcn_exp2f(m.l[q][0] - mx), e1 = __builtin_amdgcn_exp2f(m.l[q][1] - mx), e2 = __builtin_amdgcn_exp2f(m.l[q][2] - mx);
        const float inv = 1.0f / (e0 + e1 + e2); e0 *= inv; e1 *= inv; e2 *= inv;
        f32x4 a0, b0, a1, b1, a2, b2;
        unpack8(m.og[q][0], a0, b0); unpack8(m.og[q][1], a1, b1); unpack8(m.og[q][2], a2, b2);
        *(u32x4*)(OATT + (size_t)row * KC + ch * 8) = pack8(a0 * e0 + a1 * e1 + a2 * e2, b0 * e0 + b1 * e1 + b2 * e2);
    }
}
template <int E> __device__ __forceinline__ void conv_steps_roll(f32x2 (&acc)[32], const f32x2 (&w)[31], const unsigned (&uw)[62], unsigned (&nx)[32], const bf16* upn) {
    if constexpr (E < 62) {
        const f32x2 uv = {bf_lo(uw[E]), bf_hi(uw[E])};
        constexpr int TLO = (E - 30 > 0) ? E - 30 : 0, THI = (E < 31) ? E : 31;
#pragma unroll
        for (int t = TLO; t <= THI; ++t) acc[t] = acc[t] + w[E - t] * uv;
        if constexpr (E < 32) nx[E] = *(const unsigned*)(upn + (size_t)E * DM);
        conv_steps_roll<E + 1>(acc, w, uw, nx, upn);
    }
}
#define CV_BFLY(n) { const bool up_half = (lane & (n)) != 0; _Pragma("unroll") for (int i = 0; i < (n); ++i) { \
        const float keep = up_half ? v[i + (n)] : v[i], send = up_half ? v[i] : v[i + (n)]; v[i] = keep + __shfl_xor(send, (n)); } }
__device__ __forceinline__ void conv_phase(const Params& p, LAS unsigned char* lds, int vcu, int tid, int wave, int lane) {
    unsigned char* ws = p.ws;
    const bf16* U = (const bf16*)(ws + WS_B); bf16* CACT = (bf16*)(ws + WS_A) + DAO;
    const bf16* OG = (const bf16*)(ws + WS_OG); const float* LSE = (const float*)(ws + WS_LSE); bf16* OATT = (bf16*)(ws + WS_A);
    const int ch = 2 * tid;
    LAS f32x2* wl = (LAS f32x2*)lds + tid;
    {
        f32x2 w0[31];
#pragma unroll
        for (int i = 0; i < 31; ++i) w0[i] = *(const f32x2*)(p.in[11] + (size_t)i * DM + ch);
#pragma unroll
        for (int i = 0; i < 31; ++i) wl[i * 512] = w0[i];
    }
    const f32x2 cb = *(const f32x2*)(p.in[12] + ch), lw = *(const f32x2*)(p.in[13] + ch), lb = *(const f32x2*)(p.in[14] + ch);
    LAS float* red = (LAS float*)(lds + 31 * 512 * 8);
    unsigned uw[62];
    {
        const int row0 = vcu * (CV_PER_WG * CV_T);
        conv_loads<0>(uw, U + (size_t)(row0 - 30) * DM + ch, (row0 & 4095) != 0);
    }
#pragma unroll 1
    for (int i = 0; i < CV_PER_WG; ++i) {
        const int row0 = (vcu * CV_PER_WG + i) * CV_T;
        unsigned nx[32];
        const int rown = (i + 1 < CV_PER_WG) ? row0 + CV_T : row0;
        f32x2 acc[CV_T];
#pragma unroll
        for (int t = 0; t < CV_T; ++t) acc[t] = cb;
        asm volatile("" ::: "memory");
        f32x2 w[31];
#pragma unroll
        for (int i = 0; i < 31; ++i) w[i] = wl[i * 512];
        conv_steps_roll<0>(acc, w, uw, nx, U + (size_t)rown * DM + ch);
        const int mrow = row0 + (tid >> 5), mch = tid & 31;
        float tsum, tsq;
        {
            float v[32];
#pragma unroll
            for (int t = 0; t < CV_T; ++t) v[t] = acc[t].x + acc[t].y;
            CV_BFLY(16) CV_BFLY(8) CV_BFLY(4) CV_BFLY(2) CV_BFLY(1)
            tsum = v[0] + __shfl_xor(v[0], 32);
        }
        {
            float v[32];
#pragma unroll
            for (int t = 0; t < CV_T; ++t) v[t] = acc[t].x * acc[t].x + acc[t].y * acc[t].y;
            CV_BFLY(16) CV_BFLY(8) CV_BFLY(4) CV_BFLY(2) CV_BFLY(1)
            tsq = v[0] + __shfl_xor(v[0], 32);
        }
        MergeLd mg; merge_ld(mg, OG, LSE, mrow, mch);
        red[wave * 64 + lane] = (lane < 32) ? tsum : tsq;
        __syncthreads();
        float tot = 0.f;
#pragma unroll
        for (int w8 = 0; w8 < 8; ++w8) tot += red[w8 * 64 + lane];
        __syncthreads();
        const float sq = __shfl(tot, (lane & 31) + 32);
        const float mean = tot * (1.0f / DM);
        const float var = sq * (1.0f / DM) - mean * mean;
        const float rstd = __builtin_amdgcn_rsqf(fmaxf(var, 0.f) + LN_EPS);
#pragma unroll
        for (int t = 0; t < CV_T; ++t) {
            const float mt = __builtin_bit_cast(float, __builtin_amdgcn_readlane(__builtin_bit_cast(int, mean), t));
            const float rt = __builtin_bit_cast(float, __builtin_amdgcn_readlane(__builtin_bit_cast(int, rstd), t));
            float y0 = (acc[t].x - mt) * rt * lw.x + lb.x, y1 = (acc[t].y - mt) * rt * lw.y + lb.y;
            y0 = y0 * sigmoidf_(y0); y1 = y1 * sigmoidf_(y1);
            *(unsigned*)(CACT + (size_t)(row0 + t) * KC + ch) = pg8::cvt_pk_bf16(y0, y1);
        }
        merge_fin(mg, OATT, mrow, mch);
#pragma unroll
        for (int k = 0; k < 30; ++k) uw[k] = uw[32 + k];
#pragma unroll
        for (int k = 0; k < 32; ++k) uw[30 + k] = nx[k];
    }
#undef CV_BFLY
    if (vcu < SB) {
        const int b = vcu;
        f32x2 u[34];
#pragma unroll
        for (int e = 0; e < 30; ++e) u[e] = *(const f32x2*)(p.in[5] + ((size_t)b * 30 + e) * DM + ch);
#pragma unroll
        for (int e = 30; e < 34; ++e) { const unsigned wv = *(const unsigned*)(U + (size_t)(MP + 4 * b + e - 30) * DM + ch); u[e] = (f32x2){bf_lo(wv), bf_hi(wv)}; }
        f32x2 acc[4]; float v[8];
        f32x2 w[31];
#pragma unroll
        for (int i = 0; i < 31; ++i) w[i] = wl[i * 512];
#pragma unroll
        for (int s4 = 0; s4 < 4; ++s4) {
            acc[s4] = cb;
#pragma unroll
            for (int i = 0; i < 31; ++i) acc[s4] = acc[s4] + w[i] * u[s4 + i];
            v[s4] = acc[s4].x + acc[s4].y; v[4 + s4] = acc[s4].x * acc[s4].x + acc[s4].y * acc[s4].y;
        }
#pragma unroll
        for (int o = 1; o < 64; o <<= 1)
#pragma unroll
            for (int j = 0; j < 8; ++j) v[j] += __shfl_xor(v[j], o);
        __syncthreads();
        if (lane < 8) {
            float mine = v[0];
#pragma unroll
            for (int j = 1; j < 8; ++j) mine = (lane == j) ? v[j] : mine;
            red[wave * 8 + lane] = mine;
        }
        __syncthreads();
#pragma unroll
        for (int s4 = 0; s4 < 4; ++s4) {
            float sm = 0.f, sq = 0.f;
#pragma unroll
            for (int w8 = 0; w8 < 8; ++w8) { sm += red[w8 * 8 + s4]; sq += red[w8 * 8 + 4 + s4]; }
            const float mean = sm * (1.0f / DM), var = sq * (1.0f / DM) - mean * mean, rstd = __builtin_amdgcn_rsqf(fmaxf(var, 0.f) + LN_EPS);
            float y0 = (acc[s4].x - mean) * rstd * lw.x + lb.x, y1 = (acc[s4].y - mean) * rstd * lw.y + lb.y;
            y0 = y0 * sigmoidf_(y0); y1 = y1 * sigmoidf_(y1);
            *(unsigned*)(CACT + (size_t)(MP + 4 * b + s4) * KC + ch) = pg8::cvt_pk_bf16(y0, y1);
        }
        __syncthreads();
    }
}

typedef float f32x4v __attribute__((ext_vector_type(4)));
template <int NRB, int NCB, int K>
__device__ __forceinline__ void thin_partial(LAS float* P, const bf16* A, int lda, const bf16* B0, const bf16* B1, int ldb, int wave, int lane) {
    constexpr int KW = K / 8, STEPS = KW / 32, ROWS = 16 * NRB, COLS = 16 * NCB;
    const int r16 = lane & 15, k8 = lane >> 4;
    f32x4v acc[NRB][NCB];
#pragma unroll
    for (int rb = 0; rb < NRB; ++rb)
#pragma unroll
        for (int cb = 0; cb < NCB; ++cb) acc[rb][cb] = (f32x4v){0.f, 0.f, 0.f, 0.f};
    const bf16* ap = A + (size_t)r16 * lda + wave * KW + 8 * k8;
    const bf16* bp0 = B0 + (size_t)r16 * ldb + wave * KW + 8 * k8;
    const bf16* bp1 = B1 + (size_t)r16 * ldb + wave * KW + 8 * k8;
#pragma unroll
    for (int st = 0; st < STEPS; ++st) {
        bf16x8 b[NCB];
        b[0] = *(const bf16x8*)(bp0 + 32 * st);
        if (NCB > 1) b[NCB - 1] = *(const bf16x8*)(bp1 + 32 * st);
#pragma unroll
        for (int rb = 0; rb < NRB; ++rb) {
            const bf16x8 a = *(const bf16x8*)(ap + (size_t)(16 * rb) * lda + 32 * st);
#pragma unroll
            for (int cb = 0; cb < NCB; ++cb) acc[rb][cb] = __builtin_amdgcn_mfma_f32_16x16x32_bf16(a, b[cb], acc[rb][cb], 0, 0, 0);
        }
    }
#pragma unroll
    for (int rb = 0; rb < NRB; ++rb)
#pragma unroll
        for (int cb = 0; cb < NCB; ++cb)
#pragma unroll
            for (int r = 0; r < 4; ++r) P[(wave * ROWS + 16 * rb + 4 * k8 + r) * COLS + 16 * cb + r16] = acc[rb][cb][r];
}
template <int ROWS, int COLS> __device__ __forceinline__ float thin_sum(const LAS float* P, int r, int c) {
    float v = 0.f;
#pragma unroll
    for (int w = 0; w < 8; ++w) v += P[(w * ROWS + r) * COLS + c];
    return v;
}
template <int STAGE> __device__ __forceinline__ void thin_stage(const Params& p, LAS unsigned char* lds, int vcu, int tid, int wave, int lane) {
    unsigned char* ws = p.ws;
    LAS float* P = (LAS float*)lds;
    if constexpr (STAGE == 0 || STAGE == 1 || STAGE == 2 || STAGE == 4) {
        constexpr int K = (STAGE == 0) ? DAO : (STAGE == 4) ? DFF : DM;
        constexpr int LDA = (STAGE <= 1) ? KC : K, LDB = (STAGE <= 1) ? KC : K;
        const bf16* A = (STAGE == 0) ? (const bf16*)(ws + WS_A) : (STAGE == 1) ? (const bf16*)(ws + WS_A) + DAO : (STAGE == 2) ? (const bf16*)(ws + WS_B) : (const bf16*)(ws + WS_ACT);
        const bf16* B = (STAGE == 0) ? (const bf16*)(ws + WS_WCAT) : (STAGE == 1) ? (const bf16*)(ws + WS_WCAT) + DAO : (STAGE == 2) ? (const bf16*)(ws + WS_WOUT) : (const bf16*)(ws + WS_WD);
        const int ct = vcu & 63, rb = vcu >> 6, row0 = MP + 32 * rb, col0 = 16 * ct;
        if constexpr (STAGE == 0) {
            merge4((const bf16*)(ws + WS_OG), (const float*)(ws + WS_LSE), (bf16*)(ws + WS_A), row0 + (tid >> 5), 16, tid & 31, 2);
            asm volatile("s_waitcnt vmcnt(0)" ::: "memory");
            __syncthreads();
            __builtin_amdgcn_fence(__ATOMIC_ACQUIRE, "agent");
        }
        thin_partial<2, 1, K>(P, A + (size_t)row0 * LDA, LDA, B + (size_t)col0 * LDB, B + (size_t)col0 * LDB, LDB, wave, lane);
        __syncthreads();
        const int r = tid >> 4, c = tid & 15, row = row0 + r, col = col0 + c;
        const float acc = thin_sum<32, 16>(P, r, c);
        if constexpr (STAGE == 0) {
            const bf16* GA = (const bf16*)(ws + WS_GA); bf16* HA = (bf16*)(ws + WS_B);
            HA[(size_t)row * DM + col] = (bf16)f2bf(acc * ((float)((const unsigned char*)GA)[(size_t)row * GP + col] * (1.0f / 255.0f)));
        } else if constexpr (STAGE == 1) {
            const bf16* GB = (const bf16*)(ws + WS_GB); bf16* H = (bf16*)(ws + WS_B);
            H[(size_t)row * DM + col] = (bf16)f2bf(acc * ((float)((const unsigned char*)GB)[(size_t)row * GP + col] * (1.0f / 255.0f)) + bf_lo((unsigned)H[(size_t)row * DM + col]));
        } else if constexpr (STAGE == 2) {
            const float x1 = p.in[1][(size_t)(row - MP) * DM + col] + acc;
            p.out[(size_t)row * DM + col] = x1;
            ((bf16*)(ws + WS_X1B))[(size_t)row * DM + col] = (bf16)f2bf(x1);
            float ss = x1 * x1;
            ss += __shfl_xor(ss, 1); ss += __shfl_xor(ss, 2); ss += __shfl_xor(ss, 4); ss += __shfl_xor(ss, 8);
            if (c == 0) ((float*)(ws + WS_SSS))[(size_t)(row - MP) * 64 + ct] = ss;
        } else {
            p.out[(size_t)row * DM + col] += acc;
        }
        __syncthreads();
    } else {
        const bf16* A = (const bf16*)(ws + WS_X1B); const bf16* B = (const bf16*)(ws + WS_WGU); bf16* ACT = (bf16*)(ws + WS_ACT);
        const float* SSS = (const float*)(ws + WS_SSS);
        for (int u = vcu; u < 352; u += 256) {
            const int ct = u % 176, rb = u / 176, row0 = MP + 64 * rb, ch0 = 16 * ct;
            const int bpos = (ch0 >> 7) * 256 + (ch0 & 127);
            thin_partial<4, 2, DM>(P, A + (size_t)row0 * DM, DM, B + (size_t)bpos * DM, B + (size_t)(bpos + 128) * DM, DM, wave, lane);
            __syncthreads();
#pragma unroll
            for (int i = 0; i < 2; ++i) {
                const int e = tid + 512 * i, r = e >> 4, c = e & 15, row = row0 + r;
                const f32x4 sv = *(const f32x4*)(SSS + (size_t)(row - MP) * 64 + 4 * c);
                float tot = (sv[0] + sv[1]) + (sv[2] + sv[3]);
                tot += __shfl_xor(tot, 1); tot += __shfl_xor(tot, 2); tot += __shfl_xor(tot, 4); tot += __shfl_xor(tot, 8);
                const float rstd = __builtin_amdgcn_rsqf(tot * (1.0f / DM) + RMS_EPS);
                const float g = thin_sum<64, 32>(P, r, c) * rstd, up = thin_sum<64, 32>(P, r, 16 + c) * rstd;
                ACT[(size_t)row * DFF + ch0 + c] = (bf16)f2bf(g * sigmoidf_(g) * up);
            }
            __syncthreads();
        }
    }
}

__device__ __forceinline__ void tr_item(const float* W, int ldw, int K, bf16* WT, int k0, int pos0, int src0, const float* ksc, LAS float* scr, int lane, int kdst = 0) {
    const int kr = lane >> 3, n4 = lane & 7;
    f32x4 v[8];
#pragma unroll
    for (int i = 0; i < 8; ++i) v[i] = __builtin_nontemporal_load((const GAS f32x4*)(W + (size_t)(k0 + kr + 8 * i) * ldw + src0 + 4 * n4));
#pragma unroll
    for (int i = 0; i < 8; ++i) {
        const int kk = kr + 8 * i;
        const float sc = ksc ? ksc[k0 + kk] : 1.0f;
        LAS float* d = scr + kk * 33 + 4 * n4;
        d[0] = v[i].x * sc; d[1] = v[i].y * sc; d[2] = v[i].z * sc; d[3] = v[i].w * sc;
    }
    LDS_WAIT(); asm volatile("" ::: "memory");
    const int c = lane & 7;
#pragma unroll
    for (int j = 0; j < 4; ++j) { const int n = (lane >> 3) + 8 * j; const LAS float* s = scr + (8 * c) * 33 + n;
        v4u o; o.x = pk2(s[0 * 33], s[1 * 33]); o.y = pk2(s[2 * 33], s[3 * 33]); o.z = pk2(s[4 * 33], s[5 * 33]); o.w = pk2(s[6 * 33], s[7 * 33]);
        *(GAS v4u*)(WT + (size_t)(pos0 + n) * K + kdst + k0 + 8 * c) = o; }
    LDS_WAIT(); asm volatile("" ::: "memory");
}
__device__ __forceinline__ int w1_src(int pos0) {
    const int pn = pos0 >> 8, p = pos0 & 255;
    if (pn < 9) { const int seg = pn / 3, g = pn - 3 * seg; return seg * 768 + g * 256 + 64 * ((p >> 5) & 3) + 32 * (p >> 7); }
    if (pn < 17) { return ((p < 128) ? 2304 : 3328) + 128 * (pn - 9) + (p & 127); }
    return pos0;
}
__device__ __forceinline__ int wgu_src(int pos0) { const int pn = pos0 >> 8, p = pos0 & 255; return ((p < 128) ? 0 : DFF) + 128 * pn + (p & 127); }

__device__ __forceinline__ void tr_load(const float* W, int ldw, int k0, int src0, int lane, f32x4 (&v)[8]) {
    const int kr = lane >> 3, n4 = lane & 7;
#pragma unroll
    for (int i = 0; i < 8; ++i) v[i] = __builtin_nontemporal_load((const GAS f32x4*)(W + (size_t)(k0 + kr + 8 * i) * ldw + src0 + 4 * n4));
}
__device__ __forceinline__ void tr_store(const f32x4 (&v)[8], int K, bf16* WT, int k0, int pos0, const float* ksc, LAS float* scr, int lane, int kdst) {
    const int kr = lane >> 3, n4 = lane & 7;
#pragma unroll
    for (int i = 0; i < 8; ++i) {
        const int kk = kr + 8 * i;
        const float sc = ksc ? ksc[k0 + kk] : 1.0f;
        LAS float* d = scr + kk * 33 + 4 * n4;
        d[0] = v[i].x * sc; d[1] = v[i].y * sc; d[2] = v[i].z * sc; d[3] = v[i].w * sc;
    }
    LDS_WAIT(); asm volatile("" ::: "memory");
    const int c = lane & 7;
#pragma unroll
    for (int j = 0; j < 4; ++j) { const int n = (lane >> 3) + 8 * j; const LAS float* s = scr + (8 * c) * 33 + n;
        v4u o; o.x = pk2(s[0 * 33], s[1 * 33]); o.y = pk2(s[2 * 33], s[3 * 33]); o.z = pk2(s[4 * 33], s[5 * 33]); o.w = pk2(s[6 * 33], s[7 * 33]);
        *(GAS v4u*)(WT + (size_t)(pos0 + n) * K + kdst + k0 + 8 * c) = o; }
    LDS_WAIT(); asm volatile("" ::: "memory");
}
constexpr int LW_ATT = 4 * 32, LW_CO = 16 * 32, LW_OUT = 16 * 32, LW_GU = 16 * (NGU / 32), LW_D = (DFF / 64) * 32, LW_ITEMS = LW_ATT + LW_CO + LW_OUT + LW_GU + LW_D;
__device__ __forceinline__ void lw_load(const Params& p, int it, int lane, f32x4 (&v)[8]) {
    int r = it;
    if (r >= LW_ITEMS) return;
    if (r < LW_ATT) { tr_load(p.in[10], DM, 64 * (r / 32), 32 * (r % 32), lane, v); return; } r -= LW_ATT;
    if (r < LW_CO) { tr_load(p.in[15], DM, 64 * (r / 32), 32 * (r % 32), lane, v); return; } r -= LW_CO;
    if (r < LW_OUT) { tr_load(p.in[16], DM, 64 * (r / 32), 32 * (r % 32), lane, v); return; } r -= LW_OUT;
    if (r < LW_GU) { tr_load(p.in[18], NGU, 64 * (r / (NGU / 32)), wgu_src(32 * (r % (NGU / 32))), lane, v); return; } r -= LW_GU;
    tr_load(p.in[19], DM, 64 * (r / 32), 32 * (r % 32), lane, v);
}
__device__ __forceinline__ void lw_store(const Params& p, int it, int lane, const f32x4 (&v)[8], LAS float* scr) {
    unsigned char* ws = p.ws;
    int r = it;
    if (r >= LW_ITEMS) return;
    if (r < LW_ATT) { tr_store(v, KC, (bf16*)(ws + WS_WCAT), 64 * (r / 32), 32 * (r % 32), nullptr, scr, lane, 0); return; } r -= LW_ATT;
    if (r < LW_CO) { tr_store(v, KC, (bf16*)(ws + WS_WCAT), 64 * (r / 32), 32 * (r % 32), nullptr, scr, lane, DAO); return; } r -= LW_CO;
    if (r < LW_OUT) { tr_store(v, DM, (bf16*)(ws + WS_WOUT), 64 * (r / 32), 32 * (r % 32), nullptr, scr, lane, 0); return; } r -= LW_OUT;
    if (r < LW_GU) { tr_store(v, DM, (bf16*)(ws + WS_WGU), 64 * (r / (NGU / 32)), 32 * (r % (NGU / 32)), p.in[17], scr, lane, 0); return; } r -= LW_GU;
    tr_store(v, DFF, (bf16*)(ws + WS_WD), 64 * (r / 32), 32 * (r % 32), nullptr, scr, lane, 0);
}
__device__ __forceinline__ void late_weights(const Params& p, LAS unsigned char* lds, int idx, int nwk, int wave, int lane) {
    LAS float* scr = (LAS float*)(lds + wave * 16384);
    const int stride = nwk * NWAVES;
    for (int it = idx * NWAVES + wave; it < LW_ITEMS; it += 4 * stride) {
        f32x4 v[4][8];
#pragma unroll
        for (int q = 0; q < 4; ++q) lw_load(p, it + q * stride, lane, v[q]);
#pragma unroll
        for (int q = 0; q < 4; ++q) lw_store(p, it + q * stride, lane, v[q], scr);
    }
}
__device__ __forceinline__ void copy_rows(const float* src, float* dst, int rows, int per, int rw, int gt, int NGT) {
    const int n4b = rows * rw, tot = SB * n4b;
    for (int i0 = gt; i0 < tot; i0 += 8 * NGT) {
        f32x4 v[8];
#pragma unroll
        for (int j = 0; j < 8; ++j) { const int i = i0 + j * NGT; if (i < tot) { const int b = i / n4b, r = i - b * n4b; v[j] = __builtin_nontemporal_load((const GAS f32x4*)src + (size_t)b * per * rw + 4 * rw + r); } }
#pragma unroll
        for (int j = 0; j < 8; ++j) { const int i = i0 + j * NGT; if (i < tot) { const int b = i / n4b, r = i - b * n4b; __builtin_nontemporal_store(v[j], (GAS f32x4*)dst + (size_t)b * per * rw + r); } }
    }
}
__device__ __forceinline__ void p0_prologue(const Params& p, LAS unsigned char* lds, int vcu, int G, int wave, int lane) {
    unsigned char* ws = p.ws;
    LAS float* scr = (LAS float*)(lds + wave * 16384);
    const int gw = vcu * NWAVES + wave, NGW = G * NWAVES;
    constexpr int I_W1 = 16 * (NIN / 32);
    for (int r = gw; r < I_W1; r += NGW) { const int nb = r % (NIN / 32), kb = r / (NIN / 32); tr_item(p.in[7], NIN, DM, (bf16*)(ws + WS_W1), 64 * kb, 32 * nb, w1_src(32 * nb), nullptr, scr, lane); }
    bf16* XN = (bf16*)(ws + WS_A);
    const float* nw = p.in[6];
    f32x4 wv[4];
#pragma unroll
    for (int j = 0; j < 4; ++j) wv[j] = *((const f32x4*)nw + lane + 64 * j);
    for (int m0 = gw; m0 < MR; m0 += 2 * NGW) {
        f32x4 v[2][4];
#pragma unroll
        for (int q = 0; q < 2; ++q) {
            const int m = m0 + q * NGW;
            if (m < MV) {
                const float* xrow = (m < MP) ? p.in[0] + (size_t)m * DM : p.in[1] + (size_t)(m - MP) * DM;
                const GAS f32x4* xr = (const GAS f32x4*)xrow + lane;
#pragma unroll
                for (int j = 0; j < 4; ++j) v[q][j] = __builtin_nontemporal_load(xr + 64 * j);
            } else {
#pragma unroll
                for (int j = 0; j < 4; ++j) v[q][j] = (f32x4){0.f, 0.f, 0.f, 0.f};
            }
        }
#pragma unroll
        for (int q = 0; q < 2; ++q) {
            const int m = m0 + q * NGW;
            if (m < MR) {
                float s = 0.f;
#pragma unroll
                for (int j = 0; j < 4; ++j) s += (v[q][j].x * v[q][j].x + v[q][j].y * v[q][j].y) + (v[q][j].z * v[q][j].z + v[q][j].w * v[q][j].w);
                const float rstd = __builtin_amdgcn_rsqf(wave_sum(s) * (1.f / DM) + RMS_EPS);
                GAS unsigned long long* o8 = (GAS unsigned long long*)(XN + (size_t)m * DM) + lane;
#pragma unroll
                for (int j = 0; j < 4; ++j) { const f32x4 y = v[q][j] * rstd * wv[j]; o8[64 * j] = (unsigned long long)pk2(y.x, y.y) | ((unsigned long long)pk2(y.z, y.w) << 32); }
            }
        }
    }
}

#define CW_XT        0
#define CW_QC(q)     (1024 + 16 * (q))
#define CW_BS(k, x)  (2048 + 128 * (k) + 8 * (x))
#define CW_BT(k)     (3200 + 16 * (k))
#define CW_GC(g)     (3400 + 16 * (g))
#define SB_P1 4
#define SB_P2 5
struct QuadOrder {
    int pm0, j, nN, nu;
    __device__ __forceinline__ void init(int vcu, int nN_) { pm0 = 2 * (vcu >> 2); j = vcu & 3; nN = nN_; nu = nN_ / 2; }
    __device__ __forceinline__ bool next(int i, pg8::Unit& u) const { if (i >= nu) return false; const int idx = 4 * i + j, hi = (idx >= nN) ? 1 : 0; u.pm = pm0 + hi; u.pn = idx - hi * nN; return true; }
    __device__ __forceinline__ void a_ready(const pg8::Unit&) const {}
    __device__ __forceinline__ void done(const pg8::Unit&) const {}
};
struct BatchOrder {
    int b, j, ns;
    __device__ __forceinline__ void init(int vcu) { b = vcu >> 5; j = vcu & 31; ns = (b == 0) ? 4 : 3; }
    __device__ __forceinline__ bool next(int i, pg8::Unit& u) const {
        const int idx = 32 * i + j;
        if (idx < 400) { const int sg = idx / 200, w = idx - 200 * sg; u.pm = 16 * b + 8 * sg + (w & 7); u.pn = w >> 3; return true; }
        if (idx < 400 + ns) { u.pm = 128; u.pn = b + 8 * (idx - 400); return true; }
        return false;
    }
    __device__ __forceinline__ int worker() const { return (j >= 16 + ns) ? ((b == 0) ? 0 : 12 + 13 * (b - 1)) + (j - 16 - ns) : -1; }
    __device__ __forceinline__ void a_ready(const pg8::Unit&) const {}
    __device__ __forceinline__ void done(const pg8::Unit&) const {}
};
__device__ __forceinline__ void split_arrive_t0(const XcdBarrier& b, unsigned* ctlw, int k) {
    const unsigned nloc = b.st[0];
    const unsigned old = xb_add(&ctlw[CW_BS(k, b.x)], 1u);
    if (old + 1u == nloc) { __builtin_amdgcn_fence(__ATOMIC_RELEASE, "agent"); asm volatile("s_waitcnt vmcnt(0)" ::: "memory"); (void)xb_add(&ctlw[CW_BT(k)], 1u); }
}
__device__ __forceinline__ void group_barrier(const XcdBarrier& b, unsigned* ctlw, volatile LAS unsigned* misc, int grp, unsigned target, int k) {
    asm volatile("s_waitcnt vmcnt(0)" ::: "memory");
    __syncthreads();
    if (threadIdx.x == 0) {
        __builtin_amdgcn_s_waitcnt(0);
        if (misc[11] == 0u) { __builtin_amdgcn_fence(__ATOMIC_RELEASE, "agent"); asm volatile("s_waitcnt vmcnt(0)" ::: "memory"); }
        (void)xb_add(&ctlw[CW_GC(grp)], 1u);
        split_arrive_t0(b, ctlw, k);
        XB_SPIN(xb_ld(&ctlw[CW_GC(grp)]) < target, b.bar);
        __builtin_amdgcn_fence(__ATOMIC_ACQUIRE, "agent");
        asm volatile("s_waitcnt vmcnt(0)" ::: "memory");
    }
    __syncthreads();
}
__device__ __forceinline__ void stage_done(const XcdBarrier& b, unsigned* ctlw, volatile LAS unsigned* misc, int quad, int k) {
    asm volatile("s_waitcnt vmcnt(0)" ::: "memory");
    __syncthreads();
    if (threadIdx.x == 0) {
        __builtin_amdgcn_s_waitcnt(0);
        if (misc[10] == 0u) { __builtin_amdgcn_fence(__ATOMIC_RELEASE, "agent"); asm volatile("s_waitcnt vmcnt(0)" ::: "memory"); }
        (void)xb_add(&ctlw[CW_QC(quad)], 1u);
        split_arrive_t0(b, ctlw, k);
    }
}
__device__ __forceinline__ void quad_wait(const XcdBarrier& b, unsigned* ctlw, int quad, unsigned target, bool next_too) {
    if (threadIdx.x == 0) {
        XB_SPIN(xb_ld(&ctlw[CW_QC(quad)]) < target, b.bar);
        if (next_too) XB_SPIN(xb_ld(&ctlw[CW_QC(quad + 1)]) < 4u, b.bar);
        __builtin_amdgcn_fence(__ATOMIC_ACQUIRE, "agent");
        asm volatile("s_waitcnt vmcnt(0)" ::: "memory");
    }
    __syncthreads();
}
__device__ __forceinline__ void split_wait(const XcdBarrier& b, unsigned* ctlw, int k) {
    if (threadIdx.x == 0) {
        const unsigned nx = b.st[1];
        XB_SPIN(xb_ld(&ctlw[CW_BT(k)]) < nx, b.bar);
        __builtin_amdgcn_fence(__ATOMIC_ACQUIRE, "agent");
        asm volatile("s_waitcnt vmcnt(0)" ::: "memory");
    }
    __syncthreads();
}

__global__ void __launch_bounds__(NWAVES * 64, 2) fwd_kernel(Params p) {
    extern __shared__ __attribute__((aligned(16))) unsigned char lds_raw[];
    LAS unsigned char* lds = (LAS unsigned char*)lds_raw;
    volatile LAS unsigned* MISC = (volatile LAS unsigned*)(lds + MISC_OFF);
    const int tid = threadIdx.x, lane = tid & 63, wave = __builtin_amdgcn_readfirstlane(tid >> 6);
    const int G = gridDim.x; const int bx = blockIdx.x; const int vcu = (G % 8 == 0) ? (bx % 8) * (G / 8) + bx / 8 : bx;
    unsigned char* ws = p.ws;
    gu32* ctl = (gu32*)(ws + WS_CTL);
    for (int u = tid; u < (LDS_BYTES - LDSCTL_OFF) / 4; u += NWAVES * 64) ((LAS unsigned*)(lds + LDSCTL_OFF))[u] = 0u;
    __syncthreads();
    XcdBarrier bar = xcd_barrier_post((unsigned*)(ctl + CW_BAR), MISC + 8);
    if (tid == 0) __hip_atomic_store((unsigned*)ctl + CW_XT + vcu, bar.x + 1u, __ATOMIC_RELAXED, __HIP_MEMORY_SCOPE_AGENT);
    const int lo = p.ph_lo, hi = p.ph_hi;
    unsigned* ctlw = (unsigned*)ctl;
    const int grp = vcu >> 5, quad = vcu >> 2;
#define IN(k) (lo <= (k) && (k) < hi)
#define BOTH(k) (IN(k) && IN((k) + 1))

#if PH_MASK & 1
    if (IN(0)) { p0_prologue(p, lds, vcu, G, wave, lane); if (BOTH(0)) xcd_barrier(bar); }
#endif

#if PH_MASK & (1 << 1)
    if (IN(1)) {
        pg8::Gemm g{(const bf16*)(ws + WS_A), (const bf16*)(ws + WS_W1), MR, NIN, DM}; BatchOrder S; S.init(vcu);
        if (tid < 64) {
            const unsigned xi = xb_ld(&ctlw[CW_XT + 32 * grp + (tid & 31)]), x0 = xb_ld(&ctlw[CW_XT + 32 * grp]);
            const unsigned long long m = __ballot(xi == x0 && x0 != 0u);
            if (tid == 0) MISC[11] = (m == ~0ull) ? 1u : 0u;
        }
        EpiP1 E{(bf16*)(ws + WS_Q), (bf16*)(ws + WS_K), (bf16*)(ws + WS_V), (bf16*)(ws + WS_B), (bf16*)(ws + WS_GA), (bf16*)(ws + WS_GB), (float*)(ws + WS_SQ), p.out, p.in[8], p.in[9], CopyCtx{p.in[2], p.in[3], p.in[4], p.in[5], p.out}};
        {
            const int wk = S.worker();
            if (wk >= 0) late_weights(p, lds, wk, 103, wave, lane);
        }
        __syncthreads();
        pg8::gemm_phase<EpiP1, BatchOrder, true, true>(lds, g, S, E);
        group_barrier(bar, ctlw, MISC, grp, 32u, SB_P1);
    }
#endif

#if PH_MASK & (1 << 2)
    if (IN(2)) {
        attn_phase_mfma(p, lds, vcu, tid, wave, lane);
        split_wait(bar, ctlw, SB_P1);
        if (wave < 6) attn_sample_unit(p, (LAS float*)(lds + 8192 + wave * 1024), wave * 256 + vcu, lane);
        group_barrier(bar, ctlw, MISC, grp, 64u, SB_P2);
    }
#endif
    {
        if (tid == 0) {
            const unsigned x0 = xb_ld(&ctlw[CW_XT + 4 * quad]), x1 = xb_ld(&ctlw[CW_XT + 4 * quad + 1]), x2 = xb_ld(&ctlw[CW_XT + 4 * quad + 2]), x3 = xb_ld(&ctlw[CW_XT + 4 * quad + 3]);
            MISC[10] = (x0 != 0u && x0 == x1 && x1 == x2 && x2 == x3) ? 1u : 0u;
        }
        if (IN(3)) conv_phase(p, lds, vcu, tid, wave, lane);
        stage_done(bar, ctlw, MISC, quad, 0);
        if (IN(4)) {
            quad_wait(bar, ctlw, quad, 4u, ((quad + 1) & 7) != 0);
            int k_cat = KC; asm volatile("" : "+s"(k_cat));
            pg8::Gemm g{(const bf16*)(ws + WS_A), (const bf16*)(ws + WS_WCAT), MP, DM, k_cat}; QuadOrder S; S.init(vcu, DM / 256);
            EpiGateF E{(const unsigned char*)(ws + WS_GA), (const unsigned char*)(ws + WS_GB), (bf16*)(ws + WS_B)};
            pg8::gemm_phase<EpiGateF, QuadOrder, true, true>(lds, g, S, E);
            split_wait(bar, ctlw, 0);
            split_wait(bar, ctlw, SB_P2);
            thin_stage<0>(p, lds, vcu, tid, wave, lane);
            thin_stage<1>(p, lds, vcu, tid, wave, lane);
            stage_done(bar, ctlw, MISC, quad, 1);
        }
        if (IN(6)) {
            quad_wait(bar, ctlw, quad, 8u, false);
            pg8::Gemm g{(const bf16*)(ws + WS_B), (const bf16*)(ws + WS_WOUT), MP, DM, DM}; QuadOrder S; S.init(vcu, DM / 256);
            EpiX1 E{p.in[0], p.in[1], p.out, (bf16*)(ws + WS_X1B), (float*)(ws + WS_SS)};
            pg8::gemm_phase<EpiX1, QuadOrder, true, true>(lds, g, S, E);
            split_wait(bar, ctlw, 1);
            thin_stage<2>(p, lds, vcu, tid, wave, lane);
            stage_done(bar, ctlw, MISC, quad, 2);
        }
        if (IN(7)) {
            quad_wait(bar, ctlw, quad, 12u, false);
            pg8::Gemm g{(const bf16*)(ws + WS_X1B), (const bf16*)(ws + WS_WGU), MP, NGU, DM}; QuadOrder S; S.init(vcu, NGU / 256);
            EpiAct E{(const float*)(ws + WS_SS), (bf16*)(ws + WS_ACT), CopyCtx{p.in[2], p.in[3], p.in[4], p.in[5], p.out}};
            pg8::gemm_phase<EpiAct, QuadOrder, true, true>(lds, g, S, E);
            split_wait(bar, ctlw, 2);
            thin_stage<3>(p, lds, vcu, tid, wave, lane);
            stage_done(bar, ctlw, MISC, quad, 3);
        }
        if (IN(8)) {
            quad_wait(bar, ctlw, quad, 16u, false);
            pg8::Gemm g{(const bf16*)(ws + WS_ACT), (const bf16*)(ws + WS_WD), MP, DM, DFF}; QuadOrder S; S.init(vcu, DM / 256);
            EpiOut E{p.out, (const bf16*)(ws + WS_X1B)};
            pg8::gemm_phase<EpiOut, QuadOrder, true, true>(lds, g, S, E);
            split_wait(bar, ctlw, 3);
            thin_stage<4>(p, lds, vcu, tid, wave, lane);
        }
    }
#undef IN
#undef BOTH
}

extern "C" void kernel_launch(void* const* d_in, const int* in_sizes, int n_in, void* d_out, int out_size, void* d_ws, size_t ws_size, hipStream_t stream) {
    static int grid = 0;
    if (grid == 0) {
        if (n_in != 20 || (size_t)out_size != O_TOTAL || ws_size < WS_END) { fprintf(stderr, "kernel_launch: unexpected sizes n_in %d out %d ws %zu\n", n_in, out_size, ws_size); grid = -1; return; }
        int dev = 0, cus = 0, per_cu = 0;
        if (hipGetDevice(&dev) != hipSuccess || hipDeviceGetAttribute(&cus, hipDeviceAttributeMultiprocessorCount, dev) != hipSuccess) { grid = -1; return; }
        if (hipFuncSetAttribute((const void*)fwd_kernel, hipFuncAttributeMaxDynamicSharedMemorySize, LDS_BYTES) != hipSuccess) { fprintf(stderr, "kernel_launch: hipFuncSetAttribute failed\n"); grid = -1; return; }
        if (hipOccupancyMaxActiveBlocksPerMultiprocessor(&per_cu, (const void*)fwd_kernel, NWAVES * 64, LDS_BYTES) != hipSuccess || per_cu < 1)
            fprintf(stderr, "kernel_launch: occupancy query reports %d\n", per_cu);
        (void)hipGetLastError();
        if (cus < 256) { fprintf(stderr, "kernel_launch: needs 256 CUs (one resident workgroup each), device has %d\n", cus); grid = -1; return; }
        grid = 256;
    }
    if (grid < 0) return;
    if (hipMemsetAsync((char*)d_ws + WS_CTL, 0, CTL_ZERO_BYTES, stream) != hipSuccess) return;
    Params a{};
    for (int i = 0; i < 20; ++i) a.in[i] = (const float*)d_in[i];
    a.out = (float*)d_out; a.ws = (unsigned char*)d_ws; a.ph_lo = 0; a.ph_hi = 16;
    hipLaunchKernelGGL(fwd_kernel, dim3(grid), dim3(NWAVES * 64), LDS_BYTES, stream, a);
}
```
